# Optimizing an MI355X kernel written in HIP

```python
import math
import numpy as np
import jax
import jax.numpy as jnp
from jax import lax

D_MODEL = 1024
BATCH = 8
SEQ = 4096
DEPTH = 1

HEAD_DIM = 64
N_HEADS_NSA = 8
N_KV_NSA = 2
GROUP_NSA = N_HEADS_NSA // N_KV_NSA
N_HEADS_FOX = 8
MIX_WIDTH = (N_HEADS_NSA + N_HEADS_FOX) * HEAD_DIM
NSA_Q_W = N_HEADS_NSA * HEAD_DIM
NSA_KV_W = N_KV_NSA * HEAD_DIM
FOX_W = N_HEADS_FOX * HEAD_DIM
PROJ_SIZES = (NSA_Q_W, NSA_KV_W, NSA_KV_W, NSA_KV_W, NSA_KV_W, NSA_KV_W, NSA_KV_W,
              3 * N_HEADS_NSA, FOX_W, FOX_W, FOX_W, N_HEADS_FOX)
IN_WIDTH = sum(PROJ_SIZES)
D_FF = 2816
D_PLE = 256
ROPE_THETA = 500000.0
ROT_DIM = HEAD_DIM // 4
CMP_BLOCK = 32
CMP_STRIDE = 16
CMP_HIDDEN = 256
SEL_BLOCK = 64
SEL_TOPK = 16
WINDOW = 512
NSA_Q_BLOCK = 32
FOX_Q_BLOCK = 128
FORCED_SCORE = 1e6
EPS = 1e-6
NEG = -1e30

kernel_name = 'hybrid_nsa_fox_macaron_ple'


def rmsnorm(x, g):
    xf = x.astype(jnp.float32)
    y = xf * lax.rsqrt(jnp.mean(xf * xf, axis=-1, keepdims=True) + EPS)
    return (y * g.astype(jnp.float32)).astype(x.dtype)


def swiglu(x, wg, wu, wd):
    return (jax.nn.silu(x @ wg) * (x @ wu)) @ wd


def split_heads(t, n):
    b, s, _ = t.shape
    return t.reshape(b, s, n, HEAD_DIM).transpose(0, 2, 1, 3)


def merge_heads(t):
    b, n, s, d = t.shape
    return t.transpose(0, 2, 1, 3).reshape(b, s, n * d)


def rope_tables(seq):
    pos = jnp.arange(seq, dtype=jnp.float32)
    inv = ROPE_THETA ** (-jnp.arange(0, ROT_DIM, 2, dtype=jnp.float32) / ROT_DIM)
    ang = pos[:, None] * inv[None, :]
    return jnp.cos(ang), jnp.sin(ang)


def partial_rope(x, cos, sin):
    half = ROT_DIM // 2
    xf = x.astype(jnp.float32)
    x1, x2, rest = xf[..., :half], xf[..., half:ROT_DIM], xf[..., ROT_DIM:]
    out = jnp.concatenate([x1 * cos - x2 * sin, x2 * cos + x1 * sin, rest], axis=-1)
    return out.astype(x.dtype)


def masked_softmax(s, mask):
    return jax.nn.softmax(jnp.where(mask, s.astype(jnp.float32), NEG), axis=-1)


def compress_blocks(tok, pos_emb, w1, w2):
    s = tok.shape[2]
    n_cmp = (s - CMP_BLOCK) // CMP_STRIDE + 1
    idx = np.arange(n_cmp)[:, None] * CMP_STRIDE + np.arange(CMP_BLOCK)[None, :]
    blk = tok[:, :, idx, :] + pos_emb
    blk = blk.reshape(blk.shape[0], blk.shape[1], n_cmp, CMP_BLOCK * HEAD_DIM)
    return jax.nn.silu(blk @ w1) @ w2


def nsa_attention(q, k_cmp, v_cmp, k_slc, v_slc, k_win, v_win, gates):
    b, h, s, d = q.shape
    qg = q.reshape(b, N_KV_NSA, GROUP_NSA, s, d)
    gg_all = gates.reshape(b, N_KV_NSA, GROUP_NSA, s, 3)
    n_cmp = k_cmp.shape[2]
    n_sel = s // SEL_BLOCK
    top = min(SEL_TOPK, n_sel)
    cmp_start = np.arange(n_cmp) * CMP_STRIDE
    cmp_end = jnp.asarray(cmp_start + CMP_BLOCK - 1)
    sel_start = np.arange(n_sel) * SEL_BLOCK
    overlap = jnp.asarray(((cmp_start[:, None] <= sel_start[None, :] + SEL_BLOCK - 1)
                           & (cmp_start[:, None] + CMP_BLOCK - 1 >= sel_start[None, :])).astype(np.float32))
    ks_blocks = k_slc.reshape(b, N_KV_NSA, n_sel, SEL_BLOCK, d)
    vs_blocks = v_slc.reshape(b, N_KV_NSA, n_sel, SEL_BLOCK, d)
    pad = ((0, 0), (0, 0), (WINDOW, 0), (0, 0))
    kw_pad = jnp.pad(k_win, pad)
    vw_pad = jnp.pad(v_win, pad)
    bi = np.arange(b)[:, None, None, None]
    hi = np.arange(N_KV_NSA)[None, :, None, None]
    blk_j = jnp.arange(n_sel)
    scale = HEAD_DIM ** -0.5
    qn = NSA_Q_BLOCK

    def block(qb):
        t0 = qb * qn
        tpos = t0 + jnp.arange(qn)
        qq = lax.dynamic_slice_in_dim(qg, t0, qn, axis=3)
        gg = lax.dynamic_slice_in_dim(gg_all, t0, qn, axis=3)
        m_c = cmp_end[None, :] <= tpos[:, None]
        s_c = jnp.einsum('bkgqd,bknd->bkgqn', qq, k_cmp) * scale
        p_c = masked_softmax(s_c, m_c) * m_c
        o_c = jnp.einsum('bkgqn,bknd->bkgqd', p_c.astype(v_cmp.dtype), v_cmp)
        imp = jnp.einsum('bkgqn,nj->bkqj', p_c, overlap)
        cur = tpos // SEL_BLOCK
        valid = blk_j[None, :] <= cur[:, None]
        forced = (blk_j[None, :] == 0) | (blk_j[None, :] == cur[:, None]) | (blk_j[None, :] == cur[:, None] - 1)
        imp = jnp.where(valid, jnp.where(forced, FORCED_SCORE, imp), -1.0)
        vals, sel = lax.top_k(imp, top)
        kg = ks_blocks[bi, hi, sel].reshape(b, N_KV_NSA, qn, top * SEL_BLOCK, d)
        vg = vs_blocks[bi, hi, sel].reshape(b, N_KV_NSA, qn, top * SEL_BLOCK, d)
        kpos = (sel[..., None] * SEL_BLOCK + jnp.arange(SEL_BLOCK)).reshape(b, N_KV_NSA, qn, top * SEL_BLOCK)
        m_s = (kpos <= tpos[:, None]) & jnp.repeat(vals >= 0, SEL_BLOCK, axis=-1)
        s_s = jnp.einsum('bkgqd,bkqnd->bkgqn', qq, kg) * scale
        p_s = masked_softmax(s_s, m_s[:, :, None])
        o_s = jnp.einsum('bkgqn,bkqnd->bkgqd', p_s.astype(vg.dtype), vg)
        kw = lax.dynamic_slice_in_dim(kw_pad, t0, qn + WINDOW, axis=2)
        vw = lax.dynamic_slice_in_dim(vw_pad, t0, qn + WINDOW, axis=2)
        kpos_w = t0 - WINDOW + jnp.arange(qn + WINDOW)
        diff = tpos[:, None] - kpos_w[None, :]
        m_w = (kpos_w[None, :] >= 0) & (diff >= 0) & (diff < WINDOW)
        s_w = jnp.einsum('bkgqd,bknd->bkgqn', qq, kw) * scale
        p_w = masked_softmax(s_w, m_w)
        o_w = jnp.einsum('bkgqn,bknd->bkgqd', p_w.astype(vw.dtype), vw)
        return gg[..., 0:1] * o_c + gg[..., 1:2] * o_s + gg[..., 2:3] * o_w

    out = lax.map(block, jnp.arange(s // qn))
    return jnp.moveaxis(out, 0, 3).reshape(b, h, s, d)


def forgetting_attention(q, k, v, log_f):
    b, h, s, d = q.shape
    c = jnp.cumsum(log_f, axis=-1)
    kpos = jnp.arange(s)
    scale = HEAD_DIM ** -0.5
    qn = FOX_Q_BLOCK

    def block(qb):
        t0 = qb * qn
        tpos = t0 + jnp.arange(qn)
        qq = lax.dynamic_slice_in_dim(q, t0, qn, axis=2)
        cq = lax.dynamic_slice_in_dim(c, t0, qn, axis=2)
        logits = (jnp.einsum('bhqd,bhsd->bhqs', qq, k).astype(jnp.float32) * scale
                  + cq[..., :, None] - c[:, :, None, :])
        p = masked_softmax(logits, kpos[None, :] <= tpos[:, None])
        return jnp.einsum('bhqs,bhsd->bhqd', p.astype(v.dtype), v)

    out = lax.map(block, jnp.arange(s // qn))
    return jnp.moveaxis(out, 0, 2).reshape(b, h, s, d)


def setup_inputs(seed: int = 0) -> dict:
    key = jax.random.key(seed)
    ks = iter(jax.random.split(key, 40))
    nrm = lambda shape, sc: jax.random.normal(next(ks), shape, jnp.float32) * sc
    gain = lambda n: 1.0 + nrm((DEPTH, n), 0.05)
    L = DEPTH
    return {
        'x': nrm((BATCH, SEQ, D_MODEL), 1.0),
        'p': nrm((DEPTH, BATCH, SEQ, D_PLE), 1.0),
        'ffn1_norm': gain(D_MODEL),
        'ffn1_wg': nrm((L, D_MODEL, D_FF), D_MODEL ** -0.5),
        'ffn1_wu': nrm((L, D_MODEL, D_FF), D_MODEL ** -0.5),
        'ffn1_wd': nrm((L, D_FF, D_MODEL), D_FF ** -0.5),
        'mix_norm': gain(D_MODEL),
        'w_in': nrm((L, D_MODEL, IN_WIDTH), D_MODEL ** -0.5),
        'b_forget': 4.0 + nrm((L, N_HEADS_FOX), 0.5),
        'q_norm_nsa': gain(HEAD_DIM),
        'k_norm_cmp': gain(HEAD_DIM),
        'k_norm_slc': gain(HEAD_DIM),
        'k_norm_win': gain(HEAD_DIM),
        'cmp_pos_k': nrm((L, CMP_BLOCK, HEAD_DIM), 0.02),
        'cmp_pos_v': nrm((L, CMP_BLOCK, HEAD_DIM), 0.02),
        'cmp_k_w1': nrm((L, CMP_BLOCK * HEAD_DIM, CMP_HIDDEN), (CMP_BLOCK * HEAD_DIM) ** -0.5),
        'cmp_k_w2': nrm((L, CMP_HIDDEN, HEAD_DIM), CMP_HIDDEN ** -0.5),
        'cmp_v_w1': nrm((L, CMP_BLOCK * HEAD_DIM, CMP_HIDDEN), (CMP_BLOCK * HEAD_DIM) ** -0.5),
        'cmp_v_w2': nrm((L, CMP_HIDDEN, HEAD_DIM), CMP_HIDDEN ** -0.5),
        'q_norm_fox': gain(HEAD_DIM),
        'k_norm_fox': gain(HEAD_DIM),
        'out_norm_nsa': gain(NSA_Q_W),
        'out_norm_fox': gain(FOX_W),
        'w_out': nrm((L, MIX_WIDTH, D_MODEL), MIX_WIDTH ** -0.5),
        'ffn2_norm': gain(D_MODEL),
        'ffn2_wg': nrm((L, D_MODEL, D_FF), D_MODEL ** -0.5),
        'ffn2_wu': nrm((L, D_MODEL, D_FF), D_MODEL ** -0.5),
        'ffn2_wd': nrm((L, D_FF, D_MODEL), D_FF ** -0.5),
        'ple_gate_norm': gain(D_MODEL),
        'ple_w_gate': nrm((L, D_MODEL, D_MODEL), D_MODEL ** -0.5),
        'ple_w_proj': nrm((L, D_PLE, D_MODEL), D_PLE ** -0.5),
        'ple_norm': gain(D_MODEL),
    }


def reference(x, p, ffn1_norm, ffn1_wg, ffn1_wu, ffn1_wd, mix_norm, w_in, b_forget,
              q_norm_nsa, k_norm_cmp, k_norm_slc, k_norm_win, cmp_pos_k, cmp_pos_v,
              cmp_k_w1, cmp_k_w2, cmp_v_w1, cmp_v_w2, q_norm_fox, k_norm_fox,
              out_norm_nsa, out_norm_fox, w_out, ffn2_norm, ffn2_wg, ffn2_wu, ffn2_wd,
              ple_gate_norm, ple_w_gate, ple_w_proj, ple_norm):
    b, s, _ = x.shape
    cos, sin = rope_tables(s)
    split_points = [int(v) for v in np.cumsum(PROJ_SIZES)[:-1]]
    h = x
    for i in range(DEPTH):
        h = h + 0.5 * swiglu(rmsnorm(h, ffn1_norm[i]), ffn1_wg[i], ffn1_wu[i], ffn1_wd[i])
        a = rmsnorm(h, mix_norm[i])
        u = a @ w_in[i]
        (qa, kc, vc, ksl, vsl, kwn, vwn, ga, qf, kf, vf, fl) = jnp.split(u, split_points, axis=-1)
        q_a = partial_rope(rmsnorm(split_heads(qa, N_HEADS_NSA), q_norm_nsa[i]), cos, sin)
        kc_tok = partial_rope(split_heads(kc, N_KV_NSA), cos, sin)
        k_cmp = rmsnorm(compress_blocks(kc_tok, cmp_pos_k[i], cmp_k_w1[i], cmp_k_w2[i]), k_norm_cmp[i])
        v_cmp = compress_blocks(split_heads(vc, N_KV_NSA), cmp_pos_v[i], cmp_v_w1[i], cmp_v_w2[i])
        k_slc = partial_rope(rmsnorm(split_heads(ksl, N_KV_NSA), k_norm_slc[i]), cos, sin)
        k_win = partial_rope(rmsnorm(split_heads(kwn, N_KV_NSA), k_norm_win[i]), cos, sin)
        gates = jax.nn.sigmoid(ga).reshape(b, s, N_HEADS_NSA, 3).transpose(0, 2, 1, 3)
        o_a = nsa_attention(q_a, k_cmp, v_cmp, k_slc, split_heads(vsl, N_KV_NSA),
                            k_win, split_heads(vwn, N_KV_NSA), gates)
        q_b = rmsnorm(split_heads(qf, N_HEADS_FOX), q_norm_fox[i])
        k_b = rmsnorm(split_heads(kf, N_HEADS_FOX), k_norm_fox[i])
        log_f = jax.nn.log_sigmoid((fl + b_forget[i]).astype(jnp.float32)).transpose(0, 2, 1)
        o_b = forgetting_attention(q_b, k_b, split_heads(vf, N_HEADS_FOX), log_f)
        mixed = jnp.concatenate([rmsnorm(merge_heads(o_a), out_norm_nsa[i]),
                                 rmsnorm(merge_heads(o_b), out_norm_fox[i])], axis=-1)
        h = h + mixed @ w_out[i]
        h = h + 0.5 * swiglu(rmsnorm(h, ffn2_norm[i]), ffn2_wg[i], ffn2_wu[i], ffn2_wd[i])
        gate = jax.nn.sigmoid(rmsnorm(h, ple_gate_norm[i]) @ ple_w_gate[i])
        e = rmsnorm(p[i] @ ple_w_proj[i], ple_norm[i])
        h = h + gate * e
    return h
```

```cpp
#include <hip/hip_runtime.h>
#include <hip/hip_cooperative_groups.h>
#include <cstdint>
#include <cstdio>
namespace cg = cooperative_groups;

#ifndef ONE_LAUNCH
#define ONE_LAUNCH 0
#endif

typedef unsigned short bf16;
constexpr int BATCH = 8, SEQ = 4096, M = BATCH * SEQ, D = 1024, DFF = 2816, INW = 2848, DPLE = 256;
constexpr int QP = 2816;
constexpr int NCMP = 255;
constexpr float EPS = 1e-6f;
constexpr float C2 = 0.125f * 1.4426950408889634f;
constexpr float LOG2E = 1.4426950408889634f;
constexpr int C_QA = 0, C_CK = 512, C_CV = 640, C_SK = 768, C_SV = 896, C_WK = 1024, C_WV = 1152, C_QF = 1280, C_KF = 1792, C_VF = 2304;

constexpr size_t MiB = 1u << 20;
constexpr size_t WS_XN = 0, WS_O = 64 * MiB, WS_BIG = 128 * MiB, WS_SMALL = 320 * MiB;
constexpr size_t WS_KCMP = WS_SMALL, WS_VCMP = WS_SMALL + 1 * MiB, WS_C = WS_SMALL + 2 * MiB, WS_GATES = WS_SMALL + 4 * MiB,
                 WS_LOGF = WS_SMALL + 8 * MiB, WS_ROPE = WS_SMALL + 10 * MiB, WS_END = WS_SMALL + 12 * MiB;

struct P {
    const float* in[32];
    float* out;
    unsigned char* ws;
};

__device__ __forceinline__ float bf2f(bf16 v) { return __uint_as_float((unsigned)v << 16); }
__device__ __forceinline__ bf16 f2bf(float f) { unsigned u = __float_as_uint(f); return (bf16)((u + 0x7fffu + ((u >> 16) & 1u)) >> 16); }
__device__ __forceinline__ float wave_sum(float v) {
#pragma unroll
    for (int o = 1; o < 64; o <<= 1) v += __shfl_xor(v, o);
    return v;
}
__device__ __forceinline__ float wave_max(float v) {
#pragma unroll
    for (int o = 1; o < 64; o <<= 1) v = fmaxf(v, __shfl_xor(v, o));
    return v;
}
__device__ __forceinline__ float sigmoidf_(float x) { return 1.f / (1.f + __expf(-x)); }
__device__ __forceinline__ float siluf_(float x) { return x / (1.f + __expf(-x)); }

__device__ __forceinline__ void ph_rope(const P& p, int bid, int nb) {
    float* rope = (float*)(p.ws + WS_ROPE);
    for (int i = bid * 256 + threadIdx.x; i < SEQ * 8; i += nb * 256) {
        const int t = i >> 3, f = i & 7;
        const double inv = pow(500000.0, -(double)f / 8.0);
        const double ang = (double)t * inv;
        rope[2 * i] = (float)cos(ang); rope[2 * i + 1] = (float)sin(ang);
    }
}
__device__ __forceinline__ void ph_rmsnorm(const float* in, const float* gain, bf16* outb, float* outf, int bid, int nb) {
    const int lane = threadIdx.x & 63, w = threadIdx.x >> 6;
    for (int r = bid * 4 + w; r < M; r += nb * 4) {
        const float* x = in + (size_t)r * D;
        float v[16]; float s = 0.f;
#pragma unroll
        for (int j = 0; j < 16; ++j) { v[j] = x[lane + 64 * j]; s += v[j] * v[j]; }
        s = wave_sum(s);
        const float rs = 1.0f / sqrtf(s * (1.f / D) + EPS);
#pragma unroll
        for (int j = 0; j < 16; ++j) {
            const float y = v[j] * rs * gain[lane + 64 * j];
            if (outb) outb[(size_t)r * D + lane + 64 * j] = f2bf(y);
            else outf[(size_t)r * D + lane + 64 * j] = y;
        }
    }
}
struct GA { const void* A; int lda; bool a_f32; const float* B0; const float* B1; int ldb; int N, K; float alpha; const float* res; float* outf; bf16* outb; const float* E; };

__device__ __forceinline__ int win_srccol(int tn, int c) {
    if (tn < 20) return tn * 64 + c;
    if (tn < 44) return 1304 + (tn - 20) * 64 + c;
    if (c < 24) return 1280 + c;
    if (c < 32) return 2840 + (c - 24);
    return -1;
}

template <int MODE> __device__ __forceinline__ void ngemm(const P& p, const GA& g, float* sm, int bid, int nb) {
    float* As = sm;
    float* Bs0 = sm + 16 * 68;
    float* Bs1 = Bs0 + 16 * 64;
    float* T = Bs1 + 16 * 64;
    const int tid = threadIdx.x, ty = tid >> 4, tx = tid & 15, lane = tid & 63, w = tid >> 6;
    const int ntn = (g.N + 63) / 64, ntm = M / 64, ntiles = ntn * ntm;
    for (int tile = bid; tile < ntiles; tile += nb) {
        const int tm = tile / ntn, tn = tile % ntn;
        float acc0[4][4], acc1[4][4];
#pragma unroll
        for (int i = 0; i < 4; ++i)
#pragma unroll
            for (int j = 0; j < 4; ++j) { acc0[i][j] = 0.f; acc1[i][j] = 0.f; }
        for (int k0 = 0; k0 < g.K; k0 += 16) {
            {
                const int r = tid >> 2, kq = (tid & 3) * 4;
                float a[4];
                if (g.a_f32) { const float* ap = (const float*)g.A + (size_t)(tm * 64 + r) * g.lda + k0 + kq; a[0] = ap[0]; a[1] = ap[1]; a[2] = ap[2]; a[3] = ap[3]; }
                else { const bf16* ap = (const bf16*)g.A + (size_t)(tm * 64 + r) * g.lda + k0 + kq; a[0] = bf2f(ap[0]); a[1] = bf2f(ap[1]); a[2] = bf2f(ap[2]); a[3] = bf2f(ap[3]); }
#pragma unroll
                for (int i = 0; i < 4; ++i) As[(kq + i) * 68 + r] = a[i];
            }
            {
                const int k = tid >> 4, c4 = (tid & 15) * 4;
#pragma unroll
                for (int i = 0; i < 4; ++i) {
                    int sc = tn * 64 + c4 + i;
                    if (MODE == 4) sc = win_srccol(tn, c4 + i);
                    else if (sc >= g.N) sc = -1;
                    Bs0[k * 64 + c4 + i] = sc >= 0 ? g.B0[(size_t)(k0 + k) * g.ldb + sc] : 0.f;
                    if (MODE == 0) Bs1[k * 64 + c4 + i] = sc >= 0 ? g.B1[(size_t)(k0 + k) * g.ldb + sc] : 0.f;
                }
            }
            __syncthreads();
#pragma unroll
            for (int kk = 0; kk < 16; ++kk) {
                float a[4], b[4], b1[4];
#pragma unroll
                for (int i = 0; i < 4; ++i) { a[i] = As[kk * 68 + ty * 4 + i]; b[i] = Bs0[kk * 64 + tx * 4 + i]; if (MODE == 0) b1[i] = Bs1[kk * 64 + tx * 4 + i]; }
#pragma unroll
                for (int i = 0; i < 4; ++i)
#pragma unroll
                    for (int j = 0; j < 4; ++j) { acc0[i][j] += a[i] * b[j]; if (MODE == 0) acc1[i][j] += a[i] * b1[j]; }
            }
            __syncthreads();
        }
        if (MODE != 4) {
#pragma unroll
            for (int i = 0; i < 4; ++i)
#pragma unroll
                for (int j = 0; j < 4; ++j) {
                    const int r = tm * 64 + ty * 4 + i, c = tn * 64 + tx * 4 + j;
                    if (c < g.N) {
                        if (MODE == 0) g.outb[(size_t)r * g.N + c] = f2bf(siluf_(acc0[i][j]) * acc1[i][j]);
                        if (MODE == 1) g.outf[(size_t)r * D + c] = g.res[(size_t)r * D + c] + g.alpha * acc0[i][j];
                        if (MODE == 2) g.outf[(size_t)r * g.N + c] = acc0[i][j];
                        if (MODE == 3) g.outf[(size_t)r * D + c] = g.outf[(size_t)r * D + c] + sigmoidf_(acc0[i][j]) * g.E[(size_t)r * D + c];
                    }
                }
        } else {
#pragma unroll
            for (int i = 0; i < 4; ++i)
#pragma unroll
                for (int j = 0; j < 4; ++j) T[(ty * 4 + i) * 65 + tx * 4 + j] = acc0[i][j];
            __syncthreads();
            bf16* QKV = (bf16*)(p.ws + WS_BIG);
            float* gates = (float*)(p.ws + WS_GATES);
            float* logf_ = (float*)(p.ws + WS_LOGF);
            const float* rope = (const float*)(p.ws + WS_ROPE);
            const float* gain = nullptr; bool dorope = false; float scale = 1.f; int dcol = tn * 64;
            if (tn < 8) { gain = p.in[9]; dorope = true; scale = C2; }
            else if (tn < 10) { dorope = true; }
            else if (tn < 12) {}
            else if (tn < 14) { gain = p.in[11]; dorope = true; }
            else if (tn < 16) {}
            else if (tn < 18) { gain = p.in[12]; dorope = true; }
            else if (tn < 20) {}
            else if (tn < 28) { gain = p.in[19]; scale = C2; }
            else if (tn < 36) { gain = p.in[20]; }
            for (int rr = 0; rr < 16; ++rr) {
                const int rl = w * 16 + rr, r = tm * 64 + rl, t = r & (SEQ - 1);
                float v = T[rl * 65 + lane];
                if (tn < 44) {
                    if (gain) { const float ss = wave_sum(v * v); v = v * (1.0f / sqrtf(ss * (1.f / 64.f) + EPS)) * gain[lane]; }
                    if (dorope) {
                        const float pr = __shfl_xor(v, 8);
                        if (lane < 16) { const float c = rope[(t * 8 + (lane & 7)) * 2], s = rope[(t * 8 + (lane & 7)) * 2 + 1]; v = lane < 8 ? v * c - pr * s : v * c + pr * s; }
                    }
                    QKV[(size_t)r * QP + dcol + lane] = f2bf(v * scale);
                } else {
                    if (lane < 24) gates[(size_t)r * 24 + lane] = sigmoidf_(v);
                    else if (lane < 32) { const float x = v + p.in[8][lane - 24]; logf_[(size_t)r * 8 + lane - 24] = fminf(x, 0.f) - log1pf(__expf(-fabsf(x))); }
                }
            }
            __syncthreads();
        }
    }
}
__device__ __forceinline__ void ph_compress(const P& p, float* sm, int bid, int nb) {
    float* blk = sm;
    float* hid = sm + 2048;
    const bf16* QKV = (const bf16*)(p.ws + WS_BIG);
    const int tid = threadIdx.x;
    for (int item = bid; item < 16 * 256 * 2; item += nb) {
        const int which = item & 1, n = (item >> 1) & 255, bk = item >> 9, b = bk >> 1, kvh = bk & 1;
        bf16* outp = (bf16*)(p.ws + (which ? WS_VCMP : WS_KCMP)) + ((size_t)bk * 256 + n) * 64;
        if (n == 255) { if (tid < 64) outp[tid] = 0; continue; }
        const float* pos = which ? p.in[14] : p.in[13];
        const float* w1 = which ? p.in[17] : p.in[15];
        const float* w2 = which ? p.in[18] : p.in[16];
        const int col0 = (which ? C_CV : C_CK) + kvh * 64;
        for (int i = tid; i < 2048; i += 256) { const int l = i >> 6, d = i & 63; blk[i] = bf2f(QKV[(size_t)(b * SEQ + 16 * n + l) * QP + col0 + d]) + pos[i]; }
        __syncthreads();
        float acc = 0.f;
        for (int i = 0; i < 2048; ++i) acc += blk[i] * w1[(size_t)i * 256 + tid];
        hid[tid] = siluf_(acc);
        __syncthreads();
        if (tid < 64) {
            float o = 0.f;
            for (int j = 0; j < 256; ++j) o += hid[j] * w2[j * 64 + tid];
            if (!which) { const float ss = wave_sum(o * o); o = o * (1.0f / sqrtf(ss * (1.f / 64.f) + EPS)) * p.in[10][tid]; }
            outp[tid] = f2bf(o);
        }
        __syncthreads();
    }
}
__device__ __forceinline__ void ph_cumsum(const P& p, int bid, int nb) {
    const float* logf_ = (const float*)(p.ws + WS_LOGF);
    float* C = (float*)(p.ws + WS_C);
    const int lane = threadIdx.x & 63, w = threadIdx.x >> 6;
    for (int item = bid * 4 + w; item < BATCH * 8; item += nb * 4) {
        const int b = item >> 3, h = item & 7;
        float carry = 0.f;
        for (int t0 = 0; t0 < SEQ; t0 += 64) {
            float v = logf_[(size_t)(b * SEQ + t0 + lane) * 8 + h];
#pragma unroll
            for (int o = 1; o < 64; o <<= 1) { const float u = __shfl_up(v, o); if (lane >= o) v += u; }
            v += carry;
            C[(size_t)item * SEQ + t0 + lane] = v;
            carry = __shfl(v, 63);
        }
    }
}
__device__ __forceinline__ float dot64(const float* q, const bf16* k) {
    float s = 0.f;
#pragma unroll
    for (int i = 0; i < 8; ++i) {
        const uint4 v = *(const uint4*)(k + 8 * i);
        const unsigned u[4] = {v.x, v.y, v.z, v.w};
#pragma unroll
        for (int j = 0; j < 4; ++j) { s += q[8 * i + 2 * j] * __uint_as_float(u[j] << 16); s += q[8 * i + 2 * j + 1] * __uint_as_float(u[j] & 0xffff0000u); }
    }
    return s;
}
__device__ __forceinline__ void ph_nsa(const P& p, float* sm, int bid, int nb) {
    float* impp = sm;
    float* pl = sm + 256;
    const bf16* QKV = (const bf16*)(p.ws + WS_BIG);
    const bf16* KC = (const bf16*)(p.ws + WS_KCMP);
    const bf16* VC = (const bf16*)(p.ws + WS_VCMP);
    const float* gates = (const float*)(p.ws + WS_GATES);
    bf16* O = (bf16*)(p.ws + WS_O);
    const int lane = threadIdx.x & 63, g = threadIdx.x >> 6;
    float* mypl = pl + g * 1024;
    for (int item = bid; item < M * 2; item += nb) {
        const int kvh = item & 1, m = item >> 1, b = m / SEQ, t = m % SEQ, h = kvh * 4 + g;
        float q[64];
        { const bf16* qp = QKV + (size_t)m * QP + C_QA + h * 64;
#pragma unroll
          for (int i = 0; i < 64; ++i) q[i] = bf2f(qp[i]); }
        const int ncv = t >= 31 ? (t - 31) / 16 + 1 : 0;
        const bf16* kc = KC + (size_t)(b * 2 + kvh) * 256 * 64;
        const bf16* vc = VC + (size_t)(b * 2 + kvh) * 256 * 64;
        float sc[4]; float mx = -1e30f;
#pragma unroll
        for (int i = 0; i < 4; ++i) { const int n = lane + 64 * i; sc[i] = -1e30f; if (n < ncv) { sc[i] = dot64(q, kc + n * 64); mx = fmaxf(mx, sc[i]); } }
        mx = wave_max(mx);
        float sum = 0.f;
#pragma unroll
        for (int i = 0; i < 4; ++i) { const int n = lane + 64 * i; sc[i] = n < ncv ? exp2f(sc[i] - mx) : 0.f; sum += sc[i]; }
        sum = wave_sum(sum);
        const float rs = ncv > 0 ? 1.f / sum : 0.f;
#pragma unroll
        for (int i = 0; i < 4; ++i) mypl[lane + 64 * i] = sc[i] * rs;
        __syncthreads();
        float oc = 0.f;
        for (int n = 0; n < ncv; ++n) oc += mypl[n] * bf2f(vc[n * 64 + lane]);
        { float im = 0.f; const int lo = max(0, 4 * lane - 1), hi = min(254, 4 * lane + 3);
          for (int n = lo; n <= hi; ++n) im += mypl[n];
          impp[g * 64 + lane] = im; }
        __syncthreads();
        const int cur = t >> 6;
        float val = (impp[lane] + impp[64 + lane]) + (impp[128 + lane] + impp[192 + lane]);
        if (lane > cur) val = -1.f; else if (lane == 0 || lane == cur || lane == cur - 1) val = 1e6f;
        int rank = 0;
        for (int i = 0; i < 64; ++i) { const float vi = __shfl(val, i); rank += (vi > val || (vi == val && i < lane)) ? 1 : 0; }
        const unsigned long long selmask = __ballot(rank < 16 && val >= 0.f);
        __syncthreads();
        float os = 0.f;
        {
            const bf16* kb = QKV + (size_t)(b * SEQ) * QP + C_SK + kvh * 64;
            const bf16* vb = QKV + (size_t)(b * SEQ) * QP + C_SV + kvh * 64;
            unsigned long long mk = selmask; int idx = 0; float mx2 = -1e30f;
            while (mk) { const int j = __ffsll((long long)mk) - 1; mk &= mk - 1; const int kp = j * 64 + lane;
                float s = -1e30f; if (kp <= t) { s = dot64(q, kb + (size_t)kp * QP); mx2 = fmaxf(mx2, s); }
                mypl[idx * 64 + lane] = s; ++idx; }
            mx2 = wave_max(mx2);
            float sum2 = 0.f;
            for (int i = 0; i < idx; ++i) { const float s = mypl[i * 64 + lane]; const float e = s > -1e29f ? exp2f(s - mx2) : 0.f; mypl[i * 64 + lane] = e; sum2 += e; }
            sum2 = wave_sum(sum2);
            mk = selmask; idx = 0;
            while (mk) { const int j = __ffsll((long long)mk) - 1; mk &= mk - 1;
                const int nk = min(64, t - j * 64 + 1);
                for (int kk = 0; kk < nk; ++kk) os += mypl[idx * 64 + kk] * bf2f(vb[(size_t)(j * 64 + kk) * QP + lane]);
                ++idx; }
            os /= sum2;
        }
        float ow = 0.f;
        {
            const bf16* kb = QKV + (size_t)(b * SEQ) * QP + C_WK + kvh * 64;
            const bf16* vb = QKV + (size_t)(b * SEQ) * QP + C_WV + kvh * 64;
            const int k0 = max(0, t - 511), nk = t - k0 + 1;
            float mx3 = -1e30f;
            for (int i = 0; i * 64 < nk; ++i) { const int kk = i * 64 + lane; float s = -1e30f; if (kk < nk) { s = dot64(q, kb + (size_t)(k0 + kk) * QP); mx3 = fmaxf(mx3, s); } mypl[kk] = s; }
            mx3 = wave_max(mx3);
            float sum3 = 0.f;
            for (int i = 0; i * 64 < nk; ++i) { const int kk = i * 64 + lane; const float s = mypl[kk]; const float e = kk < nk ? exp2f(s - mx3) : 0.f; mypl[kk] = e; sum3 += e; }
            sum3 = wave_sum(sum3);
            for (int kk = 0; kk < nk; ++kk) ow += mypl[kk] * bf2f(vb[(size_t)(k0 + kk) * QP + lane]);
            ow /= sum3;
        }
        const float* gg = gates + (size_t)m * 24 + h * 3;
        O[(size_t)m * D + h * 64 + lane] = f2bf(gg[0] * oc + gg[1] * os + gg[2] * ow);
        __syncthreads();
    }
}
__device__ __forceinline__ void ph_fox(const P& p, float* sm, int bid, int nb) {
    const bf16* QKV = (const bf16*)(p.ws + WS_BIG);
    const float* C = (const float*)(p.ws + WS_C);
    bf16* O = (bf16*)(p.ws + WS_O);
    const int lane = threadIdx.x & 63, w = threadIdx.x >> 6;
    float* pl = sm + w * 4096;
    for (int it = bid * 4 + w; it < M * 8; it += nb * 4) {
        const int tt = it % SEQ, bh = it / SEQ, b = bh >> 3, h = bh & 7;
        const int t = (tt & 1) ? (SEQ - 1 - (tt >> 1)) : (tt >> 1);
        const int m = b * SEQ + t;
        float q[64];
        { const bf16* qp = QKV + (size_t)m * QP + C_QF + h * 64;
#pragma unroll
          for (int i = 0; i < 64; ++i) q[i] = bf2f(qp[i]); }
        const bf16* kb = QKV + (size_t)(b * SEQ) * QP + C_KF + h * 64;
        const bf16* vb = QKV + (size_t)(b * SEQ) * QP + C_VF + h * 64;
        const float* c = C + (size_t)bh * SEQ;
        const float ct = c[t];
        const int nk = t + 1;
        float mx = -1e30f;
        for (int i = 0; i * 64 < nk; ++i) { const int kk = i * 64 + lane; float s = -1e30f; if (kk < nk) { s = dot64(q, kb + (size_t)kk * QP) + (ct - c[kk]) * LOG2E; mx = fmaxf(mx, s); } pl[kk] = s; }
        mx = wave_max(mx);
        float sum = 0.f;
        for (int i = 0; i * 64 < nk; ++i) { const int kk = i * 64 + lane; const float e = kk < nk ? exp2f(pl[kk] - mx) : 0.f; pl[kk] = e; sum += e; }
        sum = wave_sum(sum);
        float o = 0.f;
        for (int kk = 0; kk < nk; ++kk) o += pl[kk] * bf2f(vb[(size_t)kk * QP + lane]);
        O[(size_t)m * D + 512 + h * 64 + lane] = f2bf(o / sum);
    }
}
__device__ __forceinline__ void ph_groupnorm(const P& p, int bid, int nb) {
    const bf16* O = (const bf16*)(p.ws + WS_O);
    bf16* XN = (bf16*)(p.ws + WS_XN);
    const int lane = threadIdx.x & 63, w = threadIdx.x >> 6;
    for (int it = bid * 4 + w; it < M * 2; it += nb * 4) {
        const int m = it >> 1, grp = it & 1;
        const float* gain = grp ? p.in[22] : p.in[21];
        float v[8]; float s = 0.f;
#pragma unroll
        for (int j = 0; j < 8; ++j) { v[j] = bf2f(O[(size_t)m * D + grp * 512 + lane + 64 * j]); s += v[j] * v[j]; }
        s = wave_sum(s);
        const float rs = 1.0f / sqrtf(s * (1.f / 512.f) + EPS);
#pragma unroll
        for (int j = 0; j < 8; ++j) XN[(size_t)m * D + grp * 512 + lane + 64 * j] = f2bf(v[j] * rs * gain[lane + 64 * j]);
    }
}

constexpr int NPHASE = 20;
__device__ __forceinline__ void run_phase(const P& p, float* sm, int ph, int bid, int nb) {
    bf16* XN = (bf16*)(p.ws + WS_XN);
    bf16* HID = (bf16*)(p.ws + WS_BIG);
    float* E = (float*)(p.ws + WS_BIG);
    switch (ph) {
    case 0: ph_rope(p, bid, nb); ph_rmsnorm(p.in[0], p.in[2], XN, nullptr, bid, nb); break;
    case 1: { GA g{XN, D, false, p.in[3], p.in[4], DFF, DFF, D, 0.f, nullptr, nullptr, HID, nullptr}; ngemm<0>(p, g, sm, bid, nb); } break;
    case 2: { GA g{HID, DFF, false, p.in[5], nullptr, D, D, DFF, 0.5f, p.in[0], p.out, nullptr, nullptr}; ngemm<1>(p, g, sm, bid, nb); } break;
    case 3: ph_rmsnorm(p.out, p.in[6], XN, nullptr, bid, nb); break;
    case 4: { GA g{XN, D, false, p.in[7], nullptr, INW, 45 * 64, D, 0.f, nullptr, nullptr, nullptr, nullptr}; ngemm<4>(p, g, sm, bid, nb); } break;
    case 5: ph_compress(p, sm, bid, nb); ph_cumsum(p, bid, nb); break;
    case 6: ph_nsa(p, sm, bid, nb); break;
    case 7: ph_fox(p, sm, bid, nb); break;
    case 8: ph_groupnorm(p, bid, nb); break;
    case 9: { GA g{XN, D, false, p.in[23], nullptr, D, D, D, 1.f, p.out, p.out, nullptr, nullptr}; ngemm<1>(p, g, sm, bid, nb); } break;
    case 10: ph_rmsnorm(p.out, p.in[24], XN, nullptr, bid, nb); break;
    case 11: { GA g{XN, D, false, p.in[25], p.in[26], DFF, DFF, D, 0.f, nullptr, nullptr, HID, nullptr}; ngemm<0>(p, g, sm, bid, nb); } break;
    case 12: { GA g{HID, DFF, false, p.in[27], nullptr, D, D, DFF, 0.5f, p.out, p.out, nullptr, nullptr}; ngemm<1>(p, g, sm, bid, nb); } break;
    case 13: ph_rmsnorm(p.out, p.in[28], XN, nullptr, bid, nb); break;
    case 14: { GA g{p.in[1], DPLE, true, p.in[30], nullptr, D, D, DPLE, 0.f, nullptr, E, nullptr, nullptr}; ngemm<2>(p, g, sm, bid, nb); } break;
    case 15: ph_rmsnorm(E, p.in[31], nullptr, E, bid, nb); break;
    case 16: { GA g{XN, D, false, p.in[29], nullptr, D, D, D, 0.f, nullptr, p.out, nullptr, E}; ngemm<3>(p, g, sm, bid, nb); } break;
    default: break;
    }
}
constexpr int LAST_PHASE = 16;

__global__ void __launch_bounds__(256) k_phase(P p, int ph) {
    __shared__ float sm[16384];
    run_phase(p, sm, ph, blockIdx.x, gridDim.x);
}
__global__ void __launch_bounds__(256) k_mega(P p) {
    __shared__ float sm[16384];
    cg::grid_group grid = cg::this_grid();
    for (int ph = 0; ph <= LAST_PHASE; ++ph) {
        run_phase(p, sm, ph, blockIdx.x, gridDim.x);
        if (ph < LAST_PHASE) grid.sync();
    }
}

extern "C" void kernel_launch(void* const* d_in, const int* in_sizes, int n_in, void* d_out, int out_size, void* d_ws, size_t ws_size, hipStream_t stream) {
    if (n_in != 32 || out_size != M * D || ws_size < WS_END) { fprintf(stderr, "kernel_launch: unexpected sizes n_in %d out %d ws %zu\n", n_in, out_size, ws_size); return; }
    P p{};
    for (int i = 0; i < 32; ++i) p.in[i] = (const float*)d_in[i];
    p.out = (float*)d_out; p.ws = (unsigned char*)d_ws;
#if ONE_LAUNCH
    static int grid = 0;
    if (!grid) {
        int dev = 0, cus = 0, per_cu = 0;
        hipGetDevice(&dev);
        hipDeviceGetAttribute(&cus, hipDeviceAttributeMultiprocessorCount, dev);
        hipOccupancyMaxActiveBlocksPerMultiprocessor(&per_cu, k_mega, 256, 0);
        if (per_cu > 2) per_cu = 2;
        grid = cus * per_cu;
    }
    void* args[] = {&p};
    hipError_t e = hipLaunchCooperativeKernel((void*)k_mega, dim3(grid), dim3(256), args, 0, stream);
    if (e != hipSuccess) fprintf(stderr, "cooperative launch failed: %s (grid %d)\n", hipGetErrorString(e), grid);
#else
    for (int ph = 0; ph <= LAST_PHASE; ++ph) hipLaunchKernelGGL(k_phase, dim3(2048), dim3(256), 0, stream, p, ph);
#endif
}
```

```cpp
#include <hip/hip_runtime.h>
#include <hip/hip_cooperative_groups.h>
#include <cstdint>
#include <cstdio>
namespace cg = cooperative_groups;

#ifndef ONE_LAUNCH
#define ONE_LAUNCH 1
#endif

typedef unsigned short bf16;
constexpr int BATCH = 8, SEQ = 4096, M = BATCH * SEQ, D = 1024, DFF = 2816, INW = 2848, DPLE = 256;
constexpr int QP = 2816;
constexpr int NCMP = 255;
constexpr float EPS = 1e-6f;
constexpr float C2 = 0.125f * 1.4426950408889634f;
constexpr float LOG2E = 1.4426950408889634f;
constexpr int C_QA = 0, C_CK = 512, C_CV = 640, C_SK = 768, C_SV = 896, C_WK = 1024, C_WV = 1152, C_QF = 1280, C_KF = 1792, C_VF = 2304;

constexpr size_t MiB = 1u << 20;
constexpr size_t WS_XN = 0, WS_O = 64 * MiB, WS_BIG = 128 * MiB, WS_SMALL = 320 * MiB;
constexpr size_t WS_KCMP = WS_SMALL, WS_VCMP = WS_SMALL + 1 * MiB, WS_C = WS_SMALL + 2 * MiB, WS_GATES = WS_SMALL + 4 * MiB,
                 WS_LOGF = WS_SMALL + 8 * MiB, WS_ROPE = WS_SMALL + 10 * MiB, WS_END = WS_SMALL + 12 * MiB;

struct P {
    const float* in[32];
    float* out;
    unsigned char* ws;
};

__device__ __forceinline__ float bf2f(bf16 v) { return __uint_as_float((unsigned)v << 16); }
__device__ __forceinline__ bf16 f2bf(float f) { unsigned u = __float_as_uint(f); return (bf16)((u + 0x7fffu + ((u >> 16) & 1u)) >> 16); }
__device__ __forceinline__ float wave_sum(float v) {
#pragma unroll
    for (int o = 1; o < 64; o <<= 1) v += __shfl_xor(v, o);
    return v;
}
__device__ __forceinline__ float wave_max(float v) {
#pragma unroll
    for (int o = 1; o < 64; o <<= 1) v = fmaxf(v, __shfl_xor(v, o));
    return v;
}
__device__ __forceinline__ float sigmoidf_(float x) { return 1.f / (1.f + __expf(-x)); }
__device__ __forceinline__ float siluf_(float x) { return x / (1.f + __expf(-x)); }

__device__ __forceinline__ void ph_rope(const P& p, int bid, int nb) {
    float* rope = (float*)(p.ws + WS_ROPE);
    for (int i = bid * 256 + threadIdx.x; i < SEQ * 8; i += nb * 256) {
        const int t = i >> 3, f = i & 7;
        const double inv = pow(500000.0, -(double)f / 8.0);
        const double ang = (double)t * inv;
        rope[2 * i] = (float)cos(ang); rope[2 * i + 1] = (float)sin(ang);
    }
}
__device__ __forceinline__ void ph_rmsnorm(const float* in, const float* gain, bf16* outb, float* outf, int bid, int nb) {
    const int lane = threadIdx.x & 63, w = threadIdx.x >> 6;
    for (int r = bid * 4 + w; r < M; r += nb * 4) {
        const float* x = in + (size_t)r * D;
        float v[16]; float s = 0.f;
#pragma unroll
        for (int j = 0; j < 16; ++j) { v[j] = x[lane + 64 * j]; s += v[j] * v[j]; }
        s = wave_sum(s);
        const float rs = 1.0f / sqrtf(s * (1.f / D) + EPS);
#pragma unroll
        for (int j = 0; j < 16; ++j) {
            const float y = v[j] * rs * gain[lane + 64 * j];
            if (outb) outb[(size_t)r * D + lane + 64 * j] = f2bf(y);
            else outf[(size_t)r * D + lane + 64 * j] = y;
        }
    }
}
struct GA { const void* A; int lda; bool a_f32; const float* B0; const float* B1; int ldb; int N, K; float alpha; const float* res; float* outf; bf16* outb; const float* E; };

__device__ __forceinline__ int win_srccol(int tn, int c) {
    if (tn < 20) return tn * 64 + c;
    if (tn < 44) return 1304 + (tn - 20) * 64 + c;
    if (c < 24) return 1280 + c;
    if (c < 32) return 2840 + (c - 24);
    return -1;
}

template <int MODE> __device__ __forceinline__ void ngemm(const P& p, const GA& g, float* sm, int bid, int nb) {
    float* As = sm;
    float* Bs0 = sm + 16 * 68;
    float* Bs1 = Bs0 + 16 * 64;
    float* T = Bs1 + 16 * 64;
    const int tid = threadIdx.x, ty = tid >> 4, tx = tid & 15, lane = tid & 63, w = tid >> 6;
    const int ntn = (g.N + 63) / 64, ntm = M / 64, ntiles = ntn * ntm;
    for (int tile = bid; tile < ntiles; tile += nb) {
        const int tm = tile / ntn, tn = tile % ntn;
        float acc0[4][4], acc1[4][4];
#pragma unroll
        for (int i = 0; i < 4; ++i)
#pragma unroll
            for (int j = 0; j < 4; ++j) { acc0[i][j] = 0.f; acc1[i][j] = 0.f; }
        for (int k0 = 0; k0 < g.K; k0 += 16) {
            {
                const int r = tid >> 2, kq = (tid & 3) * 4;
                float a[4];
                if (g.a_f32) { const float* ap = (const float*)g.A + (size_t)(tm * 64 + r) * g.lda + k0 + kq; a[0] = ap[0]; a[1] = ap[1]; a[2] = ap[2]; a[3] = ap[3]; }
                else { const bf16* ap = (const bf16*)g.A + (size_t)(tm * 64 + r) * g.lda + k0 + kq; a[0] = bf2f(ap[0]); a[1] = bf2f(ap[1]); a[2] = bf2f(ap[2]); a[3] = bf2f(ap[3]); }
#pragma unroll
                for (int i = 0; i < 4; ++i) As[(kq + i) * 68 + r] = a[i];
            }
            {
                const int k = tid >> 4, c4 = (tid & 15) * 4;
#pragma unroll
                for (int i = 0; i < 4; ++i) {
                    int sc = tn * 64 + c4 + i;
                    if (MODE == 4) sc = win_srccol(tn, c4 + i);
                    else if (sc >= g.N) sc = -1;
                    Bs0[k * 64 + c4 + i] = sc >= 0 ? g.B0[(size_t)(k0 + k) * g.ldb + sc] : 0.f;
                    if (MODE == 0) Bs1[k * 64 + c4 + i] = sc >= 0 ? g.B1[(size_t)(k0 + k) * g.ldb + sc] : 0.f;
                }
            }
            __syncthreads();
#pragma unroll
            for (int kk = 0; kk < 16; ++kk) {
                float a[4], b[4], b1[4];
#pragma unroll
                for (int i = 0; i < 4; ++i) { a[i] = As[kk * 68 + ty * 4 + i]; b[i] = Bs0[kk * 64 + tx * 4 + i]; if (MODE == 0) b1[i] = Bs1[kk * 64 + tx * 4 + i]; }
#pragma unroll
                for (int i = 0; i < 4; ++i)
#pragma unroll
                    for (int j = 0; j < 4; ++j) { acc0[i][j] += a[i] * b[j]; if (MODE == 0) acc1[i][j] += a[i] * b1[j]; }
            }
            __syncthreads();
        }
        if (MODE != 4) {
#pragma unroll
            for (int i = 0; i < 4; ++i)
#pragma unroll
                for (int j = 0; j < 4; ++j) {
                    const int r = tm * 64 + ty * 4 + i, c = tn * 64 + tx * 4 + j;
                    if (c < g.N) {
                        if (MODE == 0) g.outb[(size_t)r * g.N + c] = f2bf(siluf_(acc0[i][j]) * acc1[i][j]);
                        if (MODE == 1) g.outf[(size_t)r * D + c] = g.res[(size_t)r * D + c] + g.alpha * acc0[i][j];
                        if (MODE == 2) g.outf[(size_t)r * g.N + c] = acc0[i][j];
                        if (MODE == 3) g.outf[(size_t)r * D + c] = g.outf[(size_t)r * D + c] + sigmoidf_(acc0[i][j]) * g.E[(size_t)r * D + c];
                    }
                }
        } else {
#pragma unroll
            for (int i = 0; i < 4; ++i)
#pragma unroll
                for (int j = 0; j < 4; ++j) T[(ty * 4 + i) * 65 + tx * 4 + j] = acc0[i][j];
            __syncthreads();
            bf16* QKV = (bf16*)(p.ws + WS_BIG);
            float* gates = (float*)(p.ws + WS_GATES);
            float* logf_ = (float*)(p.ws + WS_LOGF);
            const float* rope = (const float*)(p.ws + WS_ROPE);
            const float* gain = nullptr; bool dorope = false; float scale = 1.f; int dcol = tn * 64;
            if (tn < 8) { gain = p.in[9]; dorope = true; scale = C2; }
            else if (tn < 10) { dorope = true; }
            else if (tn < 12) {}
            else if (tn < 14) { gain = p.in[11]; dorope = true; }
            else if (tn < 16) {}
            else if (tn < 18) { gain = p.in[12]; dorope = true; }
            else if (tn < 20) {}
            else if (tn < 28) { gain = p.in[19]; scale = C2; }
            else if (tn < 36) { gain = p.in[20]; }
            for (int rr = 0; rr < 16; ++rr) {
                const int rl = w * 16 + rr, r = tm * 64 + rl, t = r & (SEQ - 1);
                float v = T[rl * 65 + lane];
                if (tn < 44) {
                    if (gain) { const float ss = wave_sum(v * v); v = v * (1.0f / sqrtf(ss * (1.f / 64.f) + EPS)) * gain[lane]; }
                    if (dorope) {
                        const float pr = __shfl_xor(v, 8);
                        if (lane < 16) { const float c = rope[(t * 8 + (lane & 7)) * 2], s = rope[(t * 8 + (lane & 7)) * 2 + 1]; v = lane < 8 ? v * c - pr * s : v * c + pr * s; }
                    }
                    QKV[(size_t)r * QP + dcol + lane] = f2bf(v * scale);
                } else {
                    if (lane < 24) gates[(size_t)r * 24 + lane] = sigmoidf_(v);
                    else if (lane < 32) { const float x = v + p.in[8][lane - 24]; logf_[(size_t)r * 8 + lane - 24] = fminf(x, 0.f) - log1pf(__expf(-fabsf(x))); }
                }
            }
            __syncthreads();
        }
    }
}
__device__ __forceinline__ void ph_compress(const P& p, float* sm, int bid, int nb) {
    float* blk = sm;
    float* hid = sm + 2048;
    const bf16* QKV = (const bf16*)(p.ws + WS_BIG);
    const int tid = threadIdx.x;
    for (int item = bid; item < 16 * 256 * 2; item += nb) {
        const int which = item & 1, n = (item >> 1) & 255, bk = item >> 9, b = bk >> 1, kvh = bk & 1;
        bf16* outp = (bf16*)(p.ws + (which ? WS_VCMP : WS_KCMP)) + ((size_t)bk * 256 + n) * 64;
        if (n == 255) { if (tid < 64) outp[tid] = 0; continue; }
        const float* pos = which ? p.in[14] : p.in[13];
        const float* w1 = which ? p.in[17] : p.in[15];
        const float* w2 = which ? p.in[18] : p.in[16];
        const int col0 = (which ? C_CV : C_CK) + kvh * 64;
        for (int i = tid; i < 2048; i += 256) { const int l = i >> 6, d = i & 63; blk[i] = bf2f(QKV[(size_t)(b * SEQ + 16 * n + l) * QP + col0 + d]) + pos[i]; }
        __syncthreads();
        float acc = 0.f;
        for (int i = 0; i < 2048; ++i) acc += blk[i] * w1[(size_t)i * 256 + tid];
        hid[tid] = siluf_(acc);
        __syncthreads();
        if (tid < 64) {
            float o = 0.f;
            for (int j = 0; j < 256; ++j) o += hid[j] * w2[j * 64 + tid];
            if (!which) { const float ss = wave_sum(o * o); o = o * (1.0f / sqrtf(ss * (1.f / 64.f) + EPS)) * p.in[10][tid]; }
            outp[tid] = f2bf(o);
        }
        __syncthreads();
    }
}
__device__ __forceinline__ void ph_cumsum(const P& p, int bid, int nb) {
    const float* logf_ = (const float*)(p.ws + WS_LOGF);
    float* C = (float*)(p.ws + WS_C);
    const int lane = threadIdx.x & 63, w = threadIdx.x >> 6;
    for (int item = bid * 4 + w; item < BATCH * 8; item += nb * 4) {
        const int b = item >> 3, h = item & 7;
        float carry = 0.f;
        for (int t0 = 0; t0 < SEQ; t0 += 64) {
            float v = logf_[(size_t)(b * SEQ + t0 + lane) * 8 + h];
#pragma unroll
            for (int o = 1; o < 64; o <<= 1) { const float u = __shfl_up(v, o); if (lane >= o) v += u; }
            v += carry;
            C[(size_t)item * SEQ + t0 + lane] = v;
            carry = __shfl(v, 63);
        }
    }
}
__device__ __forceinline__ float dot64(const float* q, const bf16* k) {
    float s = 0.f;
#pragma unroll
    for (int i = 0; i < 8; ++i) {
        const uint4 v = *(const uint4*)(k + 8 * i);
        const unsigned u[4] = {v.x, v.y, v.z, v.w};
#pragma unroll
        for (int j = 0; j < 4; ++j) { s += q[8 * i + 2 * j] * __uint_as_float(u[j] << 16); s += q[8 * i + 2 * j + 1] * __uint_as_float(u[j] & 0xffff0000u); }
    }
    return s;
}
__device__ __forceinline__ void ph_nsa(const P& p, float* sm, int bid, int nb) {
    float* impp = sm;
    float* pl = sm + 256;
    const bf16* QKV = (const bf16*)(p.ws + WS_BIG);
    const bf16* KC = (const bf16*)(p.ws + WS_KCMP);
    const bf16* VC = (const bf16*)(p.ws + WS_VCMP);
    const float* gates = (const float*)(p.ws + WS_GATES);
    bf16* O = (bf16*)(p.ws + WS_O);
    const int lane = threadIdx.x & 63, g = threadIdx.x >> 6;
    float* mypl = pl + g * 1024;
    for (int item = bid; item < M * 2; item += nb) {
        const int kvh = item & 1, m = item >> 1, b = m / SEQ, t = m % SEQ, h = kvh * 4 + g;
        float q[64];
        { const bf16* qp = QKV + (size_t)m * QP + C_QA + h * 64;
#pragma unroll
          for (int i = 0; i < 64; ++i) q[i] = bf2f(qp[i]); }
        const int ncv = t >= 31 ? (t - 31) / 16 + 1 : 0;
        const bf16* kc = KC + (size_t)(b * 2 + kvh) * 256 * 64;
        const bf16* vc = VC + (size_t)(b * 2 + kvh) * 256 * 64;
        float sc[4]; float mx = -1e30f;
#pragma unroll
        for (int i = 0; i < 4; ++i) { const int n = lane + 64 * i; sc[i] = -1e30f; if (n < ncv) { sc[i] = dot64(q, kc + n * 64); mx = fmaxf(mx, sc[i]); } }
        mx = wave_max(mx);
        float sum = 0.f;
#pragma unroll
        for (int i = 0; i < 4; ++i) { const int n = lane + 64 * i; sc[i] = n < ncv ? exp2f(sc[i] - mx) : 0.f; sum += sc[i]; }
        sum = wave_sum(sum);
        const float rs = ncv > 0 ? 1.f / sum : 0.f;
#pragma unroll
        for (int i = 0; i < 4; ++i) mypl[lane + 64 * i] = sc[i] * rs;
        __syncthreads();
        float oc = 0.f;
        for (int n = 0; n < ncv; ++n) oc += mypl[n] * bf2f(vc[n * 64 + lane]);
        { float im = 0.f; const int lo = max(0, 4 * lane - 1), hi = min(254, 4 * lane + 3);
          for (int n = lo; n <= hi; ++n) im += mypl[n];
          impp[g * 64 + lane] = im; }
        __syncthreads();
        const int cur = t >> 6;
        float val = (impp[lane] + impp[64 + lane]) + (impp[128 + lane] + impp[192 + lane]);
        if (lane > cur) val = -1.f; else if (lane == 0 || lane == cur || lane == cur - 1) val = 1e6f;
        int rank = 0;
        for (int i = 0; i < 64; ++i) { const float vi = __shfl(val, i); rank += (vi > val || (vi == val && i < lane)) ? 1 : 0; }
        const unsigned long long selmask = __ballot(rank < 16 && val >= 0.f);
        __syncthreads();
        float os = 0.f;
        {
            const bf16* kb = QKV + (size_t)(b * SEQ) * QP + C_SK + kvh * 64;
            const bf16* vb = QKV + (size_t)(b * SEQ) * QP + C_SV + kvh * 64;
            unsigned long long mk = selmask; int idx = 0; float mx2 = -1e30f;
            while (mk) { const int j = __ffsll((long long)mk) - 1; mk &= mk - 1; const int kp = j * 64 + lane;
                float s = -1e30f; if (kp <= t) { s = dot64(q, kb + (size_t)kp * QP); mx2 = fmaxf(mx2, s); }
                mypl[idx * 64 + lane] = s; ++idx; }
            mx2 = wave_max(mx2);
            float sum2 = 0.f;
            for (int i = 0; i < idx; ++i) { const float s = mypl[i * 64 + lane]; const float e = s > -1e29f ? exp2f(s - mx2) : 0.f; mypl[i * 64 + lane] = e; sum2 += e; }
            sum2 = wave_sum(sum2);
            mk = selmask; idx = 0;
            while (mk) { const int j = __ffsll((long long)mk) - 1; mk &= mk - 1;
                const int nk = min(64, t - j * 64 + 1);
                for (int kk = 0; kk < nk; ++kk) os += mypl[idx * 64 + kk] * bf2f(vb[(size_t)(j * 64 + kk) * QP + lane]);
                ++idx; }
            os /= sum2;
        }
        float ow = 0.f;
        {
            const bf16* kb = QKV + (size_t)(b * SEQ) * QP + C_WK + kvh * 64;
            const bf16* vb = QKV + (size_t)(b * SEQ) * QP + C_WV + kvh * 64;
            const int k0 = max(0, t - 511), nk = t - k0 + 1;
            float mx3 = -1e30f;
            for (int i = 0; i * 64 < nk; ++i) { const int kk = i * 64 + lane; float s = -1e30f; if (kk < nk) { s = dot64(q, kb + (size_t)(k0 + kk) * QP); mx3 = fmaxf(mx3, s); } mypl[kk] = s; }
            mx3 = wave_max(mx3);
            float sum3 = 0.f;
            for (int i = 0; i * 64 < nk; ++i) { const int kk = i * 64 + lane; const float s = mypl[kk]; const float e = kk < nk ? exp2f(s - mx3) : 0.f; mypl[kk] = e; sum3 += e; }
            sum3 = wave_sum(sum3);
            for (int kk = 0; kk < nk; ++kk) ow += mypl[kk] * bf2f(vb[(size_t)(k0 + kk) * QP + lane]);
            ow /= sum3;
        }
        const float* gg = gates + (size_t)m * 24 + h * 3;
        O[(size_t)m * D + h * 64 + lane] = f2bf(gg[0] * oc + gg[1] * os + gg[2] * ow);
        __syncthreads();
    }
}
__device__ __forceinline__ void ph_fox(const P& p, float* sm, int bid, int nb) {
    const bf16* QKV = (const bf16*)(p.ws + WS_BIG);
    const float* C = (const float*)(p.ws + WS_C);
    bf16* O = (bf16*)(p.ws + WS_O);
    const int lane = threadIdx.x & 63, w = threadIdx.x >> 6;
    float* pl = sm + w * 4096;
    for (int it = bid * 4 + w; it < M * 8; it += nb * 4) {
        const int tt = it % SEQ, bh = it / SEQ, b = bh >> 3, h = bh & 7;
        const int t = (tt & 1) ? (SEQ - 1 - (tt >> 1)) : (tt >> 1);
        const int m = b * SEQ + t;
        float q[64];
        { const bf16* qp = QKV + (size_t)m * QP + C_QF + h * 64;
#pragma unroll
          for (int i = 0; i < 64; ++i) q[i] = bf2f(qp[i]); }
        const bf16* kb = QKV + (size_t)(b * SEQ) * QP + C_KF + h * 64;
        const bf16* vb = QKV + (size_t)(b * SEQ) * QP + C_VF + h * 64;
        const float* c = C + (size_t)bh * SEQ;
        const float ct = c[t];
        const int nk = t + 1;
        float mx = -1e30f;
        for (int i = 0; i * 64 < nk; ++i) { const int kk = i * 64 + lane; float s = -1e30f; if (kk < nk) { s = dot64(q, kb + (size_t)kk * QP) + (ct - c[kk]) * LOG2E; mx = fmaxf(mx, s); } pl[kk] = s; }
        mx = wave_max(mx);
        float sum = 0.f;
        for (int i = 0; i * 64 < nk; ++i) { const int kk = i * 64 + lane; const float e = kk < nk ? exp2f(pl[kk] - mx) : 0.f; pl[kk] = e; sum += e; }
        sum = wave_sum(sum);
        float o = 0.f;
        for (int kk = 0; kk < nk; ++kk) o += pl[kk] * bf2f(vb[(size_t)kk * QP + lane]);
        O[(size_t)m * D + 512 + h * 64 + lane] = f2bf(o / sum);
    }
}
__device__ __forceinline__ void ph_groupnorm(const P& p, int bid, int nb) {
    const bf16* O = (const bf16*)(p.ws + WS_O);
    bf16* XN = (bf16*)(p.ws + WS_XN);
    const int lane = threadIdx.x & 63, w = threadIdx.x >> 6;
    for (int it = bid * 4 + w; it < M * 2; it += nb * 4) {
        const int m = it >> 1, grp = it & 1;
        const float* gain = grp ? p.in[22] : p.in[21];
        float v[8]; float s = 0.f;
#pragma unroll
        for (int j = 0; j < 8; ++j) { v[j] = bf2f(O[(size_t)m * D + grp * 512 + lane + 64 * j]); s += v[j] * v[j]; }
        s = wave_sum(s);
        const float rs = 1.0f / sqrtf(s * (1.f / 512.f) + EPS);
#pragma unroll
        for (int j = 0; j < 8; ++j) XN[(size_t)m * D + grp * 512 + lane + 64 * j] = f2bf(v[j] * rs * gain[lane + 64 * j]);
    }
}

constexpr int NPHASE = 20;
__device__ __forceinline__ void run_phase(const P& p, float* sm, int ph, int bid, int nb) {
    bf16* XN = (bf16*)(p.ws + WS_XN);
    bf16* HID = (bf16*)(p.ws + WS_BIG);
    float* E = (float*)(p.ws + WS_BIG);
    switch (ph) {
    case 0: ph_rope(p, bid, nb); ph_rmsnorm(p.in[0], p.in[2], XN, nullptr, bid, nb); break;
    case 1: { GA g{XN, D, false, p.in[3], p.in[4], DFF, DFF, D, 0.f, nullptr, nullptr, HID, nullptr}; ngemm<0>(p, g, sm, bid, nb); } break;
    case 2: { GA g{HID, DFF, false, p.in[5], nullptr, D, D, DFF, 0.5f, p.in[0], p.out, nullptr, nullptr}; ngemm<1>(p, g, sm, bid, nb); } break;
    case 3: ph_rmsnorm(p.out, p.in[6], XN, nullptr, bid, nb); break;
    case 4: { GA g{XN, D, false, p.in[7], nullptr, INW, 45 * 64, D, 0.f, nullptr, nullptr, nullptr, nullptr}; ngemm<4>(p, g, sm, bid, nb); } break;
    case 5: ph_compress(p, sm, bid, nb); ph_cumsum(p, bid, nb); break;
    case 6: ph_nsa(p, sm, bid, nb); break;
    case 7: ph_fox(p, sm, bid, nb); break;
    case 8: ph_groupnorm(p, bid, nb); break;
    case 9: { GA g{XN, D, false, p.in[23], nullptr, D, D, D, 1.f, p.out, p.out, nullptr, nullptr}; ngemm<1>(p, g, sm, bid, nb); } break;
    case 10: ph_rmsnorm(p.out, p.in[24], XN, nullptr, bid, nb); break;
    case 11: { GA g{XN, D, false, p.in[25], p.in[26], DFF, DFF, D, 0.f, nullptr, nullptr, HID, nullptr}; ngemm<0>(p, g, sm, bid, nb); } break;
    case 12: { GA g{HID, DFF, false, p.in[27], nullptr, D, D, DFF, 0.5f, p.out, p.out, nullptr, nullptr}; ngemm<1>(p, g, sm, bid, nb); } break;
    case 13: ph_rmsnorm(p.out, p.in[28], XN, nullptr, bid, nb); break;
    case 14: { GA g{p.in[1], DPLE, true, p.in[30], nullptr, D, D, DPLE, 0.f, nullptr, E, nullptr, nullptr}; ngemm<2>(p, g, sm, bid, nb); } break;
    case 15: ph_rmsnorm(E, p.in[31], nullptr, E, bid, nb); break;
    case 16: { GA g{XN, D, false, p.in[29], nullptr, D, D, D, 0.f, nullptr, p.out, nullptr, E}; ngemm<3>(p, g, sm, bid, nb); } break;
    default: break;
    }
}
constexpr int LAST_PHASE = 16;

__global__ void __launch_bounds__(256) k_phase(P p, int ph) {
    __shared__ float sm[16384];
    run_phase(p, sm, ph, blockIdx.x, gridDim.x);
}
__global__ void __launch_bounds__(256) k_mega(P p) {
    __shared__ float sm[16384];
    cg::grid_group grid = cg::this_grid();
    for (int ph = 0; ph <= LAST_PHASE; ++ph) {
        run_phase(p, sm, ph, blockIdx.x, gridDim.x);
        if (ph < LAST_PHASE) grid.sync();
    }
}

extern "C" void kernel_launch(void* const* d_in, const int* in_sizes, int n_in, void* d_out, int out_size, void* d_ws, size_t ws_size, hipStream_t stream) {
    if (n_in != 32 || out_size != M * D || ws_size < WS_END) { fprintf(stderr, "kernel_launch: unexpected sizes n_in %d out %d ws %zu\n", n_in, out_size, ws_size); return; }
    P p{};
    for (int i = 0; i < 32; ++i) p.in[i] = (const float*)d_in[i];
    p.out = (float*)d_out; p.ws = (unsigned char*)d_ws;
#if ONE_LAUNCH
    static int grid = 0;
    if (!grid) {
        int dev = 0, cus = 0, per_cu = 0;
        hipGetDevice(&dev);
        hipDeviceGetAttribute(&cus, hipDeviceAttributeMultiprocessorCount, dev);
        hipOccupancyMaxActiveBlocksPerMultiprocessor(&per_cu, k_mega, 256, 0);
        if (per_cu > 2) per_cu = 2;
        grid = cus * per_cu;
    }
    void* args[] = {&p};
    hipError_t e = hipLaunchCooperativeKernel((void*)k_mega, dim3(grid), dim3(256), args, 0, stream);
    if (e != hipSuccess) fprintf(stderr, "cooperative launch failed: %s (grid %d)\n", hipGetErrorString(e), grid);
#else
    for (int ph = 0; ph <= LAST_PHASE; ++ph) hipLaunchKernelGGL(k_phase, dim3(2048), dim3(256), 0, stream, p, ph);
#endif
}
```

```cpp
#include <hip/hip_runtime.h>
#include <hip/hip_cooperative_groups.h>
#include <cstdint>
#include <cstdio>
namespace cg = cooperative_groups;

typedef unsigned short bf16;
constexpr int BATCH = 8, SEQ = 4096, M = BATCH * SEQ, D = 1024, DFF = 2816, INW = 2848, DPLE = 256;
constexpr int QP = 2816;
constexpr float EPS = 1e-6f;
constexpr float C2 = 0.125f * 1.4426950408889634f;
constexpr float LOG2E = 1.4426950408889634f;
constexpr int C_QA = 0, C_CK = 512, C_CV = 640, C_SK = 768, C_SV = 896, C_WK = 1024, C_WV = 1152, C_QF = 1280, C_KF = 1792, C_VF = 2304;

constexpr size_t MiB = 1u << 20;
constexpr size_t WS_CTL = 0;
constexpr size_t WS_WGU1 = 2 * MiB, WS_WD1 = 13 * MiB, WS_WIN = 19 * MiB, WS_WOUT = 25 * MiB, WS_WGU2 = 27 * MiB, WS_WD2 = 38 * MiB, WS_WGATE = 44 * MiB, WS_WPROJ = 46 * MiB;
constexpr size_t WS_KCMP = 50 * MiB, WS_VCMP = 51 * MiB, WS_C = 52 * MiB, WS_GATES = 53 * MiB, WS_LOGF = 56 * MiB, WS_ROPE = 57 * MiB;
constexpr size_t WS_SSQ1 = 58 * MiB, WS_SSQ2 = 60 * MiB, WS_SSQ3 = 62 * MiB, WS_SSQE = 64 * MiB, WS_SEL = 66 * MiB;
constexpr size_t WS_PB = 70 * MiB;
constexpr size_t WS_XN = 88 * MiB;
constexpr size_t WS_O = 152 * MiB;
constexpr size_t WS_BIG = 216 * MiB;
constexpr size_t WS_E = 408 * MiB;
constexpr size_t WS_END = 472 * MiB;

struct P {
    const float* in[32];
    float* out;
    unsigned char* ws;
};

__device__ __forceinline__ float bf2f(bf16 v) { return __uint_as_float((unsigned)v << 16); }
__device__ __forceinline__ bf16 f2bf(float f) { unsigned u = __float_as_uint(f); return (bf16)((u + 0x7fffu + ((u >> 16) & 1u)) >> 16); }
__device__ __forceinline__ float wave_sum(float v) {
#pragma unroll
    for (int o = 1; o < 64; o <<= 1) v += __shfl_xor(v, o);
    return v;
}
__device__ __forceinline__ float wave_max(float v) {
#pragma unroll
    for (int o = 1; o < 64; o <<= 1) v = fmaxf(v, __shfl_xor(v, o));
    return v;
}
__device__ __forceinline__ float sigmoidf_(float x) { return 1.f / (1.f + __expf(-x)); }
__device__ __forceinline__ float siluf_(float x) { return x / (1.f + __expf(-x)); }

__device__ __forceinline__ void ph_rope(const P& p, int bid, int nb) {
    float* rope = (float*)(p.ws + WS_ROPE);
    for (int i = bid * 256 + threadIdx.x; i < SEQ * 8; i += nb * 256) {
        const int t = i >> 3, f = i & 7;
        const double inv = pow(500000.0, -(double)f / 8.0);
        const double ang = (double)t * inv;
        rope[t * 16 + f] = (float)cos(ang); rope[t * 16 + 8 + f] = (float)sin(ang);
    }
}
__device__ __forceinline__ void ph_rmsnorm(const float* in, const float* gain, bf16* outb, float* outf, int bid, int nb) {
    const int lane = threadIdx.x & 63, w = threadIdx.x >> 6;
    for (int r = bid * 4 + w; r < M; r += nb * 4) {
        const float* x = in + (size_t)r * D;
        float v[16]; float s = 0.f;
#pragma unroll
        for (int j = 0; j < 16; ++j) { v[j] = x[lane + 64 * j]; s += v[j] * v[j]; }
        s = wave_sum(s);
        const float rs = 1.0f / sqrtf(s * (1.f / D) + EPS);
#pragma unroll
        for (int j = 0; j < 16; ++j) {
            const float y = v[j] * rs * gain[lane + 64 * j];
            if (outb) outb[(size_t)r * D + lane + 64 * j] = f2bf(y);
            else outf[(size_t)r * D + lane + 64 * j] = y;
        }
    }
}
struct GA { const void* A; int lda; bool a_f32; const float* B0; const float* B1; int ldb; int N, K; float alpha; const float* res; float* outf; bf16* outb; const float* E; };

__device__ __forceinline__ int win_srccol(int tn, int c) {
    if (tn < 20) return tn * 64 + c;
    if (tn < 44) return 1304 + (tn - 20) * 64 + c;
    if (c < 24) return 1280 + c;
    if (c < 32) return 2840 + (c - 24);
    return -1;
}

template <int MODE> __device__ __forceinline__ void ngemm(const P& p, const GA& g, float* sm, int bid, int nb) {
    float* As = sm;
    float* Bs0 = sm + 16 * 68;
    float* Bs1 = Bs0 + 16 * 64;
    float* T = Bs1 + 16 * 64;
    const int tid = threadIdx.x, ty = tid >> 4, tx = tid & 15, lane = tid & 63, w = tid >> 6;
    const int ntn = (g.N + 63) / 64, ntm = M / 64, ntiles = ntn * ntm;
    for (int tile = bid; tile < ntiles; tile += nb) {
        const int tm = tile / ntn, tn = tile % ntn;
        float acc0[4][4], acc1[4][4];
#pragma unroll
        for (int i = 0; i < 4; ++i)
#pragma unroll
            for (int j = 0; j < 4; ++j) { acc0[i][j] = 0.f; acc1[i][j] = 0.f; }
        for (int k0 = 0; k0 < g.K; k0 += 16) {
            {
                const int r = tid >> 2, kq = (tid & 3) * 4;
                float a[4];
                if (g.a_f32) { const float* ap = (const float*)g.A + (size_t)(tm * 64 + r) * g.lda + k0 + kq; a[0] = ap[0]; a[1] = ap[1]; a[2] = ap[2]; a[3] = ap[3]; }
                else { const bf16* ap = (const bf16*)g.A + (size_t)(tm * 64 + r) * g.lda + k0 + kq; a[0] = bf2f(ap[0]); a[1] = bf2f(ap[1]); a[2] = bf2f(ap[2]); a[3] = bf2f(ap[3]); }
#pragma unroll
                for (int i = 0; i < 4; ++i) As[(kq + i) * 68 + r] = a[i];
            }
            {
                const int k = tid >> 4, c4 = (tid & 15) * 4;
#pragma unroll
                for (int i = 0; i < 4; ++i) {
                    int sc = tn * 64 + c4 + i;
                    if (MODE == 4) sc = win_srccol(tn, c4 + i);
                    else if (sc >= g.N) sc = -1;
                    Bs0[k * 64 + c4 + i] = sc >= 0 ? g.B0[(size_t)(k0 + k) * g.ldb + sc] : 0.f;
                    if (MODE == 0) Bs1[k * 64 + c4 + i] = sc >= 0 ? g.B1[(size_t)(k0 + k) * g.ldb + sc] : 0.f;
                }
            }
            __syncthreads();
#pragma unroll
            for (int kk = 0; kk < 16; ++kk) {
                float a[4], b[4], b1[4];
#pragma unroll
                for (int i = 0; i < 4; ++i) { a[i] = As[kk * 68 + ty * 4 + i]; b[i] = Bs0[kk * 64 + tx * 4 + i]; if (MODE == 0) b1[i] = Bs1[kk * 64 + tx * 4 + i]; }
#pragma unroll
                for (int i = 0; i < 4; ++i)
#pragma unroll
                    for (int j = 0; j < 4; ++j) { acc0[i][j] += a[i] * b[j]; if (MODE == 0) acc1[i][j] += a[i] * b1[j]; }
            }
            __syncthreads();
        }
        if (MODE != 4) {
#pragma unroll
            for (int i = 0; i < 4; ++i)
#pragma unroll
                for (int j = 0; j < 4; ++j) {
                    const int r = tm * 64 + ty * 4 + i, c = tn * 64 + tx * 4 + j;
                    if (c < g.N) {
                        if (MODE == 0) g.outb[(size_t)r * g.N + c] = f2bf(siluf_(acc0[i][j]) * acc1[i][j]);
                        if (MODE == 1) g.outf[(size_t)r * D + c] = g.res[(size_t)r * D + c] + g.alpha * acc0[i][j];
                        if (MODE == 2) g.outf[(size_t)r * g.N + c] = acc0[i][j];
                        if (MODE == 3) g.outf[(size_t)r * D + c] = g.outf[(size_t)r * D + c] + sigmoidf_(acc0[i][j]) * g.E[(size_t)r * D + c];
                    }
                }
        } else {
#pragma unroll
            for (int i = 0; i < 4; ++i)
#pragma unroll
                for (int j = 0; j < 4; ++j) T[(ty * 4 + i) * 65 + tx * 4 + j] = acc0[i][j];
            __syncthreads();
            bf16* QKV = (bf16*)(p.ws + WS_BIG);
            float* gates = (float*)(p.ws + WS_GATES);
            float* logf_ = (float*)(p.ws + WS_LOGF);
            const float* rope = (const float*)(p.ws + WS_ROPE);
            const float* gain = nullptr; bool dorope = false; float scale = 1.f; int dcol = tn * 64;
            if (tn < 8) { gain = p.in[9]; dorope = true; scale = C2; }
            else if (tn < 10) { dorope = true; }
            else if (tn < 12) {}
            else if (tn < 14) { gain = p.in[11]; dorope = true; }
            else if (tn < 16) {}
            else if (tn < 18) { gain = p.in[12]; dorope = true; }
            else if (tn < 20) {}
            else if (tn < 28) { gain = p.in[19]; scale = C2; }
            else if (tn < 36) { gain = p.in[20]; }
            for (int rr = 0; rr < 16; ++rr) {
                const int rl = w * 16 + rr, r = tm * 64 + rl, t = r & (SEQ - 1);
                float v = T[rl * 65 + lane];
                if (tn < 44) {
                    if (gain) { const float ss = wave_sum(v * v); v = v * (1.0f / sqrtf(ss * (1.f / 64.f) + EPS)) * gain[lane]; }
                    if (dorope) {
                        const float pr = __shfl_xor(v, 8);
                        if (lane < 16) { const float c = rope[t * 16 + (lane & 7)], s = rope[t * 16 + 8 + (lane & 7)]; v = lane < 8 ? v * c - pr * s : v * c + pr * s; }
                    }
                    QKV[(size_t)r * QP + dcol + lane] = f2bf(v * scale);
                } else {
                    if (lane < 24) gates[(size_t)r * 24 + lane] = sigmoidf_(v);
                    else if (lane < 32) { const float x = v + p.in[8][lane - 24]; logf_[(size_t)r * 8 + lane - 24] = fminf(x, 0.f) - log1pf(__expf(-fabsf(x))); }
                }
            }
            __syncthreads();
        }
    }
}
__device__ __forceinline__ void ph_compress(const P& p, float* sm, int bid, int nb) {
    float* blk = sm;
    float* hid = sm + 2048;
    const bf16* QKV = (const bf16*)(p.ws + WS_BIG);
    const int tid = threadIdx.x;
    for (int item = bid; item < 16 * 256 * 2; item += nb) {
        const int which = item & 1, n = (item >> 1) & 255, bk = item >> 9, b = bk >> 1, kvh = bk & 1;
        bf16* outp = (bf16*)(p.ws + (which ? WS_VCMP : WS_KCMP)) + ((size_t)bk * 256 + n) * 64;
        if (n == 255) { if (tid < 64) outp[tid] = 0; continue; }
        const float* pos = which ? p.in[14] : p.in[13];
        const float* w1 = which ? p.in[17] : p.in[15];
        const float* w2 = which ? p.in[18] : p.in[16];
        const int col0 = (which ? C_CV : C_CK) + kvh * 64;
        for (int i = tid; i < 2048; i += 256) { const int l = i >> 6, d = i & 63; blk[i] = bf2f(QKV[(size_t)(b * SEQ + 16 * n + l) * QP + col0 + d]) + pos[i]; }
        __syncthreads();
        float acc = 0.f;
        for (int i = 0; i < 2048; ++i) acc += blk[i] * w1[(size_t)i * 256 + tid];
        hid[tid] = siluf_(acc);
        __syncthreads();
        if (tid < 64) {
            float o = 0.f;
            for (int j = 0; j < 256; ++j) o += hid[j] * w2[j * 64 + tid];
            if (!which) { const float ss = wave_sum(o * o); o = o * (1.0f / sqrtf(ss * (1.f / 64.f) + EPS)) * p.in[10][tid]; }
            outp[tid] = f2bf(o);
        }
        __syncthreads();
    }
}
__device__ __forceinline__ void ph_cumsum(const P& p, int bid, int nb) {
    const float* logf_ = (const float*)(p.ws + WS_LOGF);
    float* C = (float*)(p.ws + WS_C);
    const int lane = threadIdx.x & 63, w = threadIdx.x >> 6;
    for (int item = bid * 4 + w; item < BATCH * 8; item += nb * 4) {
        const int b = item >> 3, h = item & 7;
        float carry = 0.f;
        for (int t0 = 0; t0 < SEQ; t0 += 64) {
            float v = logf_[(size_t)(b * SEQ + t0 + lane) * 8 + h];
#pragma unroll
            for (int o = 1; o < 64; o <<= 1) { const float u = __shfl_up(v, o); if (lane >= o) v += u; }
            v += carry;
            C[(size_t)item * SEQ + t0 + lane] = v;
            carry = __shfl(v, 63);
        }
    }
}
__device__ __forceinline__ float dot64(const float* q, const bf16* k) {
    float s = 0.f;
#pragma unroll
    for (int i = 0; i < 8; ++i) {
        const uint4 v = *(const uint4*)(k + 8 * i);
        const unsigned u[4] = {v.x, v.y, v.z, v.w};
#pragma unroll
        for (int j = 0; j < 4; ++j) { s += q[8 * i + 2 * j] * __uint_as_float(u[j] << 16); s += q[8 * i + 2 * j + 1] * __uint_as_float(u[j] & 0xffff0000u); }
    }
    return s;
}
__device__ __forceinline__ void ph_nsa(const P& p, float* sm, int bid, int nb) {
    float* impp = sm;
    float* pl = sm + 256;
    const bf16* QKV = (const bf16*)(p.ws + WS_BIG);
    const bf16* KC = (const bf16*)(p.ws + WS_KCMP);
    const bf16* VC = (const bf16*)(p.ws + WS_VCMP);
    const float* gates = (const float*)(p.ws + WS_GATES);
    bf16* O = (bf16*)(p.ws + WS_O);
    const int lane = threadIdx.x & 63, g = threadIdx.x >> 6;
    float* mypl = pl + g * 1024;
    for (int item = bid; item < M * 2; item += nb) {
        const int kvh = item & 1, m = item >> 1, b = m / SEQ, t = m % SEQ, h = kvh * 4 + g;
        float q[64];
        { const bf16* qp = QKV + (size_t)m * QP + C_QA + h * 64;
#pragma unroll
          for (int i = 0; i < 64; ++i) q[i] = bf2f(qp[i]); }
        const int ncv = t >= 31 ? (t - 31) / 16 + 1 : 0;
        const bf16* kc = KC + (size_t)(b * 2 + kvh) * 256 * 64;
        const bf16* vc = VC + (size_t)(b * 2 + kvh) * 256 * 64;
        float sc[4]; float mx = -1e30f;
#pragma unroll
        for (int i = 0; i < 4; ++i) { const int n = lane + 64 * i; sc[i] = -1e30f; if (n < ncv) { sc[i] = dot64(q, kc + n * 64); mx = fmaxf(mx, sc[i]); } }
        mx = wave_max(mx);
        float sum = 0.f;
#pragma unroll
        for (int i = 0; i < 4; ++i) { const int n = lane + 64 * i; sc[i] = n < ncv ? exp2f(sc[i] - mx) : 0.f; sum += sc[i]; }
        sum = wave_sum(sum);
        const float rs = ncv > 0 ? 1.f / sum : 0.f;
#pragma unroll
        for (int i = 0; i < 4; ++i) mypl[lane + 64 * i] = sc[i] * rs;
        __syncthreads();
        float oc = 0.f;
        for (int n = 0; n < ncv; ++n) oc += mypl[n] * bf2f(vc[n * 64 + lane]);
        { float im = 0.f; const int lo = max(0, 4 * lane - 1), hi = min(254, 4 * lane + 3);
          for (int n = lo; n <= hi; ++n) im += mypl[n];
          impp[g * 64 + lane] = im; }
        __syncthreads();
        const int cur = t >> 6;
        float val = (impp[lane] + impp[64 + lane]) + (impp[128 + lane] + impp[192 + lane]);
        if (lane > cur) val = -1.f; else if (lane == 0 || lane == cur || lane == cur - 1) val = 1e6f;
        int rank = 0;
        for (int i = 0; i < 64; ++i) { const float vi = __shfl(val, i); rank += (vi > val || (vi == val && i < lane)) ? 1 : 0; }
        const unsigned long long selmask = __ballot(rank < 16 && val >= 0.f);
        __syncthreads();
        float os = 0.f;
        {
            const bf16* kb = QKV + (size_t)(b * SEQ) * QP + C_SK + kvh * 64;
            const bf16* vb = QKV + (size_t)(b * SEQ) * QP + C_SV + kvh * 64;
            unsigned long long mk = selmask; int idx = 0; float mx2 = -1e30f;
            while (mk) { const int j = __ffsll((long long)mk) - 1; mk &= mk - 1; const int kp = j * 64 + lane;
                float s = -1e30f; if (kp <= t) { s = dot64(q, kb + (size_t)kp * QP); mx2 = fmaxf(mx2, s); }
                mypl[idx * 64 + lane] = s; ++idx; }
            mx2 = wave_max(mx2);
            float sum2 = 0.f;
            for (int i = 0; i < idx; ++i) { const float s = mypl[i * 64 + lane]; const float e = s > -1e29f ? exp2f(s - mx2) : 0.f; mypl[i * 64 + lane] = e; sum2 += e; }
            sum2 = wave_sum(sum2);
            mk = selmask; idx = 0;
            while (mk) { const int j = __ffsll((long long)mk) - 1; mk &= mk - 1;
                const int nk = min(64, t - j * 64 + 1);
                for (int kk = 0; kk < nk; ++kk) os += mypl[idx * 64 + kk] * bf2f(vb[(size_t)(j * 64 + kk) * QP + lane]);
                ++idx; }
            os /= sum2;
        }
        float ow = 0.f;
        {
            const bf16* kb = QKV + (size_t)(b * SEQ) * QP + C_WK + kvh * 64;
            const bf16* vb = QKV + (size_t)(b * SEQ) * QP + C_WV + kvh * 64;
            const int k0 = max(0, t - 511), nk = t - k0 + 1;
            float mx3 = -1e30f;
            for (int i = 0; i * 64 < nk; ++i) { const int kk = i * 64 + lane; float s = -1e30f; if (kk < nk) { s = dot64(q, kb + (size_t)(k0 + kk) * QP); mx3 = fmaxf(mx3, s); } mypl[kk] = s; }
            mx3 = wave_max(mx3);
            float sum3 = 0.f;
            for (int i = 0; i * 64 < nk; ++i) { const int kk = i * 64 + lane; const float s = mypl[kk]; const float e = kk < nk ? exp2f(s - mx3) : 0.f; mypl[kk] = e; sum3 += e; }
            sum3 = wave_sum(sum3);
            for (int kk = 0; kk < nk; ++kk) ow += mypl[kk] * bf2f(vb[(size_t)(k0 + kk) * QP + lane]);
            ow /= sum3;
        }
        const float* gg = gates + (size_t)m * 24 + h * 3;
        O[(size_t)m * D + h * 64 + lane] = f2bf(gg[0] * oc + gg[1] * os + gg[2] * ow);
        __syncthreads();
    }
}
__device__ __forceinline__ void ph_fox(const P& p, float* sm, int bid, int nb) {
    const bf16* QKV = (const bf16*)(p.ws + WS_BIG);
    const float* C = (const float*)(p.ws + WS_C);
    bf16* O = (bf16*)(p.ws + WS_O);
    const int lane = threadIdx.x & 63, w = threadIdx.x >> 6;
    float* pl = sm + w * 4096;
    for (int it = bid * 4 + w; it < M * 8; it += nb * 4) {
        const int tt = it % SEQ, bh = it / SEQ, b = bh >> 3, h = bh & 7;
        const int t = (tt & 1) ? (SEQ - 1 - (tt >> 1)) : (tt >> 1);
        const int m = b * SEQ + t;
        float q[64];
        { const bf16* qp = QKV + (size_t)m * QP + C_QF + h * 64;
#pragma unroll
          for (int i = 0; i < 64; ++i) q[i] = bf2f(qp[i]); }
        const bf16* kb = QKV + (size_t)(b * SEQ) * QP + C_KF + h * 64;
        const bf16* vb = QKV + (size_t)(b * SEQ) * QP + C_VF + h * 64;
        const float* c = C + (size_t)bh * SEQ;
        const float ct = c[t];
        const int nk = t + 1;
        float mx = -1e30f;
        for (int i = 0; i * 64 < nk; ++i) { const int kk = i * 64 + lane; float s = -1e30f; if (kk < nk) { s = dot64(q, kb + (size_t)kk * QP) + (ct - c[kk]) * LOG2E; mx = fmaxf(mx, s); } pl[kk] = s; }
        mx = wave_max(mx);
        float sum = 0.f;
        for (int i = 0; i * 64 < nk; ++i) { const int kk = i * 64 + lane; const float e = kk < nk ? exp2f(pl[kk] - mx) : 0.f; pl[kk] = e; sum += e; }
        sum = wave_sum(sum);
        float o = 0.f;
        for (int kk = 0; kk < nk; ++kk) o += pl[kk] * bf2f(vb[(size_t)kk * QP + lane]);
        O[(size_t)m * D + 512 + h * 64 + lane] = f2bf(o / sum);
    }
}
__device__ __forceinline__ void ph_groupnorm(const P& p, int bid, int nb) {
    const bf16* O = (const bf16*)(p.ws + WS_O);
    bf16* XN = (bf16*)(p.ws + WS_XN);
    const int lane = threadIdx.x & 63, w = threadIdx.x >> 6;
    for (int it = bid * 4 + w; it < M * 2; it += nb * 4) {
        const int m = it >> 1, grp = it & 1;
        const float* gain = grp ? p.in[22] : p.in[21];
        float v[8]; float s = 0.f;
#pragma unroll
        for (int j = 0; j < 8; ++j) { v[j] = bf2f(O[(size_t)m * D + grp * 512 + lane + 64 * j]); s += v[j] * v[j]; }
        s = wave_sum(s);
        const float rs = 1.0f / sqrtf(s * (1.f / 512.f) + EPS);
#pragma unroll
        for (int j = 0; j < 8; ++j) XN[(size_t)m * D + grp * 512 + lane + 64 * j] = f2bf(v[j] * rs * gain[lane + 64 * j]);
    }
}

namespace pg8 {
#define PG8_LAS __attribute__((address_space(3)))
typedef unsigned short bf16_t;
typedef short bf16x8 __attribute__((ext_vector_type(8)));
typedef float f32x4 __attribute__((ext_vector_type(4)));
typedef unsigned u32x4 __attribute__((ext_vector_type(4)));
constexpr int BM = 256, BK = 64, HALF = 128, HTB = HALF * BK * 2  , STAGE_BYTES = 8 * HTB, NXCD = 8, WGM = 8;

__host__ __device__ __forceinline__ int lds_byte(int r, int c) { const int st = (r >> 4) * 2 + (c >> 5), rr = r & 15, cc = c & 31, ob = rr * 64 + cc * 2; return st * 1024 + (ob ^ (((ob >> 9) & 1) << 5)); }
__host__ __device__ __forceinline__ void stage_rc(int b, int& R, int& C) { const int st = b / 1024, sb = b % 1024, swz = sb ^ (((sb >> 9) & 1) << 5); R = (st >> 1) * 16 + swz / 64; C = (st & 1) * 32 + (swz % 64) / 2; }
__host__ __device__ __forceinline__ int perm32(int rho) { const int n = rho >> 4, i = rho & 15; return 8 * (i >> 2) + 4 * n + (i & 3); }

struct Unit { int pm, pn; };
struct Gemm { const bf16_t* A; const bf16_t* Bt; int M, N, K; };

struct StaticOrder {
    int nM, nN, nwg, G, c;
    __host__ __device__ void init(int M, int N, int G_, int c_) { nM = M / BM; nN = N / BM; nwg = nM * nN; G = G_; c = c_; }
    __host__ __device__ bool next(int i, Unit& u) const {
        const long L = (long)i * G + c; if (L >= nwg) return false;
        int wgid = (int)L; { const int q = nwg / NXCD, r = nwg % NXCD, xcd = wgid % NXCD, off = wgid / NXCD; wgid = (xcd < r ? xcd * (q + 1) : r * (q + 1) + (xcd - r) * q) + off; }
        const int nig = WGM * nN, gid = wgid / nig, fm = gid * WGM, gsz = (nM - fm) < WGM ? (nM - fm) : WGM;
        u.pm = fm + ((wgid % nig) % gsz); u.pn = (wgid % nig) / gsz; return true;
    }
    __device__ __forceinline__ void a_ready(const Unit&) const {}
    __device__ __forceinline__ void done(const Unit&) const {}
};

__device__ __forceinline__ unsigned cvt_pk_bf16(float lo, float hi) { unsigned r; asm volatile("v_cvt_pk_bf16_f32 %0, %1, %2" : "=v"(r) : "v"(lo), "v"(hi)); return r; }
__device__ __forceinline__ float hsum4(const f32x4 a) { return (a[0] + a[1]) + (a[2] + a[3]); }
__device__ __forceinline__ float rstd16(const float* ssq, int row, float invn) {
    const f32x4* s = (const f32x4*)(ssq + (size_t)row * 16);
    const float t = (hsum4(s[0]) + hsum4(s[1])) + (hsum4(s[2]) + hsum4(s[3]));
    return 1.0f / sqrtf(t * invn + 1e-6f);
}
__device__ __forceinline__ f32x4 sigmoid4(const f32x4 x) { f32x4 r;
#pragma unroll
    for (int e = 0; e < 4; ++e) r[e] = __builtin_amdgcn_rcpf(1.0f + __builtin_amdgcn_exp2f(-1.4426950408889634f * x[e]));
    return r; }
__device__ __forceinline__ u32x4 pack8(const f32x4 a, const f32x4 b) { u32x4 w; w.x = cvt_pk_bf16(a[0], a[1]); w.y = cvt_pk_bf16(a[2], a[3]); w.z = cvt_pk_bf16(b[0], b[1]); w.w = cvt_pk_bf16(b[2], b[3]); return w; }
__device__ __forceinline__ void unpack8(const u32x4 w, f32x4& a, f32x4& b) {
    a[0] = __uint_as_float(w.x << 16); a[1] = __uint_as_float(w.x & 0xffff0000u); a[2] = __uint_as_float(w.y << 16); a[3] = __uint_as_float(w.y & 0xffff0000u);
    b[0] = __uint_as_float(w.z << 16); b[1] = __uint_as_float(w.z & 0xffff0000u); b[2] = __uint_as_float(w.w << 16); b[3] = __uint_as_float(w.w & 0xffff0000u); }

struct EpiSwiglu {
    static constexpr bool PERM = true, AFTER_DRAIN = false;
    bf16_t* H; const float* ssq;
    __device__ __forceinline__ void operator()(const f32x4 (&acc)[2][2][4][2], const Unit& u, int wr, int wc, int fr, int fq) const {
        const int row0 = u.pm * BM + wr * 64 + fr, col0 = u.pn * 128 + wc * 32 + 8 * fq;
#pragma unroll
        for (int ai = 0; ai < 2; ++ai)
#pragma unroll
            for (int m = 0; m < 4; ++m) { const int row = row0 + ai * HALF + m * 16; const float r = ssq ? rstd16(ssq, row, 1.f / 1024.f) : 1.f;
                const f32x4 g0 = acc[ai][0][m][0] * r, g1 = acc[ai][0][m][1] * r, u0 = acc[ai][1][m][0] * r, u1 = acc[ai][1][m][1] * r;
                *(u32x4*)(H + (size_t)row * 2816 + col0) = pack8(g0 * sigmoid4(g0) * u0, g1 * sigmoid4(g1) * u1); }
    }
};
struct EpiResid {
    static constexpr bool PERM = true, AFTER_DRAIN = false;
    const float* res; float* out; bf16_t* xb; float* ssq; float alpha;
    __device__ __forceinline__ void operator()(const f32x4 (&acc)[2][2][4][2], const Unit& u, int wr, int wc, int fr, int fq) const {
        const int row0 = u.pm * BM + wr * 64 + fr, col0 = u.pn * BM + wc * 32 + 8 * fq;
#pragma unroll
        for (int ai = 0; ai < 2; ++ai)
#pragma unroll
            for (int m = 0; m < 4; ++m) { const int row = row0 + ai * HALF + m * 16; float ss = 0.f;
#pragma unroll
                for (int bj = 0; bj < 2; ++bj) { const size_t off = (size_t)row * 1024 + col0 + bj * HALF;
                    const f32x4 o0 = *(const f32x4*)(res + off) + alpha * acc[ai][bj][m][0], o1 = *(const f32x4*)(res + off + 4) + alpha * acc[ai][bj][m][1];
                    *(f32x4*)(out + off) = o0; *(f32x4*)(out + off + 4) = o1; *(u32x4*)(xb + off) = pack8(o0, o1);
                    ss += hsum4(o0 * o0) + hsum4(o1 * o1); }
                ss += __shfl_xor(ss, 16); ss += __shfl_xor(ss, 32);
                if (fq == 0) ssq[(size_t)row * 16 + u.pn * 4 + wc] = ss;
                asm volatile("" ::: "memory"); }
    }
};
struct EpiE {
    static constexpr bool PERM = true, AFTER_DRAIN = false;
    bf16_t* E; float* ssq;
    __device__ __forceinline__ void operator()(const f32x4 (&acc)[2][2][4][2], const Unit& u, int wr, int wc, int fr, int fq) const {
        const int row0 = u.pm * BM + wr * 64 + fr, col0 = u.pn * BM + wc * 32 + 8 * fq;
#pragma unroll
        for (int ai = 0; ai < 2; ++ai)
#pragma unroll
            for (int m = 0; m < 4; ++m) { const int row = row0 + ai * HALF + m * 16; float ss = 0.f;
#pragma unroll
                for (int bj = 0; bj < 2; ++bj) { const size_t off = (size_t)row * 1024 + col0 + bj * HALF; const f32x4 o0 = acc[ai][bj][m][0], o1 = acc[ai][bj][m][1];
                    *(u32x4*)(E + off) = pack8(o0, o1); ss += hsum4(o0 * o0) + hsum4(o1 * o1); }
                ss += __shfl_xor(ss, 16); ss += __shfl_xor(ss, 32);
                if (fq == 0) ssq[(size_t)row * 16 + u.pn * 4 + wc] = ss; }
    }
};
struct EpiPle {
    static constexpr bool PERM = true, AFTER_DRAIN = false;
    float* out; const bf16_t* E; const float* ssq3; const float* ssqe; const float* ge;
    __device__ __forceinline__ void operator()(const f32x4 (&acc)[2][2][4][2], const Unit& u, int wr, int wc, int fr, int fq) const {
        const int row0 = u.pm * BM + wr * 64 + fr, col0 = u.pn * BM + wc * 32 + 8 * fq;
        f32x4 gv[2][2];
#pragma unroll
        for (int bj = 0; bj < 2; ++bj) { gv[bj][0] = *(const f32x4*)(ge + col0 + bj * HALF); gv[bj][1] = *(const f32x4*)(ge + col0 + bj * HALF + 4); }
#pragma unroll
        for (int ai = 0; ai < 2; ++ai)
#pragma unroll
            for (int m = 0; m < 4; ++m) { const int row = row0 + ai * HALF + m * 16; const float r3 = rstd16(ssq3, row, 1.f / 1024.f), re = rstd16(ssqe, row, 1.f / 1024.f);
#pragma unroll
                for (int bj = 0; bj < 2; ++bj) { const size_t off = (size_t)row * 1024 + col0 + bj * HALF;
                    f32x4 e0, e1; unpack8(*(const u32x4*)(E + off), e0, e1);
                    const f32x4 o0 = *(const f32x4*)(out + off) + sigmoid4(acc[ai][bj][m][0] * r3) * (e0 * re * gv[bj][0]);
                    const f32x4 o1 = *(const f32x4*)(out + off + 4) + sigmoid4(acc[ai][bj][m][1] * r3) * (e1 * re * gv[bj][1]);
                    *(f32x4*)(out + off) = o0; *(f32x4*)(out + off + 4) = o1; }
                asm volatile("" ::: "memory"); }
    }
};
struct EpiQKV {
    static constexpr bool PERM = true, AFTER_DRAIN = false;
    bf16_t* QKV; float* gates; float* logf; const float* ssq1; const float* rope; const float* gq_nsa; const float* gk_slc; const float* gk_win; const float* gq_fox; const float* gk_fox; const float* bforget;
    __device__ __forceinline__ void operator()(const f32x4 (&acc)[2][2][4][2], const Unit& u, int wr, int wc, int fr, int fq) const {
        const int row0 = u.pm * BM + wr * 64 + fr;
        if (u.pn == 11) {
            if (wc != 0) return;
            f32x4 bf0 = *(const f32x4*)(bforget), bf1 = *(const f32x4*)(bforget + 4);
#pragma unroll
            for (int ai = 0; ai < 2; ++ai)
#pragma unroll
                for (int m = 0; m < 4; ++m) { const int row = row0 + ai * HALF + m * 16; const float r1 = rstd16(ssq1, row, 1.f / 1024.f);
                    const f32x4 v0 = acc[ai][0][m][0] * r1, v1 = acc[ai][0][m][1] * r1;
                    if (fq < 3) { *(f32x4*)(gates + (size_t)row * 24 + 8 * fq) = sigmoid4(v0); *(f32x4*)(gates + (size_t)row * 24 + 8 * fq + 4) = sigmoid4(v1); }
                    else { f32x4 x0 = v0 + bf0, x1 = v1 + bf1, l0, l1;
#pragma unroll
                        for (int e = 0; e < 4; ++e) { l0[e] = fminf(x0[e], 0.f) - log1pf(__expf(-fabsf(x0[e]))); l1[e] = fminf(x1[e], 0.f) - log1pf(__expf(-fabsf(x1[e]))); }
                        *(f32x4*)(logf + (size_t)row * 8) = l0; *(f32x4*)(logf + (size_t)row * 8 + 4) = l1; } }
            return;
        }
        const int c0 = u.pn * 256 + wc * 64;
        const float* gain = nullptr; bool dorope = false; float scale = 1.f;
        if (c0 < 512) { gain = gq_nsa; dorope = true; scale = 0.125f * 1.4426950408889634f; }
        else if (c0 < 640) { dorope = true; }
        else if (c0 < 768) {}
        else if (c0 < 896) { gain = gk_slc; dorope = true; }
        else if (c0 < 1024) {}
        else if (c0 < 1152) { gain = gk_win; dorope = true; }
        else if (c0 < 1280) {}
        else if (c0 < 1792) { gain = gq_fox; scale = 0.125f * 1.4426950408889634f; }
        else if (c0 < 2304) { gain = gk_fox; }
        f32x4 gv[2][2];
#pragma unroll
        for (int bj = 0; bj < 2; ++bj)
#pragma unroll
            for (int n = 0; n < 2; ++n) gv[bj][n] = gain ? *(const f32x4*)(gain + 32 * bj + 8 * fq + 4 * n) : (f32x4){1.f, 1.f, 1.f, 1.f};
#pragma unroll
        for (int ai = 0; ai < 2; ++ai)
#pragma unroll
            for (int m = 0; m < 4; ++m) { const int row = row0 + ai * HALF + m * 16, t = row & 4095; const float r1 = rstd16(ssq1, row, 1.f / 1024.f);
                f32x4 v[2][2];
#pragma unroll
                for (int bj = 0; bj < 2; ++bj)
#pragma unroll
                    for (int n = 0; n < 2; ++n) v[bj][n] = acc[ai][bj][m][n] * r1;
                if (gain) { float ss = (hsum4(v[0][0] * v[0][0]) + hsum4(v[0][1] * v[0][1])) + (hsum4(v[1][0] * v[1][0]) + hsum4(v[1][1] * v[1][1]));
                    ss += __shfl_xor(ss, 16); ss += __shfl_xor(ss, 32);
                    const float rn = 1.0f / sqrtf(ss * (1.f / 64.f) + 1e-6f);
#pragma unroll
                    for (int bj = 0; bj < 2; ++bj)
#pragma unroll
                        for (int n = 0; n < 2; ++n) v[bj][n] = v[bj][n] * rn * gv[bj][n]; }
                if (dorope) { f32x4 p0, p1;
#pragma unroll
                    for (int e = 0; e < 4; ++e) { p0[e] = __shfl_xor(v[0][0][e], 16); p1[e] = __shfl_xor(v[0][1][e], 16); }
                    if (fq < 2) { const f32x4 cs0 = *(const f32x4*)(rope + t * 16), cs1 = *(const f32x4*)(rope + t * 16 + 4), sn0 = *(const f32x4*)(rope + t * 16 + 8), sn1 = *(const f32x4*)(rope + t * 16 + 12);
                        if (fq == 0) { v[0][0] = v[0][0] * cs0 - p0 * sn0; v[0][1] = v[0][1] * cs1 - p1 * sn1; }
                        else { v[0][0] = v[0][0] * cs0 + p0 * sn0; v[0][1] = v[0][1] * cs1 + p1 * sn1; } } }
#pragma unroll
                for (int bj = 0; bj < 2; ++bj) *(u32x4*)(QKV + (size_t)row * 2816 + c0 + 32 * bj + 8 * fq) = pack8(v[bj][0] * scale, v[bj][1] * scale);
            }
    }
};
template <class Epi, class Sched, bool ALIGN_EPI = false, bool SP2 = false>
__device__ __forceinline__ void gemm_phase(PG8_LAS unsigned char* lds, const Gemm g, const Sched& S, const Epi& E) {
    const int tid = threadIdx.x, wid = __builtin_amdgcn_readfirstlane(tid >> 6), lane = tid & 63, wr = wid >> 2, wc = wid & 3, fr = lane & 15, fq = lane >> 4;
    const int K = g.K, nt = K / BK;
    unsigned voffA[2], voffB[2];
#pragma unroll
    for (int i = 0; i < 2; ++i) { int R, C; stage_rc(tid * 16 + i * 8192, R, C); const int Rb = Epi::PERM ? ((R & ~31) + perm32(R & 31)) : R;
        voffA[i] = (unsigned)(R * K + C) * 2u; voffB[i] = (unsigned)(Rb * K + C) * 2u; }
    const size_t kstep = (size_t)(BK * 2);
    const size_t hstep = (size_t)HALF * K * 2;
    const size_t tstep = 2 * hstep;
    const unsigned ldsw = (unsigned)wid * 1024u;
    const int aoff = lds_byte(wr * 64 + fr, fq * 8), boff = lds_byte(wc * 32 + fr, fq * 8);
#define PG8_SA(b, h) (((b) * 2 + (h)) * HTB)
#define PG8_SB(b, h) ((4 + (b) * 2 + (h)) * HTB)
#define PG8_STAGE(bufoff, gbase, voff) do { _Pragma("unroll") for (int _i = 0; _i < 2; ++_i) \
        __builtin_amdgcn_global_load_lds((const unsigned*)((const char*)(gbase) + (voff)[_i]), (PG8_LAS unsigned*)(lds + (bufoff) + ldsw + _i * 8192), 16, 0, 0); } while (0)
#define PG8_LDA(dst, b, h) do { _Pragma("unroll") for (int m = 0; m < 4; ++m) _Pragma("unroll") for (int k = 0; k < 2; ++k) dst[m][k] = *(const PG8_LAS bf16x8*)(lds + PG8_SA(b, h) + aoff + m * 2048 + k * 1024); } while (0)
#define PG8_LDB(dst, b, h) do { _Pragma("unroll") for (int n = 0; n < 2; ++n) _Pragma("unroll") for (int k = 0; k < 2; ++k) dst[n][k] = *(const PG8_LAS bf16x8*)(lds + PG8_SB(b, h) + boff + n * 2048 + k * 1024); } while (0)
#define PG8_MMA(ai, bj, At, Bt) do { __builtin_amdgcn_s_setprio(1); _Pragma("unroll") for (int m = 0; m < 4; ++m) _Pragma("unroll") for (int n = 0; n < 2; ++n) _Pragma("unroll") for (int k = 0; k < 2; ++k) \
        acc[ai][bj][m][n] = __builtin_amdgcn_mfma_f32_16x16x32_bf16(Bt[n][k], At[m][k], acc[ai][bj][m][n], 0, 0, 0); __builtin_amdgcn_s_setprio(0); } while (0)
#define PG8_WAIT_V(n) asm volatile("s_waitcnt vmcnt(" #n ")" ::: "memory")
#define PG8_WAIT_L(n) asm volatile("s_waitcnt lgkmcnt(" #n ")" ::: "memory")
#define PG8_BAR __builtin_amdgcn_s_barrier()
#define PG8_SCHED __builtin_amdgcn_sched_barrier(0)
    Unit cur, nxt; int ui = 0;
    if (!S.next(0, cur)) return;
    f32x4 acc[2][2][4][2];
#pragma unroll
    for (int a = 0; a < 2; ++a)
#pragma unroll
        for (int b = 0; b < 2; ++b)
#pragma unroll
            for (int m = 0; m < 4; ++m)
#pragma unroll
                for (int n = 0; n < 2; ++n) acc[a][b][m][n] = (f32x4){0.f, 0.f, 0.f, 0.f};
    bf16x8 At[4][2], B0[2][2], B1[2][2];
    const char* cA = (const char*)g.A + (size_t)cur.pm * tstep; const char* cB = (const char*)g.Bt + (size_t)cur.pn * tstep;
    S.a_ready(cur);
    if constexpr (SP2) {
        PG8_STAGE(PG8_SB(0, 0), cB, voffB); PG8_STAGE(PG8_SB(0, 1), cB + hstep, voffB); PG8_STAGE(PG8_SA(0, 0), cA, voffA); PG8_STAGE(PG8_SA(0, 1), cA + hstep, voffA);
        if (wr == 1) PG8_BAR;
        PG8_WAIT_V(2); PG8_BAR;
        PG8_STAGE(PG8_SB(1, 0), cB + kstep, voffB); PG8_STAGE(PG8_SA(1, 0), cA + kstep, voffA); PG8_STAGE(PG8_SB(1, 1), cB + hstep + kstep, voffB);
        PG8_WAIT_V(6); PG8_BAR;
    } else {
        PG8_STAGE(PG8_SB(0, 0), cB, voffB); PG8_STAGE(PG8_SA(0, 0), cA, voffA); PG8_STAGE(PG8_SB(0, 1), cB + hstep, voffB); PG8_STAGE(PG8_SA(0, 1), cA + hstep, voffA);
        if (wr == 1) PG8_BAR;
        PG8_WAIT_V(4); PG8_BAR;
        PG8_STAGE(PG8_SB(1, 0), cB + kstep, voffB); PG8_STAGE(PG8_SA(1, 0), cA + kstep, voffA); PG8_STAGE(PG8_SB(1, 1), cB + hstep + kstep, voffB);
        PG8_WAIT_V(6); PG8_BAR;
    }
    for (;;) {
        const bool has_next = S.next(ui + 1, nxt);
        const char* nA = has_next ? (const char*)g.A + (size_t)nxt.pm * tstep : cA; const char* nB = has_next ? (const char*)g.Bt + (size_t)nxt.pn * tstep : cB;
        for (int t = 0; t < nt; t += 2) {
            const bool last = (t == nt - 2);
            const char* a1 = cA + (size_t)(t + 1) * kstep;
            const char* a2 = last ? nA : cA + (size_t)(t + 2) * kstep; const char* b2 = last ? nB : cB + (size_t)(t + 2) * kstep;
            const char* a3 = a2 + kstep; const char* b3 = b2 + kstep;
            if (last && has_next) S.a_ready(nxt);
            if constexpr (SP2) {
            PG8_LDB(B0, 0, 0); PG8_LDB(B1, 0, 1); PG8_SCHED; PG8_LDA(At, 0, 0); PG8_STAGE(PG8_SA(1, 1), a1 + hstep, voffA);
            PG8_WAIT_V(8); PG8_WAIT_L(0); PG8_BAR; PG8_MMA(0, 0, At, B0); PG8_MMA(0, 1, At, B1); PG8_BAR; PG8_SCHED;
            PG8_LDA(At, 0, 1); PG8_STAGE(PG8_SB(0, 0), b2, voffB); PG8_STAGE(PG8_SB(0, 1), b2 + hstep, voffB); PG8_STAGE(PG8_SA(0, 0), a2, voffA);
            PG8_WAIT_V(8); PG8_WAIT_L(0); PG8_BAR; PG8_MMA(1, 0, At, B0); PG8_MMA(1, 1, At, B1); PG8_BAR; PG8_SCHED;
            PG8_LDB(B0, 1, 0); PG8_LDB(B1, 1, 1); PG8_SCHED; PG8_LDA(At, 1, 0); PG8_STAGE(PG8_SA(0, 1), a2 + hstep, voffA);
            PG8_WAIT_V(8); PG8_WAIT_L(0); PG8_BAR; PG8_MMA(0, 0, At, B0); PG8_MMA(0, 1, At, B1); PG8_BAR; PG8_SCHED;
            PG8_LDA(At, 1, 1); PG8_STAGE(PG8_SB(1, 0), b3, voffB); PG8_STAGE(PG8_SB(1, 1), b3 + hstep, voffB); PG8_STAGE(PG8_SA(1, 0), a3, voffA);
            PG8_WAIT_V(8); PG8_WAIT_L(0); PG8_BAR; PG8_MMA(1, 0, At, B0); PG8_MMA(1, 1, At, B1); PG8_BAR; PG8_SCHED;
            } else {
            PG8_LDB(B0, 0, 0); PG8_SCHED; PG8_LDA(At, 0, 0); PG8_STAGE(PG8_SA(1, 1), a1 + hstep, voffA);
            PG8_WAIT_L(8); PG8_BAR; PG8_WAIT_L(0); PG8_MMA(0, 0, At, B0); PG8_BAR; PG8_SCHED;
            PG8_LDB(B1, 0, 1); PG8_STAGE(PG8_SB(0, 0), b2, voffB);
            PG8_BAR; PG8_WAIT_L(0); PG8_MMA(0, 1, At, B1); PG8_BAR;
            PG8_LDA(At, 0, 1); PG8_STAGE(PG8_SA(0, 0), a2, voffA);
            PG8_BAR; PG8_WAIT_L(0); PG8_MMA(1, 0, At, B0); PG8_BAR; PG8_SCHED;
            PG8_STAGE(PG8_SB(0, 1), b2 + hstep, voffB);
            PG8_WAIT_V(6); PG8_BAR; PG8_MMA(1, 1, At, B1); PG8_BAR;
            PG8_LDB(B0, 1, 0); PG8_SCHED; PG8_LDA(At, 1, 0); PG8_STAGE(PG8_SA(0, 1), a2 + hstep, voffA);
            PG8_WAIT_L(8); PG8_BAR; PG8_WAIT_L(0); PG8_MMA(0, 0, At, B0); PG8_BAR; PG8_SCHED;
            PG8_LDB(B1, 1, 1); PG8_STAGE(PG8_SB(1, 0), b3, voffB);
            PG8_BAR; PG8_WAIT_L(0); PG8_MMA(0, 1, At, B1); PG8_BAR;
            PG8_LDA(At, 1, 1); PG8_STAGE(PG8_SA(1, 0), a3, voffA);
            PG8_BAR; PG8_WAIT_L(0); PG8_MMA(1, 0, At, B0); PG8_BAR; PG8_SCHED;
            PG8_STAGE(PG8_SB(1, 1), b3 + hstep, voffB);
            PG8_WAIT_V(6); PG8_BAR; PG8_MMA(1, 1, At, B1); PG8_BAR;
            }
        }
        if constexpr (ALIGN_EPI) { if (wr == 0) PG8_BAR; }
        if constexpr (!Epi::AFTER_DRAIN) { E(acc, cur, wr, wc, fr, fq); S.done(cur); }
        if (!has_next) break;
#pragma unroll
        for (int a = 0; a < 2; ++a)
#pragma unroll
            for (int b = 0; b < 2; ++b)
#pragma unroll
                for (int m = 0; m < 4; ++m)
#pragma unroll
                    for (int n = 0; n < 2; ++n) acc[a][b][m][n] = (f32x4){0.f, 0.f, 0.f, 0.f};
        cur = nxt; cA = nA; cB = nB; ++ui;
        if constexpr (ALIGN_EPI) { if (wr == 1) PG8_BAR; }
    }
    PG8_WAIT_V(0);
    if constexpr (!ALIGN_EPI) { if (wr == 0) PG8_BAR; }
    PG8_BAR;
    if constexpr (Epi::AFTER_DRAIN) { E.fused(acc, cur, wr, wc, fr, fq, lds, wid, lane); S.done(cur); }
#undef PG8_SA
#undef PG8_SB
#undef PG8_STAGE
#undef PG8_LDA
#undef PG8_LDB
#undef PG8_MMA
#undef PG8_WAIT_V
#undef PG8_WAIT_L
#undef PG8_BAR
#undef PG8_SCHED
}
}

#define LAS __attribute__((address_space(3)))
typedef unsigned v4u __attribute__((ext_vector_type(4)));
typedef float f32x4 __attribute__((ext_vector_type(4)));
constexpr int NWAVES = 8;
constexpr int RING_BYTES = 131072, LDS_BYTES = 147456;

__device__ __forceinline__ unsigned pk2(float lo, float hi) { return (unsigned)f2bf(lo) | ((unsigned)f2bf(hi) << 16); }
__device__ __forceinline__ int src_win(int np) {
    const int tile = np >> 8, w = np & 255;
    if (tile == 11) { if (w < 24) return 1280 + w; if (w < 32) return 2840 + (w - 24); return -1; }
    const int half = w >> 7, head = (w >> 5) & 3, i = w & 31;
    const int c = tile * 256 + head * 64 + half * 32 + i;
    return c < 1280 ? c : c + 24;
}
__device__ __forceinline__ void transpose_item(const float* W, int N, int K, const float* gain, bf16* WT, int n0, int k0, int sc, LAS float* scr, int lane) {
#pragma unroll 8
    for (int i = 0; i < 32; ++i) { const int kk = 2 * i + (lane >> 5); float v = sc >= 0 ? W[(size_t)(k0 + kk) * N + sc] : 0.f; if (gain) v *= gain[k0 + kk]; scr[kk * 33 + (lane & 31)] = v; }
    asm volatile("s_waitcnt lgkmcnt(0)" ::: "memory");
    const int c = lane & 7;
#pragma unroll
    for (int j = 0; j < 4; ++j) { const int n = (lane >> 3) + 8 * j; const LAS float* s = scr + (8 * c) * 33 + n;
        v4u o; o.x = pk2(s[0 * 33], s[1 * 33]); o.y = pk2(s[2 * 33], s[3 * 33]); o.z = pk2(s[4 * 33], s[5 * 33]); o.w = pk2(s[6 * 33], s[7 * 33]);
        *(v4u*)(WT + (size_t)(n0 + n) * K + k0 + 8 * c) = o; }
    asm volatile("s_waitcnt lgkmcnt(0)" ::: "memory");
}
__device__ __forceinline__ void ph_prep(const P& p, LAS unsigned char* lds) {
    const int tid = threadIdx.x, lane = tid & 63, wave = tid >> 6;
    const int gw = blockIdx.x * NWAVES + wave, NGW = gridDim.x * NWAVES;
    LAS float* scr = (LAS float*)(lds + wave * 16384);
    constexpr int I_GU = 176 * 16, I_D = 32 * 44, I_IN = 96 * 16, I_SQ = 32 * 16, I_PR = 32 * 4;
    constexpr int NITEMS = 2 * I_GU + 2 * I_D + I_IN + 2 * I_SQ + I_PR;
    for (int it = gw; it < NITEMS; it += NGW) {
        int r = it;
        if (r < 2 * I_GU) {
            const int second = r >= I_GU; if (second) r -= I_GU;
            const int ng = r / 16, kb = r % 16, n0 = ng * 32, tile = n0 >> 8, w = n0 & 255;
            const float* W = second ? (w < 128 ? p.in[25] : p.in[26]) : (w < 128 ? p.in[3] : p.in[4]);
            transpose_item(W, DFF, D, second ? p.in[24] : nullptr, (bf16*)(p.ws + (second ? WS_WGU2 : WS_WGU1)), n0, kb * 64, tile * 128 + (w & 127) + (lane & 31), scr, lane);
            continue; }
        r -= 2 * I_GU;
        if (r < 2 * I_D) {
            const int second = r >= I_D; if (second) r -= I_D;
            const int ng = r / 44, kb = r % 44;
            transpose_item(second ? p.in[27] : p.in[5], D, DFF, nullptr, (bf16*)(p.ws + (second ? WS_WD2 : WS_WD1)), ng * 32, kb * 64, ng * 32 + (lane & 31), scr, lane);
            continue; }
        r -= 2 * I_D;
        if (r < I_IN) { const int ng = r / 16, kb = r % 16;
            transpose_item(p.in[7], INW, D, p.in[6], (bf16*)(p.ws + WS_WIN), ng * 32, kb * 64, src_win(ng * 32 + (lane & 31)), scr, lane);
            continue; }
        r -= I_IN;
        if (r < 2 * I_SQ) { const int second = r >= I_SQ; if (second) r -= I_SQ;
            const int ng = r / 16, kb = r % 16;
            transpose_item(second ? p.in[29] : p.in[23], D, D, second ? p.in[28] : nullptr, (bf16*)(p.ws + (second ? WS_WGATE : WS_WOUT)), ng * 32, kb * 64, ng * 32 + (lane & 31), scr, lane);
            continue; }
        r -= 2 * I_SQ;
        { const int ng = r / 4, kb = r % 4;
          transpose_item(p.in[30], D, DPLE, nullptr, (bf16*)(p.ws + WS_WPROJ), ng * 32, kb * 64, ng * 32 + (lane & 31), scr, lane); }
    }
    { bf16* XN = (bf16*)(p.ws + WS_XN); const float* g1 = p.in[2];
      for (int m = gw; m < M; m += NGW) {
          const f32x4* xr = (const f32x4*)(p.in[0] + (size_t)m * D) + lane;
          f32x4 v[4]; float s = 0.f;
#pragma unroll
          for (int j = 0; j < 4; ++j) { v[j] = xr[64 * j]; s += (v[j][0] * v[j][0] + v[j][1] * v[j][1]) + (v[j][2] * v[j][2] + v[j][3] * v[j][3]); }
          s = wave_sum(s);
          const float rs = 1.0f / sqrtf(s * (1.f / D) + EPS);
          unsigned long long* o8 = (unsigned long long*)(XN + (size_t)m * D) + lane;
#pragma unroll
          for (int j = 0; j < 4; ++j) { const f32x4 gg = *((const f32x4*)g1 + lane + 64 * j);
              o8[64 * j] = (unsigned long long)pk2(v[j][0] * rs * gg[0], v[j][1] * rs * gg[1]) | ((unsigned long long)pk2(v[j][2] * rs * gg[2], v[j][3] * rs * gg[3]) << 32); }
      } }
    { const f32x4* src = (const f32x4*)p.in[1]; unsigned long long* dst = (unsigned long long*)(p.ws + WS_PB);
      for (size_t i = (size_t)blockIdx.x * 512 + tid; i < (size_t)M * DPLE / 4; i += (size_t)gridDim.x * 512) { const f32x4 v = src[i]; dst[i] = (unsigned long long)pk2(v[0], v[1]) | ((unsigned long long)pk2(v[2], v[3]) << 32); } }
    { float* rope = (float*)(p.ws + WS_ROPE);
      for (int i = blockIdx.x * 512 + tid; i < SEQ * 8; i += gridDim.x * 512) { const int t = i >> 3, f = i & 7;
          const double ang = (double)t * pow(500000.0, -(double)f / 8.0);
          rope[t * 16 + f] = (float)cos(ang); rope[t * 16 + 8 + f] = (float)sin(ang); } }
}

enum { PH_PREP = 0, PH_G1, PH_G2, PH_G3, PH_E, PH_G4, PH_G5, PH_G6, PH_G7, PH_N };

__device__ __forceinline__ void run_main_phase(const P& p, LAS unsigned char* lds, int ph) {
    using namespace pg8;
    bf16* XN = (bf16*)(p.ws + WS_XN); bf16* XN2 = (bf16*)(p.ws + WS_O); bf16* HID = (bf16*)(p.ws + WS_BIG); bf16* EB = (bf16*)(p.ws + WS_E);
    float* SSQ1 = (float*)(p.ws + WS_SSQ1); float* SSQ2 = (float*)(p.ws + WS_SSQ2); float* SSQ3 = (float*)(p.ws + WS_SSQ3); float* SSQE = (float*)(p.ws + WS_SSQE);
    const int G = gridDim.x, c = blockIdx.x;
    switch (ph) {
    case PH_PREP: ph_prep(p, lds); break;
    case PH_G1: { Gemm g{XN, (const bf16*)(p.ws + WS_WGU1), M, 5632, D}; StaticOrder S; S.init(M, 5632, G, c); EpiSwiglu E{HID, nullptr};
        gemm_phase<EpiSwiglu, StaticOrder, true, true>(lds, g, S, E); } break;
    case PH_G2: { Gemm g{HID, (const bf16*)(p.ws + WS_WD1), M, D, DFF}; StaticOrder S; S.init(M, D, G, c); EpiResid E{p.in[0], p.out, XN, SSQ1, 0.5f};
        gemm_phase<EpiResid, StaticOrder, true, true>(lds, g, S, E); } break;
    case PH_G3: { Gemm g{XN, (const bf16*)(p.ws + WS_WIN), M, 3072, D}; StaticOrder S; S.init(M, 3072, G, c);
        EpiQKV E{HID, (float*)(p.ws + WS_GATES), (float*)(p.ws + WS_LOGF), SSQ1, (const float*)(p.ws + WS_ROPE), p.in[9], p.in[11], p.in[12], p.in[19], p.in[20], p.in[8]};
        gemm_phase<EpiQKV, StaticOrder, true, true>(lds, g, S, E); } break;
    case PH_E: { Gemm g{(const bf16*)(p.ws + WS_PB), (const bf16*)(p.ws + WS_WPROJ), M, D, DPLE}; StaticOrder S; S.init(M, D, G, c); EpiE E{EB, SSQE};
        gemm_phase<EpiE, StaticOrder, true, true>(lds, g, S, E); } break;
    case PH_G4: { Gemm g{XN, (const bf16*)(p.ws + WS_WOUT), M, D, D}; StaticOrder S; S.init(M, D, G, c); EpiResid E{p.out, p.out, XN2, SSQ2, 1.0f};
        gemm_phase<EpiResid, StaticOrder, true, true>(lds, g, S, E); } break;
    case PH_G5: { Gemm g{XN2, (const bf16*)(p.ws + WS_WGU2), M, 5632, D}; StaticOrder S; S.init(M, 5632, G, c); EpiSwiglu E{HID, SSQ2};
        gemm_phase<EpiSwiglu, StaticOrder, true, true>(lds, g, S, E); } break;
    case PH_G6: { Gemm g{HID, (const bf16*)(p.ws + WS_WD2), M, D, DFF}; StaticOrder S; S.init(M, D, G, c); EpiResid E{p.out, p.out, XN, SSQ3, 0.5f};
        gemm_phase<EpiResid, StaticOrder, true, true>(lds, g, S, E); } break;
    case PH_G7: { Gemm g{XN, (const bf16*)(p.ws + WS_WGATE), M, D, D}; StaticOrder S; S.init(M, D, G, c); EpiPle E{p.out, EB, SSQ3, SSQE, p.in[31]};
        gemm_phase<EpiPle, StaticOrder, true, true>(lds, g, S, E); } break;
    default: break;
    }
}

__global__ void __launch_bounds__(512, 2) k_main(P p, int ph) {
    extern __shared__ __attribute__((aligned(16))) unsigned char lds_raw[];
    run_main_phase(p, (LAS unsigned char*)lds_raw, ph);
}

__device__ __forceinline__ void run_phase(const P& p, float* sm, int ph, int bid, int nb) {
    switch (ph) {
    case 5: ph_compress(p, sm, bid, nb); ph_cumsum(p, bid, nb); break;
    case 6: ph_nsa(p, sm, bid, nb); break;
    case 7: ph_fox(p, sm, bid, nb); break;
    case 8: ph_groupnorm(p, bid, nb); break;
    default: break;
    }
}
__global__ void __launch_bounds__(256) k_phase(P p, int ph) {
    __shared__ float sm[16384];
    run_phase(p, sm, ph, blockIdx.x, gridDim.x);
}

extern "C" void kernel_launch(void* const* d_in, const int* in_sizes, int n_in, void* d_out, int out_size, void* d_ws, size_t ws_size, hipStream_t stream) {
    static int grid = 0;
    if (grid == 0) {
        if (n_in != 32 || out_size != M * D || ws_size < WS_END) { fprintf(stderr, "kernel_launch: unexpected sizes n_in %d out %d ws %zu\n", n_in, out_size, ws_size); grid = -1; return; }
        int dev = 0, cus = 0;
        hipGetDevice(&dev); hipDeviceGetAttribute(&cus, hipDeviceAttributeMultiprocessorCount, dev);
        if (hipFuncSetAttribute((const void*)k_main, hipFuncAttributeMaxDynamicSharedMemorySize, LDS_BYTES) != hipSuccess) { fprintf(stderr, "hipFuncSetAttribute failed\n"); grid = -1; return; }
        grid = cus;
    }
    if (grid < 0) return;
    P p{};
    for (int i = 0; i < 32; ++i) p.in[i] = (const float*)d_in[i];
    p.out = (float*)d_out; p.ws = (unsigned char*)d_ws;
    hipMemsetAsync((char*)d_ws + WS_CTL, 0, 1 * MiB, stream);
    const int seq_main1[] = {PH_PREP, PH_G1, PH_G2, PH_G3};
    for (int ph : seq_main1) hipLaunchKernelGGL(k_main, dim3(grid), dim3(512), LDS_BYTES, stream, p, ph);
    for (int ph = 5; ph <= 8; ++ph) hipLaunchKernelGGL(k_phase, dim3(2048), dim3(256), 0, stream, p, ph);
    const int seq_main2[] = {PH_E, PH_G4, PH_G5, PH_G6, PH_G7};
    for (int ph : seq_main2) hipLaunchKernelGGL(k_main, dim3(grid), dim3(512), LDS_BYTES, stream, p, ph);
}
```

```cpp
#include <hip/hip_runtime.h>
#include <hip/hip_cooperative_groups.h>
#include <cstdint>
#include <cstdio>
namespace cg = cooperative_groups;

typedef unsigned short bf16;
constexpr int BATCH = 8, SEQ = 4096, M = BATCH * SEQ, D = 1024, DFF = 2816, INW = 2848, DPLE = 256;
constexpr int QP = 2816;
constexpr float EPS = 1e-6f;
constexpr float C2 = 0.125f * 1.4426950408889634f;
constexpr float LOG2E = 1.4426950408889634f;
constexpr int C_QA = 0, C_CK = 512, C_CV = 640, C_SK = 768, C_SV = 896, C_WK = 1024, C_WV = 1152, C_QF = 1280, C_KF = 1792, C_VF = 2304;

constexpr size_t MiB = 1u << 20;
constexpr size_t WS_CTL = 0;
constexpr size_t WS_WGU1 = 2 * MiB, WS_WD1 = 13 * MiB, WS_WIN = 19 * MiB, WS_WOUT = 25 * MiB, WS_WGU2 = 27 * MiB, WS_WD2 = 38 * MiB, WS_WGATE = 44 * MiB, WS_WPROJ = 46 * MiB;
constexpr size_t WS_KCMP = 50 * MiB, WS_VCMP = 51 * MiB, WS_C = 52 * MiB, WS_GATES = 53 * MiB, WS_LOGF = 56 * MiB, WS_ROPE = 57 * MiB;
constexpr size_t WS_SSQ1 = 58 * MiB, WS_SSQ2 = 60 * MiB, WS_SSQ3 = 62 * MiB, WS_SSQE = 64 * MiB, WS_SEL = 66 * MiB;
constexpr size_t WS_PB = 70 * MiB;
constexpr size_t WS_XN = 88 * MiB;
constexpr size_t WS_O = 152 * MiB;
constexpr size_t WS_BIG = 216 * MiB;
constexpr size_t WS_E = 408 * MiB;
constexpr size_t WS_OB = WS_O, WS_OC = WS_O + 32 * MiB, WS_OS = WS_E, WS_OW = WS_E + 32 * MiB;
constexpr size_t WS_END = 472 * MiB;

struct P {
    const float* in[32];
    float* out;
    unsigned char* ws;
};

__device__ __forceinline__ float bf2f(bf16 v) { return __uint_as_float((unsigned)v << 16); }
__device__ __forceinline__ bf16 f2bf(float f) { unsigned u = __float_as_uint(f); return (bf16)((u + 0x7fffu + ((u >> 16) & 1u)) >> 16); }
__device__ __forceinline__ float wave_sum(float v) {
#pragma unroll
    for (int o = 1; o < 64; o <<= 1) v += __shfl_xor(v, o);
    return v;
}
__device__ __forceinline__ float wave_max(float v) {
#pragma unroll
    for (int o = 1; o < 64; o <<= 1) v = fmaxf(v, __shfl_xor(v, o));
    return v;
}
__device__ __forceinline__ float sigmoidf_(float x) { return 1.f / (1.f + __expf(-x)); }
__device__ __forceinline__ float siluf_(float x) { return x / (1.f + __expf(-x)); }

__device__ __forceinline__ void ph_rope(const P& p, int bid, int nb) {
    float* rope = (float*)(p.ws + WS_ROPE);
    for (int i = bid * 256 + threadIdx.x; i < SEQ * 8; i += nb * 256) {
        const int t = i >> 3, f = i & 7;
        const double inv = pow(500000.0, -(double)f / 8.0);
        const double ang = (double)t * inv;
        rope[t * 16 + f] = (float)cos(ang); rope[t * 16 + 8 + f] = (float)sin(ang);
    }
}
__device__ __forceinline__ void ph_rmsnorm(const float* in, const float* gain, bf16* outb, float* outf, int bid, int nb) {
    const int lane = threadIdx.x & 63, w = threadIdx.x >> 6;
    for (int r = bid * 4 + w; r < M; r += nb * 4) {
        const float* x = in + (size_t)r * D;
        float v[16]; float s = 0.f;
#pragma unroll
        for (int j = 0; j < 16; ++j) { v[j] = x[lane + 64 * j]; s += v[j] * v[j]; }
        s = wave_sum(s);
        const float rs = 1.0f / sqrtf(s * (1.f / D) + EPS);
#pragma unroll
        for (int j = 0; j < 16; ++j) {
            const float y = v[j] * rs * gain[lane + 64 * j];
            if (outb) outb[(size_t)r * D + lane + 64 * j] = f2bf(y);
            else outf[(size_t)r * D + lane + 64 * j] = y;
        }
    }
}
struct GA { const void* A; int lda; bool a_f32; const float* B0; const float* B1; int ldb; int N, K; float alpha; const float* res; float* outf; bf16* outb; const float* E; };

__device__ __forceinline__ int win_srccol(int tn, int c) {
    if (tn < 20) return tn * 64 + c;
    if (tn < 44) return 1304 + (tn - 20) * 64 + c;
    if (c < 24) return 1280 + c;
    if (c < 32) return 2840 + (c - 24);
    return -1;
}

template <int MODE> __device__ __forceinline__ void ngemm(const P& p, const GA& g, float* sm, int bid, int nb) {
    float* As = sm;
    float* Bs0 = sm + 16 * 68;
    float* Bs1 = Bs0 + 16 * 64;
    float* T = Bs1 + 16 * 64;
    const int tid = threadIdx.x, ty = tid >> 4, tx = tid & 15, lane = tid & 63, w = tid >> 6;
    const int ntn = (g.N + 63) / 64, ntm = M / 64, ntiles = ntn * ntm;
    for (int tile = bid; tile < ntiles; tile += nb) {
        const int tm = tile / ntn, tn = tile % ntn;
        float acc0[4][4], acc1[4][4];
#pragma unroll
        for (int i = 0; i < 4; ++i)
#pragma unroll
            for (int j = 0; j < 4; ++j) { acc0[i][j] = 0.f; acc1[i][j] = 0.f; }
        for (int k0 = 0; k0 < g.K; k0 += 16) {
            {
                const int r = tid >> 2, kq = (tid & 3) * 4;
                float a[4];
                if (g.a_f32) { const float* ap = (const float*)g.A + (size_t)(tm * 64 + r) * g.lda + k0 + kq; a[0] = ap[0]; a[1] = ap[1]; a[2] = ap[2]; a[3] = ap[3]; }
                else { const bf16* ap = (const bf16*)g.A + (size_t)(tm * 64 + r) * g.lda + k0 + kq; a[0] = bf2f(ap[0]); a[1] = bf2f(ap[1]); a[2] = bf2f(ap[2]); a[3] = bf2f(ap[3]); }
#pragma unroll
                for (int i = 0; i < 4; ++i) As[(kq + i) * 68 + r] = a[i];
            }
            {
                const int k = tid >> 4, c4 = (tid & 15) * 4;
#pragma unroll
                for (int i = 0; i < 4; ++i) {
                    int sc = tn * 64 + c4 + i;
                    if (MODE == 4) sc = win_srccol(tn, c4 + i);
                    else if (sc >= g.N) sc = -1;
                    Bs0[k * 64 + c4 + i] = sc >= 0 ? g.B0[(size_t)(k0 + k) * g.ldb + sc] : 0.f;
                    if (MODE == 0) Bs1[k * 64 + c4 + i] = sc >= 0 ? g.B1[(size_t)(k0 + k) * g.ldb + sc] : 0.f;
                }
            }
            __syncthreads();
#pragma unroll
            for (int kk = 0; kk < 16; ++kk) {
                float a[4], b[4], b1[4];
#pragma unroll
                for (int i = 0; i < 4; ++i) { a[i] = As[kk * 68 + ty * 4 + i]; b[i] = Bs0[kk * 64 + tx * 4 + i]; if (MODE == 0) b1[i] = Bs1[kk * 64 + tx * 4 + i]; }
#pragma unroll
                for (int i = 0; i < 4; ++i)
#pragma unroll
                    for (int j = 0; j < 4; ++j) { acc0[i][j] += a[i] * b[j]; if (MODE == 0) acc1[i][j] += a[i] * b1[j]; }
            }
            __syncthreads();
        }
        if (MODE != 4) {
#pragma unroll
            for (int i = 0; i < 4; ++i)
#pragma unroll
                for (int j = 0; j < 4; ++j) {
                    const int r = tm * 64 + ty * 4 + i, c = tn * 64 + tx * 4 + j;
                    if (c < g.N) {
                        if (MODE == 0) g.outb[(size_t)r * g.N + c] = f2bf(siluf_(acc0[i][j]) * acc1[i][j]);
                        if (MODE == 1) g.outf[(size_t)r * D + c] = g.res[(size_t)r * D + c] + g.alpha * acc0[i][j];
                        if (MODE == 2) g.outf[(size_t)r * g.N + c] = acc0[i][j];
                        if (MODE == 3) g.outf[(size_t)r * D + c] = g.outf[(size_t)r * D + c] + sigmoidf_(acc0[i][j]) * g.E[(size_t)r * D + c];
                    }
                }
        } else {
#pragma unroll
            for (int i = 0; i < 4; ++i)
#pragma unroll
                for (int j = 0; j < 4; ++j) T[(ty * 4 + i) * 65 + tx * 4 + j] = acc0[i][j];
            __syncthreads();
            bf16* QKV = (bf16*)(p.ws + WS_BIG);
            float* gates = (float*)(p.ws + WS_GATES);
            float* logf_ = (float*)(p.ws + WS_LOGF);
            const float* rope = (const float*)(p.ws + WS_ROPE);
            const float* gain = nullptr; bool dorope = false; float scale = 1.f; int dcol = tn * 64;
            if (tn < 8) { gain = p.in[9]; dorope = true; scale = C2; }
            else if (tn < 10) { dorope = true; }
            else if (tn < 12) {}
            else if (tn < 14) { gain = p.in[11]; dorope = true; }
            else if (tn < 16) {}
            else if (tn < 18) { gain = p.in[12]; dorope = true; }
            else if (tn < 20) {}
            else if (tn < 28) { gain = p.in[19]; scale = C2; }
            else if (tn < 36) { gain = p.in[20]; }
            for (int rr = 0; rr < 16; ++rr) {
                const int rl = w * 16 + rr, r = tm * 64 + rl, t = r & (SEQ - 1);
                float v = T[rl * 65 + lane];
                if (tn < 44) {
                    if (gain) { const float ss = wave_sum(v * v); v = v * (1.0f / sqrtf(ss * (1.f / 64.f) + EPS)) * gain[lane]; }
                    if (dorope) {
                        const float pr = __shfl_xor(v, 8);
                        if (lane < 16) { const float c = rope[t * 16 + (lane & 7)], s = rope[t * 16 + 8 + (lane & 7)]; v = lane < 8 ? v * c - pr * s : v * c + pr * s; }
                    }
                    QKV[(size_t)r * QP + dcol + lane] = f2bf(v * scale);
                } else {
                    if (lane < 24) gates[(size_t)r * 24 + lane] = sigmoidf_(v);
                    else if (lane < 32) { const float x = v + p.in[8][lane - 24]; logf_[(size_t)r * 8 + lane - 24] = fminf(x, 0.f) - log1pf(__expf(-fabsf(x))); }
                }
            }
            __syncthreads();
        }
    }
}
__device__ __forceinline__ void ph_compress(const P& p, float* sm, int bid, int nb) {
    float* blk = sm;
    float* hid = sm + 2048;
    const bf16* QKV = (const bf16*)(p.ws + WS_BIG);
    const int tid = threadIdx.x;
    for (int item = bid; item < 16 * 256 * 2; item += nb) {
        const int which = item & 1, n = (item >> 1) & 255, bk = item >> 9, b = bk >> 1, kvh = bk & 1;
        bf16* outp = (bf16*)(p.ws + (which ? WS_VCMP : WS_KCMP)) + ((size_t)bk * 256 + n) * 64;
        if (n == 255) { if (tid < 64) outp[tid] = 0; continue; }
        const float* pos = which ? p.in[14] : p.in[13];
        const float* w1 = which ? p.in[17] : p.in[15];
        const float* w2 = which ? p.in[18] : p.in[16];
        const int col0 = (which ? C_CV : C_CK) + kvh * 64;
        for (int i = tid; i < 2048; i += 256) { const int l = i >> 6, d = i & 63; blk[i] = bf2f(QKV[(size_t)(b * SEQ + 16 * n + l) * QP + col0 + d]) + pos[i]; }
        __syncthreads();
        float acc = 0.f;
        for (int i = 0; i < 2048; ++i) acc += blk[i] * w1[(size_t)i * 256 + tid];
        hid[tid] = siluf_(acc);
        __syncthreads();
        if (tid < 64) {
            float o = 0.f;
            for (int j = 0; j < 256; ++j) o += hid[j] * w2[j * 64 + tid];
            if (!which) { const float ss = wave_sum(o * o); o = o * (1.0f / sqrtf(ss * (1.f / 64.f) + EPS)) * p.in[10][tid]; }
            outp[tid] = f2bf(o);
        }
        __syncthreads();
    }
}
__device__ __forceinline__ void ph_cumsum(const P& p, int bid, int nb) {
    const float* logf_ = (const float*)(p.ws + WS_LOGF);
    float* C = (float*)(p.ws + WS_C);
    const int lane = threadIdx.x & 63, w = threadIdx.x >> 6;
    for (int item = bid * 4 + w; item < BATCH * 8; item += nb * 4) {
        const int b = item >> 3, h = item & 7;
        float carry = 0.f;
        for (int t0 = 0; t0 < SEQ; t0 += 64) {
            float v = logf_[(size_t)(b * SEQ + t0 + lane) * 8 + h];
#pragma unroll
            for (int o = 1; o < 64; o <<= 1) { const float u = __shfl_up(v, o); if (lane >= o) v += u; }
            v += carry;
            C[(size_t)item * SEQ + t0 + lane] = v;
            carry = __shfl(v, 63);
        }
    }
}
__device__ __forceinline__ float dot64(const float* q, const bf16* k) {
    float s = 0.f;
#pragma unroll
    for (int i = 0; i < 8; ++i) {
        const uint4 v = *(const uint4*)(k + 8 * i);
        const unsigned u[4] = {v.x, v.y, v.z, v.w};
#pragma unroll
        for (int j = 0; j < 4; ++j) { s += q[8 * i + 2 * j] * __uint_as_float(u[j] << 16); s += q[8 * i + 2 * j + 1] * __uint_as_float(u[j] & 0xffff0000u); }
    }
    return s;
}
__device__ __forceinline__ void ph_nsa(const P& p, float* sm, int bid, int nb) {
    float* impp = sm;
    float* pl = sm + 256;
    const bf16* QKV = (const bf16*)(p.ws + WS_BIG);
    const bf16* KC = (const bf16*)(p.ws + WS_KCMP);
    const bf16* VC = (const bf16*)(p.ws + WS_VCMP);
    const float* gates = (const float*)(p.ws + WS_GATES);
    bf16* OC = (bf16*)(p.ws + WS_OC);
    unsigned long long* SEL = (unsigned long long*)(p.ws + WS_SEL);
    const int lane = threadIdx.x & 63, g = threadIdx.x >> 6;
    float* mypl = pl + g * 1024;
    for (int item = bid; item < M * 2; item += nb) {
        const int kvh = item & 1, m = item >> 1, b = m / SEQ, t = m % SEQ, h = kvh * 4 + g;
        float q[64];
        { const bf16* qp = QKV + (size_t)m * QP + C_QA + h * 64;
#pragma unroll
          for (int i = 0; i < 64; ++i) q[i] = bf2f(qp[i]); }
        const int ncv = t >= 31 ? (t - 31) / 16 + 1 : 0;
        const bf16* kc = KC + (size_t)(b * 2 + kvh) * 256 * 64;
        const bf16* vc = VC + (size_t)(b * 2 + kvh) * 256 * 64;
        float sc[4]; float mx = -1e30f;
#pragma unroll
        for (int i = 0; i < 4; ++i) { const int n = lane + 64 * i; sc[i] = -1e30f; if (n < ncv) { sc[i] = dot64(q, kc + n * 64); mx = fmaxf(mx, sc[i]); } }
        mx = wave_max(mx);
        float sum = 0.f;
#pragma unroll
        for (int i = 0; i < 4; ++i) { const int n = lane + 64 * i; sc[i] = n < ncv ? exp2f(sc[i] - mx) : 0.f; sum += sc[i]; }
        sum = wave_sum(sum);
        const float rs = ncv > 0 ? 1.f / sum : 0.f;
#pragma unroll
        for (int i = 0; i < 4; ++i) mypl[lane + 64 * i] = sc[i] * rs;
        __syncthreads();
        float oc = 0.f;
        for (int n = 0; n < ncv; ++n) oc += mypl[n] * bf2f(vc[n * 64 + lane]);
        { float im = 0.f; const int lo = max(0, 4 * lane - 1), hi = min(254, 4 * lane + 3);
          for (int n = lo; n <= hi; ++n) im += mypl[n];
          impp[g * 64 + lane] = im; }
        __syncthreads();
        const int cur = t >> 6;
        float val = (impp[lane] + impp[64 + lane]) + (impp[128 + lane] + impp[192 + lane]);
        if (lane > cur) val = -1.f; else if (lane == 0 || lane == cur || lane == cur - 1) val = 1e6f;
        int rank = 0;
        for (int i = 0; i < 64; ++i) { const float vi = __shfl(val, i); rank += (vi > val || (vi == val && i < lane)) ? 1 : 0; }
        const unsigned long long selmask = __ballot(rank < 16 && val >= 0.f);
        __syncthreads();
        const float* gg = gates + (size_t)m * 24 + h * 3;
        OC[(size_t)m * 512 + h * 64 + lane] = f2bf(gg[0] * oc);
        if (g == 0 && lane == 0) SEL[(size_t)m * 2 + kvh] = selmask;
        __syncthreads();
    }
}
__device__ __forceinline__ void ph_fox(const P& p, float* sm, int bid, int nb) {
    const bf16* QKV = (const bf16*)(p.ws + WS_BIG);
    const float* C = (const float*)(p.ws + WS_C);
    bf16* OB = (bf16*)(p.ws + WS_OB);
    const int lane = threadIdx.x & 63, w = threadIdx.x >> 6;
    float* pl = sm + w * 4096;
    for (int it = bid * 4 + w; it < M * 8; it += nb * 4) {
        const int tt = it % SEQ, bh = it / SEQ, b = bh >> 3, h = bh & 7;
        const int t = (tt & 1) ? (SEQ - 1 - (tt >> 1)) : (tt >> 1);
        const int m = b * SEQ + t;
        float q[64];
        { const bf16* qp = QKV + (size_t)m * QP + C_QF + h * 64;
#pragma unroll
          for (int i = 0; i < 64; ++i) q[i] = bf2f(qp[i]); }
        const bf16* kb = QKV + (size_t)(b * SEQ) * QP + C_KF + h * 64;
        const bf16* vb = QKV + (size_t)(b * SEQ) * QP + C_VF + h * 64;
        const float* c = C + (size_t)bh * SEQ;
        const float ct = c[t];
        const int nk = t + 1;
        float mx = -1e30f;
        for (int i = 0; i * 64 < nk; ++i) { const int kk = i * 64 + lane; float s = -1e30f; if (kk < nk) { s = dot64(q, kb + (size_t)kk * QP) + (ct - c[kk]) * LOG2E; mx = fmaxf(mx, s); } pl[kk] = s; }
        mx = wave_max(mx);
        float sum = 0.f;
        for (int i = 0; i * 64 < nk; ++i) { const int kk = i * 64 + lane; const float e = kk < nk ? exp2f(pl[kk] - mx) : 0.f; pl[kk] = e; sum += e; }
        sum = wave_sum(sum);
        float o = 0.f;
        for (int kk = 0; kk < nk; ++kk) o += pl[kk] * bf2f(vb[(size_t)kk * QP + lane]);
        OB[(size_t)m * 512 + h * 64 + lane] = f2bf(o / sum);
    }
}
__device__ __forceinline__ void ph_groupnorm(const P& p, int bid, int nb) {
    const bf16* OC = (const bf16*)(p.ws + WS_OC); const bf16* OS = (const bf16*)(p.ws + WS_OS); const bf16* OW = (const bf16*)(p.ws + WS_OW); const bf16* OB = (const bf16*)(p.ws + WS_OB);
    bf16* XN = (bf16*)(p.ws + WS_XN);
    const int lane = threadIdx.x & 63, w = threadIdx.x >> 6;
    for (int it = bid * 4 + w; it < M * 2; it += nb * 4) {
        const int m = it >> 1, grp = it & 1;
        const float* gain = grp ? p.in[22] : p.in[21];
        float v[8]; float s = 0.f;
#pragma unroll
        for (int j = 0; j < 8; ++j) { const size_t ix = (size_t)m * 512 + lane + 64 * j; v[j] = grp ? bf2f(OB[ix]) : (bf2f(OC[ix]) + bf2f(OS[ix])) + bf2f(OW[ix]); s += v[j] * v[j]; }
        s = wave_sum(s);
        const float rs = 1.0f / sqrtf(s * (1.f / 512.f) + EPS);
#pragma unroll
        for (int j = 0; j < 8; ++j) XN[(size_t)m * D + grp * 512 + lane + 64 * j] = f2bf(v[j] * rs * gain[lane + 64 * j]);
    }
}

namespace pg8 {
#define PG8_LAS __attribute__((address_space(3)))
typedef unsigned short bf16_t;
typedef short bf16x8 __attribute__((ext_vector_type(8)));
typedef float f32x4 __attribute__((ext_vector_type(4)));
typedef unsigned u32x4 __attribute__((ext_vector_type(4)));
constexpr int BM = 256, BK = 64, HALF = 128, HTB = HALF * BK * 2  , STAGE_BYTES = 8 * HTB, NXCD = 8, WGM = 8;

__host__ __device__ __forceinline__ int lds_byte(int r, int c) { const int st = (r >> 4) * 2 + (c >> 5), rr = r & 15, cc = c & 31, ob = rr * 64 + cc * 2; return st * 1024 + (ob ^ (((ob >> 9) & 1) << 5)); }
__host__ __device__ __forceinline__ void stage_rc(int b, int& R, int& C) { const int st = b / 1024, sb = b % 1024, swz = sb ^ (((sb >> 9) & 1) << 5); R = (st >> 1) * 16 + swz / 64; C = (st & 1) * 32 + (swz % 64) / 2; }
__host__ __device__ __forceinline__ int perm32(int rho) { const int n = rho >> 4, i = rho & 15; return 8 * (i >> 2) + 4 * n + (i & 3); }

struct Unit { int pm, pn; };
struct Gemm { const bf16_t* A; const bf16_t* Bt; int M, N, K; };

struct StaticOrder {
    int nM, nN, nwg, G, c;
    __host__ __device__ void init(int M, int N, int G_, int c_) { nM = M / BM; nN = N / BM; nwg = nM * nN; G = G_; c = c_; }
    __host__ __device__ bool next(int i, Unit& u) const {
        const long L = (long)i * G + c; if (L >= nwg) return false;
        int wgid = (int)L; { const int q = nwg / NXCD, r = nwg % NXCD, xcd = wgid % NXCD, off = wgid / NXCD; wgid = (xcd < r ? xcd * (q + 1) : r * (q + 1) + (xcd - r) * q) + off; }
        const int nig = WGM * nN, gid = wgid / nig, fm = gid * WGM, gsz = (nM - fm) < WGM ? (nM - fm) : WGM;
        u.pm = fm + ((wgid % nig) % gsz); u.pn = (wgid % nig) / gsz; return true;
    }
    __device__ __forceinline__ void a_ready(const Unit&) const {}
    __device__ __forceinline__ void done(const Unit&) const {}
};

__device__ __forceinline__ unsigned cvt_pk_bf16(float lo, float hi) { unsigned r; asm volatile("v_cvt_pk_bf16_f32 %0, %1, %2" : "=v"(r) : "v"(lo), "v"(hi)); return r; }
__device__ __forceinline__ float hsum4(const f32x4 a) { return (a[0] + a[1]) + (a[2] + a[3]); }
__device__ __forceinline__ float rstd16(const float* ssq, int row, float invn) {
    const f32x4* s = (const f32x4*)(ssq + (size_t)row * 16);
    const float t = (hsum4(s[0]) + hsum4(s[1])) + (hsum4(s[2]) + hsum4(s[3]));
    return 1.0f / sqrtf(t * invn + 1e-6f);
}
__device__ __forceinline__ f32x4 sigmoid4(const f32x4 x) { f32x4 r;
#pragma unroll
    for (int e = 0; e < 4; ++e) r[e] = __builtin_amdgcn_rcpf(1.0f + __builtin_amdgcn_exp2f(-1.4426950408889634f * x[e]));
    return r; }
__device__ __forceinline__ u32x4 pack8(const f32x4 a, const f32x4 b) { u32x4 w; w.x = cvt_pk_bf16(a[0], a[1]); w.y = cvt_pk_bf16(a[2], a[3]); w.z = cvt_pk_bf16(b[0], b[1]); w.w = cvt_pk_bf16(b[2], b[3]); return w; }
__device__ __forceinline__ void unpack8(const u32x4 w, f32x4& a, f32x4& b) {
    a[0] = __uint_as_float(w.x << 16); a[1] = __uint_as_float(w.x & 0xffff0000u); a[2] = __uint_as_float(w.y << 16); a[3] = __uint_as_float(w.y & 0xffff0000u);
    b[0] = __uint_as_float(w.z << 16); b[1] = __uint_as_float(w.z & 0xffff0000u); b[2] = __uint_as_float(w.w << 16); b[3] = __uint_as_float(w.w & 0xffff0000u); }

struct EpiSwiglu {
    static constexpr bool PERM = true, AFTER_DRAIN = false;
    bf16_t* H; const float* ssq;
    __device__ __forceinline__ void operator()(const f32x4 (&acc)[2][2][4][2], const Unit& u, int wr, int wc, int fr, int fq) const {
        const int row0 = u.pm * BM + wr * 64 + fr, col0 = u.pn * 128 + wc * 32 + 8 * fq;
#pragma unroll
        for (int ai = 0; ai < 2; ++ai)
#pragma unroll
            for (int m = 0; m < 4; ++m) { const int row = row0 + ai * HALF + m * 16; const float r = ssq ? rstd16(ssq, row, 1.f / 1024.f) : 1.f;
                const f32x4 g0 = acc[ai][0][m][0] * r, g1 = acc[ai][0][m][1] * r, u0 = acc[ai][1][m][0] * r, u1 = acc[ai][1][m][1] * r;
                *(u32x4*)(H + (size_t)row * 2816 + col0) = pack8(g0 * sigmoid4(g0) * u0, g1 * sigmoid4(g1) * u1); }
    }
};
struct EpiResid {
    static constexpr bool PERM = true, AFTER_DRAIN = false;
    const float* res; float* out; bf16_t* xb; float* ssq; float alpha;
    __device__ __forceinline__ void operator()(const f32x4 (&acc)[2][2][4][2], const Unit& u, int wr, int wc, int fr, int fq) const {
        const int row0 = u.pm * BM + wr * 64 + fr, col0 = u.pn * BM + wc * 32 + 8 * fq;
#pragma unroll
        for (int ai = 0; ai < 2; ++ai)
#pragma unroll
            for (int m = 0; m < 4; ++m) { const int row = row0 + ai * HALF + m * 16; float ss = 0.f;
#pragma unroll
                for (int bj = 0; bj < 2; ++bj) { const size_t off = (size_t)row * 1024 + col0 + bj * HALF;
                    const f32x4 o0 = *(const f32x4*)(res + off) + alpha * acc[ai][bj][m][0], o1 = *(const f32x4*)(res + off + 4) + alpha * acc[ai][bj][m][1];
                    *(f32x4*)(out + off) = o0; *(f32x4*)(out + off + 4) = o1; *(u32x4*)(xb + off) = pack8(o0, o1);
                    ss += hsum4(o0 * o0) + hsum4(o1 * o1); }
                ss += __shfl_xor(ss, 16); ss += __shfl_xor(ss, 32);
                if (fq == 0) ssq[(size_t)row * 16 + u.pn * 4 + wc] = ss;
                asm volatile("" ::: "memory"); }
    }
};
struct EpiE {
    static constexpr bool PERM = true, AFTER_DRAIN = false;
    bf16_t* E; float* ssq;
    __device__ __forceinline__ void operator()(const f32x4 (&acc)[2][2][4][2], const Unit& u, int wr, int wc, int fr, int fq) const {
        const int row0 = u.pm * BM + wr * 64 + fr, col0 = u.pn * BM + wc * 32 + 8 * fq;
#pragma unroll
        for (int ai = 0; ai < 2; ++ai)
#pragma unroll
            for (int m = 0; m < 4; ++m) { const int row = row0 + ai * HALF + m * 16; float ss = 0.f;
#pragma unroll
                for (int bj = 0; bj < 2; ++bj) { const size_t off = (size_t)row * 1024 + col0 + bj * HALF; const f32x4 o0 = acc[ai][bj][m][0], o1 = acc[ai][bj][m][1];
                    *(u32x4*)(E + off) = pack8(o0, o1); ss += hsum4(o0 * o0) + hsum4(o1 * o1); }
                ss += __shfl_xor(ss, 16); ss += __shfl_xor(ss, 32);
                if (fq == 0) ssq[(size_t)row * 16 + u.pn * 4 + wc] = ss; }
    }
};
struct EpiPle {
    static constexpr bool PERM = true, AFTER_DRAIN = false;
    float* out; const bf16_t* E; const float* ssq3; const float* ssqe; const float* ge;
    __device__ __forceinline__ void operator()(const f32x4 (&acc)[2][2][4][2], const Unit& u, int wr, int wc, int fr, int fq) const {
        const int row0 = u.pm * BM + wr * 64 + fr, col0 = u.pn * BM + wc * 32 + 8 * fq;
        f32x4 gv[2][2];
#pragma unroll
        for (int bj = 0; bj < 2; ++bj) { gv[bj][0] = *(const f32x4*)(ge + col0 + bj * HALF); gv[bj][1] = *(const f32x4*)(ge + col0 + bj * HALF + 4); }
#pragma unroll
        for (int ai = 0; ai < 2; ++ai)
#pragma unroll
            for (int m = 0; m < 4; ++m) { const int row = row0 + ai * HALF + m * 16; const float r3 = rstd16(ssq3, row, 1.f / 1024.f), re = rstd16(ssqe, row, 1.f / 1024.f);
#pragma unroll
                for (int bj = 0; bj < 2; ++bj) { const size_t off = (size_t)row * 1024 + col0 + bj * HALF;
                    f32x4 e0, e1; unpack8(*(const u32x4*)(E + off), e0, e1);
                    const f32x4 o0 = *(const f32x4*)(out + off) + sigmoid4(acc[ai][bj][m][0] * r3) * (e0 * re * gv[bj][0]);
                    const f32x4 o1 = *(const f32x4*)(out + off + 4) + sigmoid4(acc[ai][bj][m][1] * r3) * (e1 * re * gv[bj][1]);
                    *(f32x4*)(out + off) = o0; *(f32x4*)(out + off + 4) = o1; }
                asm volatile("" ::: "memory"); }
    }
};
struct EpiQKV {
    static constexpr bool PERM = true, AFTER_DRAIN = false;
    bf16_t* QKV; float* gates; float* logf; const float* ssq1; const float* rope; const float* gq_nsa; const float* gk_slc; const float* gk_win; const float* gq_fox; const float* gk_fox; const float* bforget;
    __device__ __forceinline__ void operator()(const f32x4 (&acc)[2][2][4][2], const Unit& u, int wr, int wc, int fr, int fq) const {
        const int row0 = u.pm * BM + wr * 64 + fr;
        if (u.pn == 11) {
            if (wc != 0) return;
            f32x4 bf0 = *(const f32x4*)(bforget), bf1 = *(const f32x4*)(bforget + 4);
#pragma unroll
            for (int ai = 0; ai < 2; ++ai)
#pragma unroll
                for (int m = 0; m < 4; ++m) { const int row = row0 + ai * HALF + m * 16; const float r1 = rstd16(ssq1, row, 1.f / 1024.f);
                    const f32x4 v0 = acc[ai][0][m][0] * r1, v1 = acc[ai][0][m][1] * r1;
                    if (fq < 3) { *(f32x4*)(gates + (size_t)row * 24 + 8 * fq) = sigmoid4(v0); *(f32x4*)(gates + (size_t)row * 24 + 8 * fq + 4) = sigmoid4(v1); }
                    else { f32x4 x0 = v0 + bf0, x1 = v1 + bf1, l0, l1;
#pragma unroll
                        for (int e = 0; e < 4; ++e) { l0[e] = fminf(x0[e], 0.f) - log1pf(__expf(-fabsf(x0[e]))); l1[e] = fminf(x1[e], 0.f) - log1pf(__expf(-fabsf(x1[e]))); }
                        *(f32x4*)(logf + (size_t)row * 8) = l0; *(f32x4*)(logf + (size_t)row * 8 + 4) = l1; } }
            return;
        }
        const int c0 = u.pn * 256 + wc * 64;
        const float* gain = nullptr; bool dorope = false; float scale = 1.f;
        if (c0 < 512) { gain = gq_nsa; dorope = true; scale = 0.125f * 1.4426950408889634f; }
        else if (c0 < 640) { dorope = true; }
        else if (c0 < 768) {}
        else if (c0 < 896) { gain = gk_slc; dorope = true; }
        else if (c0 < 1024) {}
        else if (c0 < 1152) { gain = gk_win; dorope = true; }
        else if (c0 < 1280) {}
        else if (c0 < 1792) { gain = gq_fox; scale = 0.125f * 1.4426950408889634f; }
        else if (c0 < 2304) { gain = gk_fox; }
        f32x4 gv[2][2];
#pragma unroll
        for (int bj = 0; bj < 2; ++bj)
#pragma unroll
            for (int n = 0; n < 2; ++n) gv[bj][n] = gain ? *(const f32x4*)(gain + 32 * bj + 8 * fq + 4 * n) : (f32x4){1.f, 1.f, 1.f, 1.f};
#pragma unroll
        for (int ai = 0; ai < 2; ++ai)
#pragma unroll
            for (int m = 0; m < 4; ++m) { const int row = row0 + ai * HALF + m * 16, t = row & 4095; const float r1 = rstd16(ssq1, row, 1.f / 1024.f);
                f32x4 v[2][2];
#pragma unroll
                for (int bj = 0; bj < 2; ++bj)
#pragma unroll
                    for (int n = 0; n < 2; ++n) v[bj][n] = acc[ai][bj][m][n] * r1;
                if (gain) { float ss = (hsum4(v[0][0] * v[0][0]) + hsum4(v[0][1] * v[0][1])) + (hsum4(v[1][0] * v[1][0]) + hsum4(v[1][1] * v[1][1]));
                    ss += __shfl_xor(ss, 16); ss += __shfl_xor(ss, 32);
                    const float rn = 1.0f / sqrtf(ss * (1.f / 64.f) + 1e-6f);
#pragma unroll
                    for (int bj = 0; bj < 2; ++bj)
#pragma unroll
                        for (int n = 0; n < 2; ++n) v[bj][n] = v[bj][n] * rn * gv[bj][n]; }
                if (dorope) { f32x4 p0, p1;
#pragma unroll
                    for (int e = 0; e < 4; ++e) { p0[e] = __shfl_xor(v[0][0][e], 16); p1[e] = __shfl_xor(v[0][1][e], 16); }
                    if (fq < 2) { const f32x4 cs0 = *(const f32x4*)(rope + t * 16), cs1 = *(const f32x4*)(rope + t * 16 + 4), sn0 = *(const f32x4*)(rope + t * 16 + 8), sn1 = *(const f32x4*)(rope + t * 16 + 12);
                        if (fq == 0) { v[0][0] = v[0][0] * cs0 - p0 * sn0; v[0][1] = v[0][1] * cs1 - p1 * sn1; }
                        else { v[0][0] = v[0][0] * cs0 + p0 * sn0; v[0][1] = v[0][1] * cs1 + p1 * sn1; } } }
#pragma unroll
                for (int bj = 0; bj < 2; ++bj) *(u32x4*)(QKV + (size_t)row * 2816 + c0 + 32 * bj + 8 * fq) = pack8(v[bj][0] * scale, v[bj][1] * scale);
            }
    }
};
template <class Epi, class Sched, bool ALIGN_EPI = false, bool SP2 = false>
__device__ __forceinline__ void gemm_phase(PG8_LAS unsigned char* lds, const Gemm g, const Sched& S, const Epi& E) {
    const int tid = threadIdx.x, wid = __builtin_amdgcn_readfirstlane(tid >> 6), lane = tid & 63, wr = wid >> 2, wc = wid & 3, fr = lane & 15, fq = lane >> 4;
    const int K = g.K, nt = K / BK;
    unsigned voffA[2], voffB[2];
#pragma unroll
    for (int i = 0; i < 2; ++i) { int R, C; stage_rc(tid * 16 + i * 8192, R, C); const int Rb = Epi::PERM ? ((R & ~31) + perm32(R & 31)) : R;
        voffA[i] = (unsigned)(R * K + C) * 2u; voffB[i] = (unsigned)(Rb * K + C) * 2u; }
    const size_t kstep = (size_t)(BK * 2);
    const size_t hstep = (size_t)HALF * K * 2;
    const size_t tstep = 2 * hstep;
    const unsigned ldsw = (unsigned)wid * 1024u;
    const int aoff = lds_byte(wr * 64 + fr, fq * 8), boff = lds_byte(wc * 32 + fr, fq * 8);
#define PG8_SA(b, h) (((b) * 2 + (h)) * HTB)
#define PG8_SB(b, h) ((4 + (b) * 2 + (h)) * HTB)
#define PG8_STAGE(bufoff, gbase, voff) do { _Pragma("unroll") for (int _i = 0; _i < 2; ++_i) \
        __builtin_amdgcn_global_load_lds((const unsigned*)((const char*)(gbase) + (voff)[_i]), (PG8_LAS unsigned*)(lds + (bufoff) + ldsw + _i * 8192), 16, 0, 0); } while (0)
#define PG8_LDA(dst, b, h) do { _Pragma("unroll") for (int m = 0; m < 4; ++m) _Pragma("unroll") for (int k = 0; k < 2; ++k) dst[m][k] = *(const PG8_LAS bf16x8*)(lds + PG8_SA(b, h) + aoff + m * 2048 + k * 1024); } while (0)
#define PG8_LDB(dst, b, h) do { _Pragma("unroll") for (int n = 0; n < 2; ++n) _Pragma("unroll") for (int k = 0; k < 2; ++k) dst[n][k] = *(const PG8_LAS bf16x8*)(lds + PG8_SB(b, h) + boff + n * 2048 + k * 1024); } while (0)
#define PG8_MMA(ai, bj, At, Bt) do { __builtin_amdgcn_s_setprio(1); _Pragma("unroll") for (int m = 0; m < 4; ++m) _Pragma("unroll") for (int n = 0; n < 2; ++n) _Pragma("unroll") for (int k = 0; k < 2; ++k) \
        acc[ai][bj][m][n] = __builtin_amdgcn_mfma_f32_16x16x32_bf16(Bt[n][k], At[m][k], acc[ai][bj][m][n], 0, 0, 0); __builtin_amdgcn_s_setprio(0); } while (0)
#define PG8_WAIT_V(n) asm volatile("s_waitcnt vmcnt(" #n ")" ::: "memory")
#define PG8_WAIT_L(n) asm volatile("s_waitcnt lgkmcnt(" #n ")" ::: "memory")
#define PG8_BAR __builtin_amdgcn_s_barrier()
#define PG8_SCHED __builtin_amdgcn_sched_barrier(0)
    Unit cur, nxt; int ui = 0;
    if (!S.next(0, cur)) return;
    f32x4 acc[2][2][4][2];
#pragma unroll
    for (int a = 0; a < 2; ++a)
#pragma unroll
        for (int b = 0; b < 2; ++b)
#pragma unroll
            for (int m = 0; m < 4; ++m)
#pragma unroll
                for (int n = 0; n < 2; ++n) acc[a][b][m][n] = (f32x4){0.f, 0.f, 0.f, 0.f};
    bf16x8 At[4][2], B0[2][2], B1[2][2];
    const char* cA = (const char*)g.A + (size_t)cur.pm * tstep; const char* cB = (const char*)g.Bt + (size_t)cur.pn * tstep;
    S.a_ready(cur);
    if constexpr (SP2) {
        PG8_STAGE(PG8_SB(0, 0), cB, voffB); PG8_STAGE(PG8_SB(0, 1), cB + hstep, voffB); PG8_STAGE(PG8_SA(0, 0), cA, voffA); PG8_STAGE(PG8_SA(0, 1), cA + hstep, voffA);
        if (wr == 1) PG8_BAR;
        PG8_WAIT_V(2); PG8_BAR;
        PG8_STAGE(PG8_SB(1, 0), cB + kstep, voffB); PG8_STAGE(PG8_SA(1, 0), cA + kstep, voffA); PG8_STAGE(PG8_SB(1, 1), cB + hstep + kstep, voffB);
        PG8_WAIT_V(6); PG8_BAR;
    } else {
        PG8_STAGE(PG8_SB(0, 0), cB, voffB); PG8_STAGE(PG8_SA(0, 0), cA, voffA); PG8_STAGE(PG8_SB(0, 1), cB + hstep, voffB); PG8_STAGE(PG8_SA(0, 1), cA + hstep, voffA);
        if (wr == 1) PG8_BAR;
        PG8_WAIT_V(4); PG8_BAR;
        PG8_STAGE(PG8_SB(1, 0), cB + kstep, voffB); PG8_STAGE(PG8_SA(1, 0), cA + kstep, voffA); PG8_STAGE(PG8_SB(1, 1), cB + hstep + kstep, voffB);
        PG8_WAIT_V(6); PG8_BAR;
    }
    for (;;) {
        const bool has_next = S.next(ui + 1, nxt);
        const char* nA = has_next ? (const char*)g.A + (size_t)nxt.pm * tstep : cA; const char* nB = has_next ? (const char*)g.Bt + (size_t)nxt.pn * tstep : cB;
        for (int t = 0; t < nt; t += 2) {
            const bool last = (t == nt - 2);
            const char* a1 = cA + (size_t)(t + 1) * kstep;
            const char* a2 = last ? nA : cA + (size_t)(t + 2) * kstep; const char* b2 = last ? nB : cB + (size_t)(t + 2) * kstep;
            const char* a3 = a2 + kstep; const char* b3 = b2 + kstep;
            if (last && has_next) S.a_ready(nxt);
            if constexpr (SP2) {
            PG8_LDB(B0, 0, 0); PG8_LDB(B1, 0, 1); PG8_SCHED; PG8_LDA(At, 0, 0); PG8_STAGE(PG8_SA(1, 1), a1 + hstep, voffA);
            PG8_WAIT_V(8); PG8_WAIT_L(0); PG8_BAR; PG8_MMA(0, 0, At, B0); PG8_MMA(0, 1, At, B1); PG8_BAR; PG8_SCHED;
            PG8_LDA(At, 0, 1); PG8_STAGE(PG8_SB(0, 0), b2, voffB); PG8_STAGE(PG8_SB(0, 1), b2 + hstep, voffB); PG8_STAGE(PG8_SA(0, 0), a2, voffA);
            PG8_WAIT_V(8); PG8_WAIT_L(0); PG8_BAR; PG8_MMA(1, 0, At, B0); PG8_MMA(1, 1, At, B1); PG8_BAR; PG8_SCHED;
            PG8_LDB(B0, 1, 0); PG8_LDB(B1, 1, 1); PG8_SCHED; PG8_LDA(At, 1, 0); PG8_STAGE(PG8_SA(0, 1), a2 + hstep, voffA);
            PG8_WAIT_V(8); PG8_WAIT_L(0); PG8_BAR; PG8_MMA(0, 0, At, B0); PG8_MMA(0, 1, At, B1); PG8_BAR; PG8_SCHED;
            PG8_LDA(At, 1, 1); PG8_STAGE(PG8_SB(1, 0), b3, voffB); PG8_STAGE(PG8_SB(1, 1), b3 + hstep, voffB); PG8_STAGE(PG8_SA(1, 0), a3, voffA);
            PG8_WAIT_V(8); PG8_WAIT_L(0); PG8_BAR; PG8_MMA(1, 0, At, B0); PG8_MMA(1, 1, At, B1); PG8_BAR; PG8_SCHED;
            } else {
            PG8_LDB(B0, 0, 0); PG8_SCHED; PG8_LDA(At, 0, 0); PG8_STAGE(PG8_SA(1, 1), a1 + hstep, voffA);
            PG8_WAIT_L(8); PG8_BAR; PG8_WAIT_L(0); PG8_MMA(0, 0, At, B0); PG8_BAR; PG8_SCHED;
            PG8_LDB(B1, 0, 1); PG8_STAGE(PG8_SB(0, 0), b2, voffB);
            PG8_BAR; PG8_WAIT_L(0); PG8_MMA(0, 1, At, B1); PG8_BAR;
            PG8_LDA(At, 0, 1); PG8_STAGE(PG8_SA(0, 0), a2, voffA);
            PG8_BAR; PG8_WAIT_L(0); PG8_MMA(1, 0, At, B0); PG8_BAR; PG8_SCHED;
            PG8_STAGE(PG8_SB(0, 1), b2 + hstep, voffB);
            PG8_WAIT_V(6); PG8_BAR; PG8_MMA(1, 1, At, B1); PG8_BAR;
            PG8_LDB(B0, 1, 0); PG8_SCHED; PG8_LDA(At, 1, 0); PG8_STAGE(PG8_SA(0, 1), a2 + hstep, voffA);
            PG8_WAIT_L(8); PG8_BAR; PG8_WAIT_L(0); PG8_MMA(0, 0, At, B0); PG8_BAR; PG8_SCHED;
            PG8_LDB(B1, 1, 1); PG8_STAGE(PG8_SB(1, 0), b3, voffB);
            PG8_BAR; PG8_WAIT_L(0); PG8_MMA(0, 1, At, B1); PG8_BAR;
            PG8_LDA(At, 1, 1); PG8_STAGE(PG8_SA(1, 0), a3, voffA);
            PG8_BAR; PG8_WAIT_L(0); PG8_MMA(1, 0, At, B0); PG8_BAR; PG8_SCHED;
            PG8_STAGE(PG8_SB(1, 1), b3 + hstep, voffB);
            PG8_WAIT_V(6); PG8_BAR; PG8_MMA(1, 1, At, B1); PG8_BAR;
            }
        }
        if constexpr (ALIGN_EPI) { if (wr == 0) PG8_BAR; }
        if constexpr (!Epi::AFTER_DRAIN) { E(acc, cur, wr, wc, fr, fq); S.done(cur); }
        if (!has_next) break;
#pragma unroll
        for (int a = 0; a < 2; ++a)
#pragma unroll
            for (int b = 0; b < 2; ++b)
#pragma unroll
                for (int m = 0; m < 4; ++m)
#pragma unroll
                    for (int n = 0; n < 2; ++n) acc[a][b][m][n] = (f32x4){0.f, 0.f, 0.f, 0.f};
        cur = nxt; cA = nA; cB = nB; ++ui;
        if constexpr (ALIGN_EPI) { if (wr == 1) PG8_BAR; }
    }
    PG8_WAIT_V(0);
    if constexpr (!ALIGN_EPI) { if (wr == 0) PG8_BAR; }
    PG8_BAR;
    if constexpr (Epi::AFTER_DRAIN) { E.fused(acc, cur, wr, wc, fr, fq, lds, wid, lane); S.done(cur); }
#undef PG8_SA
#undef PG8_SB
#undef PG8_STAGE
#undef PG8_LDA
#undef PG8_LDB
#undef PG8_MMA
#undef PG8_WAIT_V
#undef PG8_WAIT_L
#undef PG8_BAR
#undef PG8_SCHED
}
}

#include <hip/hip_bf16.h>
namespace att {
using bf16x8=__attribute__((ext_vector_type(8)))short;
using s16x4=__attribute__((ext_vector_type(4)))short;
using f32x16=__attribute__((ext_vector_type(16)))float;
using u32x4=__attribute__((ext_vector_type(4)))unsigned;
using u32x2=__attribute__((ext_vector_type(2)))unsigned;
using bf16x4=__attribute__((ext_vector_type(4)))short;
constexpr int NW=8,QBLK=32,KVBLK=64;
__device__ __forceinline__ int crow(int r,int hi){return (r&3)+8*(r>>2)+4*hi;}
#define SBAR() __builtin_amdgcn_sched_barrier(0)
template<int VAR> __device__ __forceinline__ void amask(f32x16&p0,f32x16&p1,int keybase,int qpos,int lower,int hi){
  const float NEG=-INFINITY; int kb=keybase+4*hi; asm volatile("":"+v"(kb));
  #pragma unroll
  for(int r=0;r<16;++r){const int kv=kb+(r&3)+8*(r>>2); bool m0=kv>qpos,m1=kv+32>qpos; if(VAR==2){m0=m0||(kv<lower);m1=m1||(kv+32<lower);} if(m0)p0[r]=NEG; if(m1)p1[r]=NEG;}
}
constexpr int NSLOT=3, SLOTB=8192;
constexpr int LDS_K=0, LDS_V=NSLOT*SLOTB, LDS_WS=2*NSLOT*SLOTB, LDS_OST=LDS_WS+NW*64*4, LDS_CB=LDS_OST+NW*4096, LDS_BYTES_ATT=LDS_CB+32768;
__device__ __forceinline__ void glds16(const void*gsrc,unsigned lds_dst){unsigned keep;
  asm volatile("s_mov_b32 %0, m0\n\ts_mov_b32 m0, %2\n\ts_nop 0\n\tglobal_load_lds_dwordx4 %1, off\n\ts_mov_b32 m0, %0":"=&s"(keep):"v"(gsrc),"s"(lds_dst):"memory");}
__device__ __forceinline__ float max3f(float a,float b,float c){float r;asm("v_max3_f32 %0, %1, %2, %3":"=v"(r):"v"(a),"v"(b),"v"(c));return r;}
__device__ __forceinline__ float max2f(float a,float b){float r;asm("v_max_f32_e32 %0, %1, %2":"=v"(r):"v"(a),"v"(b));return r;}
__device__ __forceinline__ float fadd_s(float a,float b){float r;asm("v_add_f32_e32 %0, %1, %2":"=v"(r):"v"(a),"v"(b));return r;}
__device__ __forceinline__ float fsub_s(float a,float b){float r;asm("v_sub_f32_e32 %0, %1, %2":"=v"(r):"v"(a),"v"(b));return r;}
typedef float f32x2_t __attribute__((ext_vector_type(2))); typedef __bf16 bf16x2_t __attribute__((ext_vector_type(2)));
__device__ __forceinline__ unsigned cvtpk_s(float lo,float hi){f32x2_t v={lo,hi};bf16x2_t b=__builtin_convertvector(v,bf16x2_t);return __builtin_bit_cast(unsigned,b);}
#define WAIT_BAR(N) asm volatile("s_waitcnt vmcnt(" #N ") lgkmcnt(0)\n\ts_barrier":::"memory")
typedef __attribute__((address_space(3))) const char* lds_cptr;
typedef short v4i16_t __attribute__((ext_vector_type(4)));
template<int VAR> __device__ __forceinline__ void qkt(f32x16&p0,f32x16&p1,const char*Kslot,const bf16x8*qr,int r32,int hi,bf16x4 kb0,bf16x4 kb1,bf16x4 qone){
  const f32x16 negm=f32x16{};
  const char*kb=Kslot+hi*1024+r32*16;
  #pragma unroll
  for(int d0=0;d0<4;++d0){
    const bf16x8 b0=*reinterpret_cast<const bf16x8*>(kb+d0*2048);
    const bf16x8 b1=*reinterpret_cast<const bf16x8*>(kb+d0*2048+512);
    if(d0==0){p0=__builtin_amdgcn_mfma_f32_32x32x16_bf16(b0,qr[0],negm,0,0,0);p1=__builtin_amdgcn_mfma_f32_32x32x16_bf16(b1,qr[0],negm,0,0,0);}
    else{p0=__builtin_amdgcn_mfma_f32_32x32x16_bf16(b0,qr[d0],p0,0,0,0);p1=__builtin_amdgcn_mfma_f32_32x32x16_bf16(b1,qr[d0],p1,0,0,0);}}
  if(VAR==0){p0=__builtin_amdgcn_mfma_f32_32x32x8bf16_1k(kb0,qone,p0,0,0,0);p1=__builtin_amdgcn_mfma_f32_32x32x8bf16_1k(kb1,qone,p1,0,0,0);}
}
__device__ __forceinline__ void kload8(bf16x8*kf,lds_cptr kp){
  kf[0]=*(const __attribute__((address_space(3))) bf16x8*)(kp);      kf[1]=*(const __attribute__((address_space(3))) bf16x8*)(kp+512);
  kf[2]=*(const __attribute__((address_space(3))) bf16x8*)(kp+2048); kf[3]=*(const __attribute__((address_space(3))) bf16x8*)(kp+2560);
  kf[4]=*(const __attribute__((address_space(3))) bf16x8*)(kp+4096); kf[5]=*(const __attribute__((address_space(3))) bf16x8*)(kp+4608);
  kf[6]=*(const __attribute__((address_space(3))) bf16x8*)(kp+6144); kf[7]=*(const __attribute__((address_space(3))) bf16x8*)(kp+6656);
}
__device__ __forceinline__ void kload2(bf16x8*kf,lds_cptr kp,int j){ kf[2*j]=*(const __attribute__((address_space(3))) bf16x8*)(kp+j*2048); kf[2*j+1]=*(const __attribute__((address_space(3))) bf16x8*)(kp+j*2048+512); }
__device__ __forceinline__ s16x4 vtr(lds_cptr p){ return __builtin_bit_cast(s16x4,__builtin_amdgcn_ds_read_tr16_b64_v4i16((__attribute__((address_space(3))) v4i16_t*)p)); }
__device__ __forceinline__ float rowmax(const f32x16&p0,const f32x16&p1){
  float a=max3f(p0[0],p0[1],p1[0]),b=max3f(p0[2],p0[3],p1[1]);a=max3f(a,p1[2],p1[3]);
  #pragma unroll
  for(int r=4;r<16;r+=4){a=max3f(a,p0[r],p0[r+1]);b=max3f(b,p0[r+2],p0[r+3]);a=max3f(a,p1[r],p1[r+1]);b=max3f(b,p1[r+2],p1[r+3]);}
  const float m=max2f(a,b);
  auto rr=__builtin_amdgcn_permlane32_swap(__float_as_uint(m),__float_as_uint(m),false,false);
  return max2f(__uint_as_float(rr[0]),__uint_as_float(rr[1]));
}
__device__ __forceinline__ void pv(f32x16*o,int vb,bf16x8 pa0,bf16x8 pa1,bf16x8 pa2,bf16x8 pa3){
  #pragma unroll
  for(int d0=0;d0<2;++d0){s16x4 lo[4],hi[4];
    #pragma unroll
    for(int ks=0;ks<4;++ks){
      asm volatile("ds_read_b64_tr_b16 %0,%1 offset:%c2":"=&v"(lo[ks]):"v"(vb),"i"(d0*4096+ks*1024):"memory");
      asm volatile("ds_read_b64_tr_b16 %0,%1 offset:%c2":"=&v"(hi[ks]):"v"(vb),"i"(d0*4096+ks*1024+512):"memory");}
    asm volatile("s_waitcnt lgkmcnt(0)":::"memory");SBAR();
    #define PK(k) (bf16x8){lo[k][0],lo[k][1],lo[k][2],lo[k][3],hi[k][0],hi[k][1],hi[k][2],hi[k][3]}
    o[d0]=__builtin_amdgcn_mfma_f32_32x32x16_bf16(pa0,PK(0),o[d0],0,0,0);
    o[d0]=__builtin_amdgcn_mfma_f32_32x32x16_bf16(pa1,PK(1),o[d0],0,0,0);
    o[d0]=__builtin_amdgcn_mfma_f32_32x32x16_bf16(pa2,PK(2),o[d0],0,0,0);
    o[d0]=__builtin_amdgcn_mfma_f32_32x32x16_bf16(pa3,PK(3),o[d0],0,0,0);
    #undef PK
  }
}
template<int VAR,int THRL> __device__ __forceinline__ void attn_unit(int b,int hx,int ux,const bf16*QKVb,bf16*Ob,const float*gates,const float*Cc,const unsigned long long*SEL,char*shm){
  int tid_=threadIdx.x; asm volatile("":"+v"(tid_));
  const int tid=tid_,lane=tid&63,r32=lane&31,hi=lane>>5; const int wid=__builtin_amdgcn_readfirstlane(tid>>6);
  const long rowbase=(long)b*SEQ;
  const int head=(VAR==0)?hx:(hx*4+(wid>>1));
  const int row0=(VAR==0)?(ux*256+wid*32):(ux*64+(wid&1)*32);
  const int qcol=(VAR==0)?(C_QF+hx*64):(C_QA+head*64);
  const int kcol=(VAR==0)?(C_KF+hx*64):(VAR==1)?(C_SK+hx*64):(C_WK+hx*64);
  const int vcol=(VAR==0)?(C_VF+hx*64):(VAR==1)?(C_SV+hx*64):(C_WV+hx*64);
  const int NTreal=(VAR==0)?(4*ux+4):(VAR==1)?(ux+1):((ux<8?ux:8)+1);
  const int NT=NTreal<4?4:((NTreal+1)&~1);
  const int tdiag=ux;
  #define TNOM(t) ((VAR==2)?(tdiag-(t)):(t))
  #define TACT(t) ((VAR==2)?((tdiag-(t))<0?0:(tdiag-(t))):(t))
  const bf16*Qw=QKVb+(rowbase+row0)*QP+qcol;
  const bf16*Kh=QKVb+rowbase*QP+kcol,*Vh=QKVb+rowbase*QP+vcol;
  const unsigned lds0=(unsigned)(uintptr_t)shm;
  float*wsf=(float*)(shm+LDS_WS)+wid*64;
  const bf16*ksrc=Kh+(long)lane*QP+wid*8;
  const bf16*vsrc=Vh+(long)(16*(wid&3)+(lane>>2))*QP+(wid>>2)*32+(lane&3)*8;
  const unsigned kdst=lds0+LDS_K+wid*1024, vdst=lds0+LDS_V+wid*1024;
  #define DMA_K(t,slot) glds16(ksrc+(long)TACT(t)*KVBLK*QP,(unsigned)__builtin_amdgcn_readfirstlane(kdst+(slot)))
  #define DMA_V(t,slot) glds16(vsrc+(long)TACT(t)*KVBLK*QP,(unsigned)__builtin_amdgcn_readfirstlane(vdst+(slot)))
  const int vb0=(int)(lds0+LDS_V)+((lane>>4)&1)*32+(lane&3)*8+(4*hi+((lane&15)>>2))*64;
  const char*Kbase=shm+LDS_K; bf16x8 kf[8];
  const lds_cptr shm3=(lds_cptr)shm; const lds_cptr kp0=shm3+LDS_K+hi*1024+r32*16; const lds_cptr vp0=shm3+LDS_V+((lane>>4)&1)*32+(lane&3)*8+(4*hi+((lane&15)>>2))*64;
  const __attribute__((address_space(3))) u32x2* cb3=(const __attribute__((address_space(3))) u32x2*)(shm3+LDS_CB);
  DMA_K(0,0);DMA_V(0,0);DMA_K(1,SLOTB);
  bf16x8 qr[4];
  #pragma unroll
  for(int d0=0;d0<4;++d0)qr[d0]=*reinterpret_cast<const bf16x8*>(&Qw[(long)r32*QP+d0*16+hi*8]);
  const int qpos=row0+r32; const int lower=(VAR==2)?((qpos-511)<0?0:(qpos-511)):0;
  unsigned long long sel=~0ull; if(VAR==1)sel=SEL[(size_t)(rowbase+qpos)*2+hx];
  bf16x4 qone=bf16x4{};
  #define QONE() do{ if(VAR==0){ int hi_=hi; asm volatile("":"+v"(hi_)); u32x2 q1=(hi_==0)?u32x2{0x3F803F80u,0x00003F80u}:u32x2{0u,0u}; qone=__builtin_bit_cast(bf16x4,q1);} }while(0)
  bf16x4 kb0=bf16x4{},kb1=bf16x4{};
  #define KBLOAD(t) do{ if(VAR==0){ const u32x2 w0_=cb3[64*(t)+r32], w1_=cb3[64*(t)+32+r32]; \
      u32x2 a0_=(hi==0)?w0_:u32x2{0u,0u}; u32x2 a1_=(hi==0)?w1_:u32x2{0u,0u}; \
      kb0=__builtin_bit_cast(bf16x4,a0_); kb1=__builtin_bit_cast(bf16x4,a1_);} }while(0)
  float mhat=0.f,l_reg=0.f;f32x16 o[2];o[0]=f32x16{};o[1]=f32x16{};const f32x16 zero16=f32x16{};
  #define CMASK(P0,P1,t) do{ amask<VAR>(P0,P1,64*TNOM(t),qpos,lower,hi); }while(0)
  bool resc=false;
  #define START(P0,P1) do{ const float rm=rowmax(P0,P1); resc=false; mhat=rm; \
      _Pragma("unroll") for(int r=0;r<16;++r){P0[r]=fsub_s(P0[r],rm);P1[r]=fsub_s(P1[r],rm);} \
    _Pragma("unroll") for(int r=0;r<16;++r)P0[r]=__builtin_amdgcn_exp2f(P0[r]); }while(0)
  #define RESC() do{ if(resc){ asm volatile("s_waitcnt lgkmcnt(0)":::"memory"); const float*wq_=wsf+4*hi; asm volatile("":"+v"(wq_)); \
      _Pragma("unroll") for(int d_=0;d_<2;++d_) _Pragma("unroll") for(int r=0;r<16;++r)o[d_][r]*=wq_[(r&3)+8*(r>>2)]; } }while(0)
  f32x16 pA0,pA1,pB0,pB1;
  int sl_prev=0,sl_cur=0,sl_next=SLOTB;
  #define ROT() do{sl_prev=sl_cur;sl_cur=sl_next;sl_next=(sl_next==(NSLOT-1)*SLOTB)?0:sl_next+SLOTB;}while(0)
  DMA_K(2,2*SLOTB);
  WAIT_BAR(3);
  KBLOAD(0); QONE();
  qkt<VAR>(pA0,pA1,Kbase,qr,r32,hi,kb0,kb1,qone);asm volatile("s_nop 15\n\ts_nop 7":"+v"(pA0),"+v"(pA1));CMASK(pA0,pA1,0);
  START(pA0,pA1);
  _Pragma("unroll") for(int r=0;r<16;++r)pA1[r]=__builtin_amdgcn_exp2f(pA1[r]);
  WAIT_BAR(0);
  DMA_K(3,0);DMA_V(1,SLOTB);
  ROT();
  kload8(kf,kp0+sl_cur);
  WAIT_BAR(2);
  s16x4 vlo[8],vhi[8]; u32x4 pw0,pw1,pw2,pw3;
  #define PKW(P,B) cvtpk_s(P[B],P[B+1])
  #define PAF(k) __builtin_bit_cast(bf16x8,pw##k)
  #define VFR(i) (bf16x8){vlo[i][0],vlo[i][1],vlo[i][2],vlo[i][3],vhi[i][0],vhi[i][1],vhi[i][2],vhi[i][3]}
  #define PIN(x) asm volatile("":"+v"(x))
  #define MX3(a,b,c) __builtin_fmaxf(__builtin_fmaxf((a),(b)),(c))
  #define GAPA(MF,A0,A1,A2,A3,W0,W1,PW) do{ MF; sacc+=A0; sacc+=A1; sacc+=A2; sacc+=A3; PIN(sacc); W0; W1; PIN(PW); SBAR(); }while(0)
  #define EX(v) __builtin_amdgcn_exp2f(v)
  #define GAPB(MF,X,B) do{ MF; X[B]=EX(X[B]-mhe); X[B+1]=EX(X[B+1]-mhe); X[B+2]=EX(X[B+2]-mhe); X[B+3]=EX(X[B+3]-mhe); PIN(X); SBAR(); }while(0)
  #define VRD(i) do{ vlo[i]=vtr(vp_+(((i)>>2)*4096+((i)&3)*1024)); vhi[i]=vtr(vp_+(((i)>>2)*4096+((i)&3)*1024+512)); }while(0)
  #define KRD(G,j) do{ if(G){ kload2(kf,kp0+sl_next,j); SBAR(); } }while(0)
  #define STEP(C0,C1,P0,P1,t,GK,GV,GL) do{ SBAR(); \
    const lds_cptr vp_=vp0+sl_prev; \
    VRD(0); SBAR(); float sacc=(P0[0]+P0[1]); \
    GAPA(C0=__builtin_amdgcn_mfma_f32_32x32x16_bf16(kf[0],qr[0],zero16,0,0,0), P0[2],P0[3],P0[4],P0[5],     pw0[0]=PKW(P0,0), pw0[1]=PKW(P0,2), pw0); \
    VRD(4); SBAR(); GAPA(C1=__builtin_amdgcn_mfma_f32_32x32x16_bf16(kf[1],qr[0],zero16,0,0,0), P0[6],P0[7],P0[8],P0[9],     pw0[2]=PKW(P0,4), pw0[3]=PKW(P0,6), pw0); \
    VRD(1); SBAR(); GAPA(C0=__builtin_amdgcn_mfma_f32_32x32x16_bf16(kf[2],qr[1],C0,0,0,0),   P0[10],P0[11],P0[12],P0[13], pw1[0]=PKW(P0,8), pw1[1]=PKW(P0,10), pw1); \
    VRD(5); SBAR(); GAPA(C1=__builtin_amdgcn_mfma_f32_32x32x16_bf16(kf[3],qr[1],C1,0,0,0),   P0[14],P0[15],P1[0],P1[1],   pw1[2]=PKW(P0,12),pw1[3]=PKW(P0,14), pw1); \
    VRD(2); SBAR(); GAPA(C0=__builtin_amdgcn_mfma_f32_32x32x16_bf16(kf[4],qr[2],C0,0,0,0),   P1[2],P1[3],P1[4],P1[5],     pw2[0]=PKW(P1,0), pw2[1]=PKW(P1,2), pw2); \
    VRD(6); SBAR(); GAPA(C1=__builtin_amdgcn_mfma_f32_32x32x16_bf16(kf[5],qr[2],C1,0,0,0),   P1[6],P1[7],P1[8],P1[9],     pw2[2]=PKW(P1,4), pw2[3]=PKW(P1,6), pw2); \
    KBLOAD(t); \
    VRD(3); SBAR(); GAPA(C0=__builtin_amdgcn_mfma_f32_32x32x16_bf16(kf[6],qr[3],C0,0,0,0),   P1[10],P1[11],P1[12],P1[13], pw3[0]=PKW(P1,8), pw3[1]=PKW(P1,10), pw3); \
    VRD(7); SBAR(); GAPA(C1=__builtin_amdgcn_mfma_f32_32x32x16_bf16(kf[7],qr[3],C1,0,0,0),   P1[14],P1[15],0.f,0.f,       pw3[2]=PKW(P1,12),pw3[3]=PKW(P1,14), pw3); \
    l_reg+=sacc; \
    if(VAR==0){ QONE(); C0=__builtin_amdgcn_mfma_f32_32x32x8bf16_1k(kb0,qone,C0,0,0,0); C1=__builtin_amdgcn_mfma_f32_32x32x8bf16_1k(kb1,qone,C1,0,0,0); SBAR(); } \
    if(GK){DMA_K((t)+3,sl_cur);} if(GV){DMA_V((t)+1,sl_next);} \
    CMASK(C0,C1,t); \
    float mhe; \
    { float a=MX3(C0[0],C0[1],C1[0]),b=MX3(C0[2],C0[3],C1[1]); a=MX3(a,C1[2],C1[3]); \
      _Pragma("unroll") for(int r=4;r<16;r+=4){a=MX3(a,C0[r],C0[r+1]);b=MX3(b,C0[r+2],C0[r+3]);a=MX3(a,C1[r],C1[r+1]);b=MX3(b,C1[r+2],C1[r+3]);} \
      float rm=__builtin_fmaxf(a,b); { auto rr=__builtin_amdgcn_permlane32_swap(__float_as_uint(rm),__float_as_uint(rm),false,false); rm=__builtin_fmaxf(__uint_as_float(rr[0]),__uint_as_float(rr[1])); } \
      bool on_=true; if(VAR==1) on_=((sel>>(t))&1ull)!=0ull; \
      rm=on_?(rm-mhat):-INFINITY; \
      resc=false; \
      if(__builtin_expect(__any(rm>(float)THRL),0)){ const float dl=__builtin_fmaxf(rm,0.f); mhat+=dl; \
        const float f=__builtin_amdgcn_exp2f(-dl); l_reg*=f; if(hi==0)wsf[r32]=f; resc=true; } \
      mhe=on_?mhat:INFINITY; } \
    SBAR(); \
    GAPB(o[0]=__builtin_amdgcn_mfma_f32_32x32x16_bf16(PAF(0),VFR(0),o[0],0,0,0), C0,0); \
    GAPB(o[1]=__builtin_amdgcn_mfma_f32_32x32x16_bf16(PAF(0),VFR(4),o[1],0,0,0), C0,4); \
    KRD(GL,0); GAPB(o[0]=__builtin_amdgcn_mfma_f32_32x32x16_bf16(PAF(1),VFR(1),o[0],0,0,0), C0,8); \
    KRD(GL,1); GAPB(o[1]=__builtin_amdgcn_mfma_f32_32x32x16_bf16(PAF(1),VFR(5),o[1],0,0,0), C0,12); \
    KRD(GL,2); GAPB(o[0]=__builtin_amdgcn_mfma_f32_32x32x16_bf16(PAF(2),VFR(2),o[0],0,0,0), C1,0); \
    KRD(GL,3); GAPB(o[1]=__builtin_amdgcn_mfma_f32_32x32x16_bf16(PAF(2),VFR(6),o[1],0,0,0), C1,4); \
    GAPB(o[0]=__builtin_amdgcn_mfma_f32_32x32x16_bf16(PAF(3),VFR(3),o[0],0,0,0), C1,8); \
    GAPB(o[1]=__builtin_amdgcn_mfma_f32_32x32x16_bf16(PAF(3),VFR(7),o[1],0,0,0), C1,12); \
    }while(0)
  int t=1;
  #undef CMASK
  #define CMASK(P0,P1,t) do{}while(0)
  for(;t+5<NT;t+=2){
    STEP(pB0,pB1,pA0,pA1,t,true,true,true);     WAIT_BAR(2); RESC(); ROT();
    STEP(pA0,pA1,pB0,pB1,t+1,true,true,true);   WAIT_BAR(2); RESC(); ROT();
  }
  #undef CMASK
  #define CMASK(P0,P1,t) do{ amask<VAR>(P0,P1,64*TNOM(t),qpos,lower,hi); }while(0)
  #define ENDW(tt) do{ if((tt)+3<NT){WAIT_BAR(2);} else if((tt)+2<NT){WAIT_BAR(1);} else {WAIT_BAR(0);} }while(0)
  for(;t+1<NT;t+=2){
    STEP(pB0,pB1,pA0,pA1,t,(t+3<NT),(t+1<NT),(t+1<NT));       ENDW(t);   RESC(); ROT();
    STEP(pA0,pA1,pB0,pB1,t+1,(t+4<NT),(t+2<NT),(t+2<NT));     ENDW(t+1); RESC(); ROT();
  }
  STEP(pB0,pB1,pA0,pA1,NT-1,false,false,false); RESC();
  { float sacc=pB0[0]+pB0[1]; _Pragma("unroll") for(int r=2;r<16;++r)sacc+=pB0[r]; _Pragma("unroll") for(int r=0;r<16;++r)sacc+=pB1[r]; l_reg+=sacc;
    pw0=(u32x4){PKW(pB0,0),PKW(pB0,2),PKW(pB0,4),PKW(pB0,6)};pw1=(u32x4){PKW(pB0,8),PKW(pB0,10),PKW(pB0,12),PKW(pB0,14)};pw2=(u32x4){PKW(pB1,0),PKW(pB1,2),PKW(pB1,4),PKW(pB1,6)};pw3=(u32x4){PKW(pB1,8),PKW(pB1,10),PKW(pB1,12),PKW(pB1,14)};
    SBAR(); pv(o,vb0+sl_cur,PAF(0),PAF(1),PAF(2),PAF(3)); }
  #undef PKW
  #undef PAF
  #undef VFR
  #undef PIN
  #undef MX3
  #undef GAPA
  #undef GAPB
  #undef EX
  #undef VRD
  #undef KRD
  #undef STEP
  #undef ENDW
  {auto rr=__builtin_amdgcn_permlane32_swap(__float_as_uint(l_reg),__float_as_uint(l_reg),false,false);l_reg=__uint_as_float(rr[0])+__uint_as_float(rr[1]);}
  if(VAR!=0){ const float gv=gates[(size_t)(rowbase+qpos)*24+head*3+VAR]; l_reg=l_reg/gv; }
  if(hi==0)wsf[32+r32]=l_reg;asm volatile("s_waitcnt lgkmcnt(0)":::"memory");
  float rli[16];
  { const float*wq_=wsf+32+4*hi; asm volatile("":"+v"(wq_));
  #pragma unroll
  for(int r=0;r<16;++r)rli[r]=__builtin_amdgcn_rcpf(wq_[(r&3)+8*(r>>2)]); }
  bf16*Ow=Ob+(rowbase+row0)*512+head*64;
  { bf16*stg=(bf16*)(shm+LDS_OST)+wid*2048; bf16*sq_=stg+(4*hi)*64+r32; asm volatile("":"+v"(sq_));
    #pragma unroll
    for(int r=0;r<16;++r){const int orow=(r&3)+8*(r>>2);
      #pragma unroll
      for(int d0=0;d0<2;++d0)sq_[orow*64+d0*32]=f2bf(o[d0][r]*rli[r]);}
    asm volatile("s_waitcnt lgkmcnt(0)":::"memory");
    #pragma unroll
    for(int i=0;i<4;++i){const int row=i*8+(lane>>3),ch=lane&7; const u32x4 v=*(const u32x4*)(stg+row*64+ch*8); *(u32x4*)(Ow+(long)row*512+ch*8)=v;} }
  asm volatile("s_waitcnt lgkmcnt(0)\n\ts_barrier":::"memory");
  #undef DMA_K
  #undef DMA_V
  #undef CMASK
  #undef SELMASK
  #undef START
  #undef RESC
  #undef ROT
  #undef KBLOAD
  #undef QONE
  #undef TNOM
  #undef TACT
}
#undef SBAR
#undef WAIT_BAR
}
#define LAS __attribute__((address_space(3)))
typedef unsigned v4u __attribute__((ext_vector_type(4)));
typedef float f32x4 __attribute__((ext_vector_type(4)));
constexpr int NWAVES = 8;
#ifndef NEW_FOX
#define NEW_FOX 1
#endif
#ifndef NEW_SLC
#define NEW_SLC 1
#endif
#ifndef NEW_WIN
#define NEW_WIN 1
#endif
constexpr int RING_BYTES = 131072, LDS_BYTES = 147456;

__device__ __forceinline__ unsigned pk2(float lo, float hi) { return (unsigned)f2bf(lo) | ((unsigned)f2bf(hi) << 16); }
__device__ __forceinline__ int src_win(int np) {
    const int tile = np >> 8, w = np & 255;
    if (tile == 11) { if (w < 24) return 1280 + w; if (w < 32) return 2840 + (w - 24); return -1; }
    const int half = w >> 7, head = (w >> 5) & 3, i = w & 31;
    const int c = tile * 256 + head * 64 + half * 32 + i;
    return c < 1280 ? c : c + 24;
}
__device__ __forceinline__ void transpose_item(const float* W, int N, int K, const float* gain, bf16* WT, int n0, int k0, int sc, LAS float* scr, int lane) {
#pragma unroll 8
    for (int i = 0; i < 32; ++i) { const int kk = 2 * i + (lane >> 5); float v = sc >= 0 ? W[(size_t)(k0 + kk) * N + sc] : 0.f; if (gain) v *= gain[k0 + kk]; scr[kk * 33 + (lane & 31)] = v; }
    asm volatile("s_waitcnt lgkmcnt(0)" ::: "memory");
    const int c = lane & 7;
#pragma unroll
    for (int j = 0; j < 4; ++j) { const int n = (lane >> 3) + 8 * j; const LAS float* s = scr + (8 * c) * 33 + n;
        v4u o; o.x = pk2(s[0 * 33], s[1 * 33]); o.y = pk2(s[2 * 33], s[3 * 33]); o.z = pk2(s[4 * 33], s[5 * 33]); o.w = pk2(s[6 * 33], s[7 * 33]);
        *(v4u*)(WT + (size_t)(n0 + n) * K + k0 + 8 * c) = o; }
    asm volatile("s_waitcnt lgkmcnt(0)" ::: "memory");
}
__device__ __forceinline__ void ph_prep(const P& p, LAS unsigned char* lds) {
    const int tid = threadIdx.x, lane = tid & 63, wave = tid >> 6;
    const int gw = blockIdx.x * NWAVES + wave, NGW = gridDim.x * NWAVES;
    LAS float* scr = (LAS float*)(lds + wave * 16384);
    constexpr int I_GU = 176 * 16, I_D = 32 * 44, I_IN = 96 * 16, I_SQ = 32 * 16, I_PR = 32 * 4;
    constexpr int NITEMS = 2 * I_GU + 2 * I_D + I_IN + 2 * I_SQ + I_PR;
    for (int it = gw; it < NITEMS; it += NGW) {
        int r = it;
        if (r < 2 * I_GU) {
            const int second = r >= I_GU; if (second) r -= I_GU;
            const int ng = r / 16, kb = r % 16, n0 = ng * 32, tile = n0 >> 8, w = n0 & 255;
            const float* W = second ? (w < 128 ? p.in[25] : p.in[26]) : (w < 128 ? p.in[3] : p.in[4]);
            transpose_item(W, DFF, D, second ? p.in[24] : nullptr, (bf16*)(p.ws + (second ? WS_WGU2 : WS_WGU1)), n0, kb * 64, tile * 128 + (w & 127) + (lane & 31), scr, lane);
            continue; }
        r -= 2 * I_GU;
        if (r < 2 * I_D) {
            const int second = r >= I_D; if (second) r -= I_D;
            const int ng = r / 44, kb = r % 44;
            transpose_item(second ? p.in[27] : p.in[5], D, DFF, nullptr, (bf16*)(p.ws + (second ? WS_WD2 : WS_WD1)), ng * 32, kb * 64, ng * 32 + (lane & 31), scr, lane);
            continue; }
        r -= 2 * I_D;
        if (r < I_IN) { const int ng = r / 16, kb = r % 16;
            transpose_item(p.in[7], INW, D, p.in[6], (bf16*)(p.ws + WS_WIN), ng * 32, kb * 64, src_win(ng * 32 + (lane & 31)), scr, lane);
            continue; }
        r -= I_IN;
        if (r < 2 * I_SQ) { const int second = r >= I_SQ; if (second) r -= I_SQ;
            const int ng = r / 16, kb = r % 16;
            transpose_item(second ? p.in[29] : p.in[23], D, D, second ? p.in[28] : nullptr, (bf16*)(p.ws + (second ? WS_WGATE : WS_WOUT)), ng * 32, kb * 64, ng * 32 + (lane & 31), scr, lane);
            continue; }
        r -= 2 * I_SQ;
        { const int ng = r / 4, kb = r % 4;
          transpose_item(p.in[30], D, DPLE, nullptr, (bf16*)(p.ws + WS_WPROJ), ng * 32, kb * 64, ng * 32 + (lane & 31), scr, lane); }
    }
    { bf16* XN = (bf16*)(p.ws + WS_XN); const float* g1 = p.in[2];
      for (int m = gw; m < M; m += NGW) {
          const f32x4* xr = (const f32x4*)(p.in[0] + (size_t)m * D) + lane;
          f32x4 v[4]; float s = 0.f;
#pragma unroll
          for (int j = 0; j < 4; ++j) { v[j] = xr[64 * j]; s += (v[j][0] * v[j][0] + v[j][1] * v[j][1]) + (v[j][2] * v[j][2] + v[j][3] * v[j][3]); }
          s = wave_sum(s);
          const float rs = 1.0f / sqrtf(s * (1.f / D) + EPS);
          unsigned long long* o8 = (unsigned long long*)(XN + (size_t)m * D) + lane;
#pragma unroll
          for (int j = 0; j < 4; ++j) { const f32x4 gg = *((const f32x4*)g1 + lane + 64 * j);
              o8[64 * j] = (unsigned long long)pk2(v[j][0] * rs * gg[0], v[j][1] * rs * gg[1]) | ((unsigned long long)pk2(v[j][2] * rs * gg[2], v[j][3] * rs * gg[3]) << 32); }
      } }
    { const f32x4* src = (const f32x4*)p.in[1]; unsigned long long* dst = (unsigned long long*)(p.ws + WS_PB);
      for (size_t i = (size_t)blockIdx.x * 512 + tid; i < (size_t)M * DPLE / 4; i += (size_t)gridDim.x * 512) { const f32x4 v = src[i]; dst[i] = (unsigned long long)pk2(v[0], v[1]) | ((unsigned long long)pk2(v[2], v[3]) << 32); } }
    { float* rope = (float*)(p.ws + WS_ROPE);
      for (int i = blockIdx.x * 512 + tid; i < SEQ * 8; i += gridDim.x * 512) { const int t = i >> 3, f = i & 7;
          const double ang = (double)t * pow(500000.0, -(double)f / 8.0);
          rope[t * 16 + f] = (float)cos(ang); rope[t * 16 + 8 + f] = (float)sin(ang); } }
}

template <int VAR> __device__ __forceinline__ void ph_attn(const P& p, LAS unsigned char* lds) {
    char* shm = (char*)lds;
    const bf16* QKV = (const bf16*)(p.ws + WS_BIG);
    bf16* Ob = (bf16*)(p.ws + (VAR == 0 ? WS_OB : VAR == 1 ? WS_OS : WS_OW));
    const float* gates = (const float*)(p.ws + WS_GATES);
    const float* Cc = (const float*)(p.ws + WS_C);
    const unsigned long long* SEL = (const unsigned long long*)(p.ws + WS_SEL);
    const int G = gridDim.x, bx = blockIdx.x, tid = threadIdx.x;
    const int vcu0 = (G == 256) ? (bx % 8) * (G / 8) + bx / 8 : bx;
    int cur_bh = -1;
    for (int i = 0;; ++i) {
        const int L = i * G + vcu0; if (L >= 1024) break;
        const int vcu = L & 255, rnd = L >> 8;
        if (VAR == 0) {
            const int bh = vcu >> 2, s = vcu & 3, qb = rnd == 0 ? s : rnd == 1 ? 7 - s : rnd == 2 ? 8 + s : 15 - s;
            if (bh != cur_bh) {
                cur_bh = bh;
                __syncthreads();
                LAS unsigned* cb = (LAS unsigned*)(lds + att::LDS_CB);
                int k0_ = tid; asm volatile("" : "+v"(k0_));
#pragma unroll 1
                for (int k = k0_; k < SEQ; k += 512) { const float v = -Cc[(size_t)bh * SEQ + k] * LOG2E;
                    const bf16 h1 = f2bf(v); const float r1 = v - bf2f(h1); const bf16 h2 = f2bf(r1); const float r2 = r1 - bf2f(h2); const bf16 h3 = f2bf(r2);
                    cb[2 * k] = (unsigned)h1 | ((unsigned)h2 << 16); cb[2 * k + 1] = (unsigned)h3; }
                __syncthreads();
            }
            att::attn_unit<0, 8>(bh >> 3, bh & 7, qb, QKV, Ob, gates, Cc, SEL, shm);
        } else {
            const int bk = vcu >> 4, s = vcu & 15, blk = rnd == 0 ? s : rnd == 1 ? 31 - s : rnd == 2 ? 32 + s : 63 - s;
            att::attn_unit<VAR, 8>(bk >> 1, bk & 1, blk, QKV, Ob, gates, Cc, SEL, shm);
        }
    }
}

enum { PH_PREP = 0, PH_G1, PH_G2, PH_G3, PH_E, PH_G4, PH_G5, PH_G6, PH_G7, PH_FOX, PH_SLC, PH_WIN, PH_N };

__device__ __forceinline__ void run_main_phase(const P& p, LAS unsigned char* lds, int ph) {
    using namespace pg8;
    bf16* XN = (bf16*)(p.ws + WS_XN); bf16* XN2 = (bf16*)(p.ws + WS_O); bf16* HID = (bf16*)(p.ws + WS_BIG); bf16* EB = (bf16*)(p.ws + WS_E);
    float* SSQ1 = (float*)(p.ws + WS_SSQ1); float* SSQ2 = (float*)(p.ws + WS_SSQ2); float* SSQ3 = (float*)(p.ws + WS_SSQ3); float* SSQE = (float*)(p.ws + WS_SSQE);
    const int G = gridDim.x, c = blockIdx.x;
    switch (ph) {
    case PH_PREP: ph_prep(p, lds); break;
    case PH_G1: { Gemm g{XN, (const bf16*)(p.ws + WS_WGU1), M, 5632, D}; StaticOrder S; S.init(M, 5632, G, c); EpiSwiglu E{HID, nullptr};
        gemm_phase<EpiSwiglu, StaticOrder, true, true>(lds, g, S, E); } break;
    case PH_G2: { Gemm g{HID, (const bf16*)(p.ws + WS_WD1), M, D, DFF}; StaticOrder S; S.init(M, D, G, c); EpiResid E{p.in[0], p.out, XN, SSQ1, 0.5f};
        gemm_phase<EpiResid, StaticOrder, true, true>(lds, g, S, E); } break;
    case PH_G3: { Gemm g{XN, (const bf16*)(p.ws + WS_WIN), M, 3072, D}; StaticOrder S; S.init(M, 3072, G, c);
        EpiQKV E{HID, (float*)(p.ws + WS_GATES), (float*)(p.ws + WS_LOGF), SSQ1, (const float*)(p.ws + WS_ROPE), p.in[9], p.in[11], p.in[12], p.in[19], p.in[20], p.in[8]};
        gemm_phase<EpiQKV, StaticOrder, true, true>(lds, g, S, E); } break;
    case PH_E: { Gemm g{(const bf16*)(p.ws + WS_PB), (const bf16*)(p.ws + WS_WPROJ), M, D, DPLE}; StaticOrder S; S.init(M, D, G, c); EpiE E{EB, SSQE};
        gemm_phase<EpiE, StaticOrder, true, true>(lds, g, S, E); } break;
    case PH_G4: { Gemm g{XN, (const bf16*)(p.ws + WS_WOUT), M, D, D}; StaticOrder S; S.init(M, D, G, c); EpiResid E{p.out, p.out, XN2, SSQ2, 1.0f};
        gemm_phase<EpiResid, StaticOrder, true, true>(lds, g, S, E); } break;
    case PH_G5: { Gemm g{XN2, (const bf16*)(p.ws + WS_WGU2), M, 5632, D}; StaticOrder S; S.init(M, 5632, G, c); EpiSwiglu E{HID, SSQ2};
        gemm_phase<EpiSwiglu, StaticOrder, true, true>(lds, g, S, E); } break;
    case PH_G6: { Gemm g{HID, (const bf16*)(p.ws + WS_WD2), M, D, DFF}; StaticOrder S; S.init(M, D, G, c); EpiResid E{p.out, p.out, XN, SSQ3, 0.5f};
        gemm_phase<EpiResid, StaticOrder, true, true>(lds, g, S, E); } break;
    case PH_G7: { Gemm g{XN, (const bf16*)(p.ws + WS_WGATE), M, D, D}; StaticOrder S; S.init(M, D, G, c); EpiPle E{p.out, EB, SSQ3, SSQE, p.in[31]};
        gemm_phase<EpiPle, StaticOrder, true, true>(lds, g, S, E); } break;
    case PH_FOX: ph_attn<0>(p, lds); break;
    case PH_SLC: ph_attn<1>(p, lds); break;
    case PH_WIN: ph_attn<2>(p, lds); break;
    default: break;
    }
}

__global__ void __launch_bounds__(512, 2) k_main(P p, int ph) {
    extern __shared__ __attribute__((aligned(16))) unsigned char lds_raw[];
    run_main_phase(p, (LAS unsigned char*)lds_raw, ph);
}

__device__ __forceinline__ void run_phase(const P& p, float* sm, int ph, int bid, int nb) {
    switch (ph) {
    case 5: ph_compress(p, sm, bid, nb); ph_cumsum(p, bid, nb); break;
    case 6: ph_nsa(p, sm, bid, nb); break;
    case 7: ph_fox(p, sm, bid, nb); break;
    case 8: ph_groupnorm(p, bid, nb); break;
    default: break;
    }
}
__global__ void __launch_bounds__(256) k_phase(P p, int ph) {
    __shared__ float sm[16384];
    run_phase(p, sm, ph, blockIdx.x, gridDim.x);
}

extern "C" void kernel_launch(void* const* d_in, const int* in_sizes, int n_in, void* d_out, int out_size, void* d_ws, size_t ws_size, hipStream_t stream) {
    static int grid = 0;
    if (grid == 0) {
        if (n_in != 32 || out_size != M * D || ws_size < WS_END) { fprintf(stderr, "kernel_launch: unexpected sizes n_in %d out %d ws %zu\n", n_in, out_size, ws_size); grid = -1; return; }
        int dev = 0, cus = 0;
        hipGetDevice(&dev); hipDeviceGetAttribute(&cus, hipDeviceAttributeMultiprocessorCount, dev);
        if (hipFuncSetAttribute((const void*)k_main, hipFuncAttributeMaxDynamicSharedMemorySize, LDS_BYTES) != hipSuccess) { fprintf(stderr, "hipFuncSetAttribute failed\n"); grid = -1; return; }
        grid = cus;
    }
    if (grid < 0) return;
    P p{};
    for (int i = 0; i < 32; ++i) p.in[i] = (const float*)d_in[i];
    p.out = (float*)d_out; p.ws = (unsigned char*)d_ws;
    hipMemsetAsync((char*)d_ws + WS_CTL, 0, 1 * MiB, stream);
    const int seq_main1[] = {PH_PREP, PH_G1, PH_G2, PH_G3};
    for (int ph : seq_main1) hipLaunchKernelGGL(k_main, dim3(grid), dim3(512), LDS_BYTES, stream, p, ph);
    hipLaunchKernelGGL(k_phase, dim3(2048), dim3(256), 0, stream, p, 5);
    hipLaunchKernelGGL(k_phase, dim3(2048), dim3(256), 0, stream, p, 6);
#if NEW_FOX
    hipLaunchKernelGGL(k_main, dim3(grid), dim3(512), LDS_BYTES, stream, p, (int)PH_FOX);
#else
    hipLaunchKernelGGL(k_phase, dim3(2048), dim3(256), 0, stream, p, 7);
#endif
#if NEW_SLC
    hipLaunchKernelGGL(k_main, dim3(grid), dim3(512), LDS_BYTES, stream, p, (int)PH_SLC);
#endif
#if NEW_WIN
    hipLaunchKernelGGL(k_main, dim3(grid), dim3(512), LDS_BYTES, stream, p, (int)PH_WIN);
#endif
    hipLaunchKernelGGL(k_phase, dim3(2048), dim3(256), 0, stream, p, 8);
    const int seq_main2[] = {PH_E, PH_G4, PH_G5, PH_G6, PH_G7};
    for (int ph : seq_main2) hipLaunchKernelGGL(k_main, dim3(grid), dim3(512), LDS_BYTES, stream, p, ph);
}
```

```cpp
#include <hip/hip_runtime.h>
#include <hip/hip_cooperative_groups.h>
#include <cstdint>
#include <cstdio>
namespace cg = cooperative_groups;

typedef unsigned short bf16;
constexpr int BATCH = 8, SEQ = 4096, M = BATCH * SEQ, D = 1024, DFF = 2816, INW = 2848, DPLE = 256;
constexpr int QP = 64;
constexpr int HS = M * 64;
constexpr float EPS = 1e-6f;
constexpr float C2 = 0.125f * 1.4426950408889634f;
constexpr float LOG2E = 1.4426950408889634f;
constexpr int C_QA = 0, C_CK = 8 * HS, C_CV = 10 * HS, C_SK = 12 * HS, C_SV = 14 * HS, C_WK = 16 * HS, C_WV = 18 * HS, C_QF = 20 * HS, C_KF = 28 * HS, C_VF = 36 * HS;

constexpr size_t MiB = 1u << 20;
constexpr size_t WS_CTL = 0;
constexpr size_t WS_WGU1 = 2 * MiB, WS_WD1 = 13 * MiB, WS_WIN = 19 * MiB, WS_WOUT = 25 * MiB, WS_WGU2 = 27 * MiB, WS_WD2 = 38 * MiB, WS_WGATE = 44 * MiB, WS_WPROJ = 46 * MiB;
constexpr size_t WS_WC1 = 47 * MiB, WS_WC2 = 49 * MiB, WS_POSBP = 49 * MiB + 512 * 1024;
constexpr size_t WS_KCMP = 50 * MiB, WS_VCMP = 51 * MiB, WS_C = 52 * MiB, WS_GATES = 53 * MiB, WS_LOGF = 56 * MiB, WS_ROPE = 57 * MiB;
constexpr size_t WS_SSQ1 = 58 * MiB, WS_SSQ2 = 60 * MiB, WS_SSQ3 = 62 * MiB, WS_SSQE = 64 * MiB, WS_SEL = 66 * MiB;
constexpr size_t WS_POSBS = 66 * MiB + 512 * 1024;
constexpr size_t WS_SSQO = 67 * MiB;
constexpr size_t WS_GOUT = 49 * MiB + 768 * 1024;
constexpr size_t WS_PB = 70 * MiB;
constexpr size_t WS_XN = 88 * MiB;
constexpr size_t WS_O = 152 * MiB;
constexpr size_t WS_BIG = 216 * MiB;
constexpr size_t WS_E = 408 * MiB;
constexpr size_t WS_OMIX = WS_E;
constexpr size_t WS_H2F8 = 472 * MiB;
constexpr size_t WS_END = 504 * MiB;
constexpr bool F8_G1 = false, F8_G2 = true, F8_G5 = true, F8_G6 = true;

struct P {
    const float* in[32];
    float* out;
    unsigned char* ws;
    double rc[12];
};

__device__ __forceinline__ int opaque_tid(int wv) { int l; asm volatile("v_mbcnt_lo_u32_b32 %0, -1, 0\n\tv_mbcnt_hi_u32_b32 %0, -1, %0" : "=v"(l)); return (wv << 6) | l; }

__device__ __forceinline__ float bf2f(bf16 v) { return __uint_as_float((unsigned)v << 16); }
__device__ __forceinline__ bf16 f2bf(float f) { unsigned u = __float_as_uint(f); return (bf16)((u + 0x7fffu + ((u >> 16) & 1u)) >> 16); }
__device__ __forceinline__ float wave_sum(float v) {
#pragma unroll
    for (int o = 1; o < 64; o <<= 1) v += __shfl_xor(v, o);
    return v;
}
__device__ __forceinline__ float wave_max(float v) {
#pragma unroll
    for (int o = 1; o < 64; o <<= 1) v = fmaxf(v, __shfl_xor(v, o));
    return v;
}
__device__ __forceinline__ float sigmoidf_(float x) { return 1.f / (1.f + __expf(-x)); }
__device__ __forceinline__ float siluf_(float x) { return x / (1.f + __expf(-x)); }

__device__ __forceinline__ void ph_cumsum(const P& p, int bid, int nb, const int wv) {
    const float* logf_ = (const float*)(p.ws + WS_LOGF);
    float* C = (float*)(p.ws + WS_C);
    const int tid = opaque_tid(wv), lane = tid & 63, w = tid >> 6;
    for (int item = (nb - 1 - bid) * 8 + w; item < BATCH * 8; item += nb * 8) {
        const int b = item >> 3, h = item & 7;
        float carry = 0.f;
        for (int t0 = 0; t0 < SEQ; t0 += 256) {
            float v[4];
#pragma unroll
            for (int u = 0; u < 4; ++u) v[u] = logf_[(size_t)(b * SEQ + t0 + 64 * u + lane) * 8 + h];
#pragma unroll
            for (int u = 0; u < 4; ++u) {
#pragma unroll
                for (int o = 1; o < 64; o <<= 1) { const float x = __shfl_up(v[u], o); if (lane >= o) v[u] += x; }
                v[u] += carry;
                C[(size_t)item * SEQ + t0 + 64 * u + lane] = v[u];
                carry = __shfl(v[u], 63);
            }
        }
    }
}
namespace pg8 {
#define PG8_LAS __attribute__((address_space(3)))
typedef unsigned short bf16_t;
typedef short bf16x8 __attribute__((ext_vector_type(8)));
typedef float f32x4 __attribute__((ext_vector_type(4)));
typedef unsigned u32x4 __attribute__((ext_vector_type(4)));
constexpr int BM = 256, BK = 64, HALF = 128, HTB = HALF * BK * 2  , STAGE_BYTES = 8 * HTB, NXCD = 8, WGM = 8;

__host__ __device__ __forceinline__ int lds_byte(int r, int c) { const int st = (r >> 4) * 2 + (c >> 5), rr = r & 15, cc = c & 31, ob = rr * 64 + cc * 2; return st * 1024 + (ob ^ (((ob >> 9) & 1) << 5)); }
__host__ __device__ __forceinline__ void stage_rc(int b, int& R, int& C) { const int st = b / 1024, sb = b % 1024, swz = sb ^ (((sb >> 9) & 1) << 5); R = (st >> 1) * 16 + swz / 64; C = (st & 1) * 32 + (swz % 64) / 2; }
__host__ __device__ __forceinline__ int perm32(int rho) { const int n = rho >> 4, i = rho & 15; return 8 * (i >> 2) + 4 * n + (i & 3); }

struct Unit { int pm, pn; };
struct Gemm { const bf16_t* A; const bf16_t* Bt; int M, N, K; int rsA = 0, ksA = BK * 2, amode = 0; };
__device__ __forceinline__ const char* a_tile(const Gemm& g, const Unit& u) {
    if (g.amode == 0) return (const char*)g.A + (size_t)u.pm * BM * (g.rsA ? (size_t)g.rsA : (size_t)g.K * 2);
    const int b = u.pm >> 1, kvh = u.pm & 1;
    return (const char*)g.A + ((size_t)((u.pn ? 10 : 8) + kvh) * (32768 * 64) + (size_t)b * 4096 * 64) * 2;
}

struct StaticOrder {
    int nM, nN, nwg, G, c, rev;
    __host__ __device__ void init(int M, int N, int G_, int c_, int rev_ = 0) { nM = M / BM; nN = N / BM; nwg = nM * nN; G = G_; c = c_; rev = rev_; }
    __host__ __device__ bool next(int i, Unit& u) const {
        const long L = (long)i * G + c; if (L >= nwg) return false;
        int wgid = (int)L; { const int q = nwg / NXCD, r = nwg % NXCD, xcd = wgid % NXCD; int off = wgid / NXCD; if (rev && r == 0) off = q - 1 - off; wgid = (xcd < r ? xcd * (q + 1) : r * (q + 1) + (xcd - r) * q) + off; }
        const int nig = WGM * nN, gid = wgid / nig, fm = gid * WGM, gsz = (nM - fm) < WGM ? (nM - fm) : WGM;
        u.pm = fm + ((wgid % nig) % gsz); u.pn = (wgid % nig) / gsz; return true;
    }
    __device__ __forceinline__ void a_ready(const Unit&) const {}
    __device__ __forceinline__ void done(const Unit&) const {}
};

__device__ __forceinline__ unsigned cvt_pk_bf16(float lo, float hi) { unsigned r; asm volatile("v_cvt_pk_bf16_f32 %0, %1, %2" : "=v"(r) : "v"(lo), "v"(hi)); return r; }
__device__ __forceinline__ float hsum4(const f32x4 a) { return (a[0] + a[1]) + (a[2] + a[3]); }
__device__ __forceinline__ float sum_rows4(float x) {
    auto a = __builtin_amdgcn_permlane16_swap(__float_as_uint(x), __float_as_uint(x), false, false); const float s = __uint_as_float(a[0]) + __uint_as_float(a[1]);
    auto b = __builtin_amdgcn_permlane32_swap(__float_as_uint(s), __float_as_uint(s), false, false); return __uint_as_float(b[0]) + __uint_as_float(b[1]); }
__device__ __forceinline__ float xor16(float x, int fq) { auto a = __builtin_amdgcn_permlane16_swap(__float_as_uint(x), __float_as_uint(x), false, false); return __uint_as_float((fq & 1) ? a[0] : a[1]); }
__device__ __forceinline__ float rstd16(const float* ssq, int row, float invn) {
    const f32x4* s = (const f32x4*)(ssq + (size_t)row * 16);
    const float t = (hsum4(s[0]) + hsum4(s[1])) + (hsum4(s[2]) + hsum4(s[3]));
    return __builtin_amdgcn_rsqf(t * invn + 1e-6f);
}
__device__ __forceinline__ f32x4 ssq_part(const float* ssq, int row, int fq) { return *((const f32x4*)(ssq + (size_t)row * 16) + fq); }
__device__ __forceinline__ float rstd_fin(const f32x4 s, float invn) { return __builtin_amdgcn_rsqf(sum_rows4(hsum4(s)) * invn + 1e-6f); }
__device__ __forceinline__ float xor32(float x, int fq) { auto a = __builtin_amdgcn_permlane32_swap(__float_as_uint(x), __float_as_uint(x), false, false); return __uint_as_float((fq & 2) ? a[0] : a[1]); }
__device__ __forceinline__ f32x4 sigmoid4(const f32x4 x) { f32x4 r;
#pragma unroll
    for (int e = 0; e < 4; ++e) r[e] = __builtin_amdgcn_rcpf(1.0f + __builtin_amdgcn_exp2f(-1.4426950408889634f * x[e]));
    return r; }
__device__ __forceinline__ u32x4 pack8(const f32x4 a, const f32x4 b) { u32x4 w; w.x = cvt_pk_bf16(a[0], a[1]); w.y = cvt_pk_bf16(a[2], a[3]); w.z = cvt_pk_bf16(b[0], b[1]); w.w = cvt_pk_bf16(b[2], b[3]); return w; }
__device__ __forceinline__ void unpack8(const u32x4 w, f32x4& a, f32x4& b) {
    a[0] = __uint_as_float(w.x << 16); a[1] = __uint_as_float(w.x & 0xffff0000u); a[2] = __uint_as_float(w.y << 16); a[3] = __uint_as_float(w.y & 0xffff0000u);
    b[0] = __uint_as_float(w.z << 16); b[1] = __uint_as_float(w.z & 0xffff0000u); b[2] = __uint_as_float(w.w << 16); b[3] = __uint_as_float(w.w & 0xffff0000u); }

typedef __attribute__((address_space(3))) float LDSF; typedef __attribute__((address_space(3))) int LDSI; typedef __attribute__((address_space(3))) f32x4 LDSV4;
template <bool HAS_SSQ, bool F8OUT = false> struct EpiSwiglu {
    static constexpr bool PERM = true, AFTER_DRAIN = false, MIDSCALE = false;
    bf16_t* H; const float* ssq; LDSF* cache;
    __device__ __forceinline__ void operator()(const f32x4 (&acc)[2][2][4][2], const Unit& u, int wr, int wc, int fr, int fq) const {
        const int row0 = u.pm * BM + wr * 64 + fr, col0 = u.pn * 128 + wc * 32 + 8 * fq;
        float rr[2][4];
        if (HAS_SSQ) {
            LDSF* cw = cache + (wr * 4 + wc) * 128 + fr * 8; LDSI* tag = (LDSI*)(cache + 1024) + (wr * 4 + wc);
            const int have = __builtin_amdgcn_readfirstlane(*tag);
            if (have == u.pm) {
                const f32x4 c0 = *(const LDSV4*)cw, c1 = *(const LDSV4*)(cw + 4);
#pragma unroll
                for (int m = 0; m < 4; ++m) { rr[0][m] = c0[m]; rr[1][m] = c1[m]; }
            } else { f32x4 sp[2][4];
#pragma unroll
                for (int ai = 0; ai < 2; ++ai)
#pragma unroll
                    for (int m = 0; m < 4; ++m) sp[ai][m] = ssq_part(ssq, row0 + ai * HALF + m * 16, fq);
#pragma unroll
                for (int ai = 0; ai < 2; ++ai)
#pragma unroll
                    for (int m = 0; m < 4; ++m) rr[ai][m] = rstd_fin(sp[ai][m], 1.f / 1024.f);
                if (fq == 0) { *(LDSV4*)cw = (f32x4){rr[0][0], rr[0][1], rr[0][2], rr[0][3]}; *(LDSV4*)(cw + 4) = (f32x4){rr[1][0], rr[1][1], rr[1][2], rr[1][3]}; }
                *tag = u.pm; } }
#pragma unroll
        for (int ai = 0; ai < 2; ++ai)
#pragma unroll
            for (int m = 0; m < 4; ++m) { const int row = row0 + ai * HALF + m * 16;
                const float r = HAS_SSQ ? rr[ai][m] : 1.f, k1 = -1.4426950408889634f * r, r2 = r * r;
                f32x4 o[2];
#pragma unroll
                for (int n = 0; n < 2; ++n) {
                    const f32x4 g4 = acc[ai][0][m][n], u4 = acc[ai][1][m][n], x4 = g4 * k1;
                    f32x4 e4;
#pragma unroll
                    for (int e2 = 0; e2 < 4; ++e2) e4[e2] = __builtin_amdgcn_exp2f(x4[e2]);
                    const f32x4 d4 = e4 + 1.0f; f32x4 rc4;
#pragma unroll
                    for (int e2 = 0; e2 < 4; ++e2) rc4[e2] = __builtin_amdgcn_rcpf(d4[e2]);
                    f32x4 t4 = g4 * u4; if (HAS_SSQ) t4 = t4 * r2;
                    o[n] = t4 * rc4; }
                if constexpr (F8OUT) { int w0 = __builtin_amdgcn_cvt_pk_fp8_f32(o[0][0], o[0][1], 0, false); w0 = __builtin_amdgcn_cvt_pk_fp8_f32(o[0][2], o[0][3], w0, true);
                    int w1 = __builtin_amdgcn_cvt_pk_fp8_f32(o[1][0], o[1][1], 0, false); w1 = __builtin_amdgcn_cvt_pk_fp8_f32(o[1][2], o[1][3], w1, true);
                    *(unsigned long long*)((unsigned char*)H + (size_t)(col0 >> 7) * (32768 * 128) + (size_t)row * 128 + (col0 & 127)) = (unsigned long long)(unsigned)w0 | ((unsigned long long)(unsigned)w1 << 32); }
                else *(u32x4*)(H + (size_t)(col0 >> 6) * (32768 * 64) + (size_t)row * 64 + (col0 & 63)) = pack8(o[0], o[1]); }
    }
};
template <bool RES_F32> struct EpiResid {
    static constexpr bool PERM = true, AFTER_DRAIN = false, MIDSCALE = false;
    const void* res; bf16_t* xb; float* ssq; float alpha;
    __device__ __forceinline__ void operator()(const f32x4 (&acc)[2][2][4][2], const Unit& u, int wr, int wc, int fr, int fq) const {
        const int row0 = u.pm * BM + wr * 64 + fr, col0 = u.pn * BM + wc * 32 + 8 * fq;
        if constexpr (!RES_F32) {
            u32x4 rb[2][2][2];
#define PG8_BLOAD(g, buf) do { _Pragma("unroll") for (int mm = 0; mm < 2; ++mm) _Pragma("unroll") for (int bj = 0; bj < 2; ++bj) \
                rb[buf][mm][bj] = *(const u32x4*)((const bf16_t*)res + (size_t)(row0 + ((g) >> 1) * HALF + (((g) & 1) * 2 + mm) * 16) * 1024 + col0 + bj * HALF); } while (0)
            PG8_BLOAD(0, 0);
#pragma unroll
            for (int g = 0; g < 4; ++g) { const int ai = g >> 1;
                if (g + 1 < 4) PG8_BLOAD(g + 1, (g + 1) & 1);
#pragma unroll
                for (int mm = 0; mm < 2; ++mm) { const int m = (g & 1) * 2 + mm, row = row0 + ai * HALF + m * 16; float ss = 0.f;
#pragma unroll
                    for (int bj = 0; bj < 2; ++bj) { const size_t off = (size_t)row * 1024 + col0 + bj * HALF;
                        f32x4 r0, r1; unpack8(rb[g & 1][mm][bj], r0, r1);
                        const f32x4 o0 = r0 + alpha * acc[ai][bj][m][0], o1 = r1 + alpha * acc[ai][bj][m][1];
                        *(u32x4*)(xb + off) = pack8(o0, o1);
                        ss += hsum4(o0 * o0) + hsum4(o1 * o1); }
                    ss = sum_rows4(ss);
                    if (fq == 0) ssq[(size_t)row * 16 + u.pn * 4 + wc] = ss; } }
#undef PG8_BLOAD
        } else {
            f32x4 rf[2][2][2][2];
#define PG8_RLOAD(g, buf) do { _Pragma("unroll") for (int mm = 0; mm < 2; ++mm) _Pragma("unroll") for (int bj = 0; bj < 2; ++bj) { \
                const float* rp_ = (const float*)res + (size_t)(row0 + ((g) >> 1) * HALF + (((g) & 1) * 2 + mm) * 16) * 1024 + col0 + bj * HALF; \
                rf[buf][mm][bj][0] = *(const f32x4*)rp_; rf[buf][mm][bj][1] = *(const f32x4*)(rp_ + 4); } } while (0)
            PG8_RLOAD(0, 0);
#pragma unroll
            for (int g = 0; g < 4; ++g) { const int ai = g >> 1;
                if (g + 1 < 4) PG8_RLOAD(g + 1, (g + 1) & 1);
#pragma unroll
                for (int mm = 0; mm < 2; ++mm) { const int m = (g & 1) * 2 + mm, row = row0 + ai * HALF + m * 16; float ss = 0.f;
#pragma unroll
                    for (int bj = 0; bj < 2; ++bj) { const size_t off = (size_t)row * 1024 + col0 + bj * HALF;
                        const f32x4 o0 = rf[g & 1][mm][bj][0] + alpha * acc[ai][bj][m][0], o1 = rf[g & 1][mm][bj][1] + alpha * acc[ai][bj][m][1];
                        *(u32x4*)(xb + off) = pack8(o0, o1);
                        ss += hsum4(o0 * o0) + hsum4(o1 * o1); }
                    ss = sum_rows4(ss);
                    if (fq == 0) ssq[(size_t)row * 16 + u.pn * 4 + wc] = ss; } }
#undef PG8_RLOAD
        }
    }
};
template <bool F8C = false> struct EpiResidNorm {
    static constexpr bool PERM = true, AFTER_DRAIN = false, MIDSCALE = true;
    const bf16_t* res; bf16_t* xb; float* ssq; const float* ssqo; unsigned char* h8;
    __device__ __forceinline__ void rarb_fin(const f32x4 s, int fq, float& ra, float& rb) const {
        const float t = hsum4(s), t2 = t + xor16(t, fq), o2 = xor32(t2, fq);
        const float sa = (fq & 2) ? o2 : t2, sb = (fq & 2) ? t2 : o2;
        ra = __builtin_amdgcn_rsqf(sa * (1.f / 512.f) + 1e-6f); rb = __builtin_amdgcn_rsqf(sb * (1.f / 512.f) + 1e-6f); }
    __device__ __forceinline__ void midscale(f32x4 (&acc)[2][2][4][2], const Unit& u, int wr, int fr, int fq) const {
        const int row0 = u.pm * BM + wr * 64 + fr;
#pragma unroll
        for (int ai = 0; ai < 2; ++ai)
#pragma unroll
          for (int mh = 0; mh < 4; mh += 2) { f32x4 sp[2];
#pragma unroll
            for (int mm = 0; mm < 2; ++mm) sp[mm] = ssq_part(ssqo, row0 + ai * HALF + (mh + mm) * 16, fq);
#pragma unroll
            for (int mm = 0; mm < 2; ++mm) { const int m = mh + mm; float ra, rb; rarb_fin(sp[mm], fq, ra, rb); const float f = ra * __builtin_amdgcn_rcpf(rb);
#pragma unroll
                for (int bj = 0; bj < 2; ++bj)
#pragma unroll
                    for (int n = 0; n < 2; ++n) acc[ai][bj][m][n] = acc[ai][bj][m][n] * f; }
            asm volatile("" ::: "memory"); }
    }
    __device__ __forceinline__ void operator()(const f32x4 (&acc)[2][2][4][2], const Unit& u, int wr, int wc, int fr, int fq) const {
        const int row0 = u.pm * BM + wr * 64 + fr, col0 = u.pn * BM + wc * 32 + 8 * fq;
        u32x4 rbv[2][2][2]; float rbs[2][4];
#define PG8_NLOAD(g, buf) do { _Pragma("unroll") for (int mm = 0; mm < 2; ++mm) _Pragma("unroll") for (int bj = 0; bj < 2; ++bj) \
            rbv[buf][mm][bj] = *(const u32x4*)(res + (size_t)(row0 + ((g) >> 1) * HALF + (((g) & 1) * 2 + mm) * 16) * 1024 + col0 + bj * HALF); } while (0)
        { f32x4 sp[2][4];
#pragma unroll
          for (int ai = 0; ai < 2; ++ai)
#pragma unroll
              for (int m = 0; m < 4; ++m) sp[ai][m] = ssq_part(ssqo, row0 + ai * HALF + m * 16, fq);
          PG8_NLOAD(0, 0);
#pragma unroll
          for (int ai = 0; ai < 2; ++ai)
#pragma unroll
              for (int m = 0; m < 4; ++m) { float ra; rarb_fin(sp[ai][m], fq, ra, rbs[ai][m]); } }
#pragma unroll
        for (int g = 0; g < 4; ++g) { const int ai = g >> 1;
            if (g + 1 < 4) PG8_NLOAD(g + 1, (g + 1) & 1);
#pragma unroll
            for (int mm = 0; mm < 2; ++mm) { const int m = (g & 1) * 2 + mm, row = row0 + ai * HALF + m * 16; float ss = 0.f;
#pragma unroll
                for (int bj = 0; bj < 2; ++bj) { const size_t off = (size_t)row * 1024 + col0 + bj * HALF;
                    f32x4 r0, r1; unpack8(rbv[g & 1][mm][bj], r0, r1);
                    const f32x4 o0 = r0 + rbs[ai][m] * acc[ai][bj][m][0], o1 = r1 + rbs[ai][m] * acc[ai][bj][m][1];
                    *(u32x4*)(xb + off) = pack8(o0, o1);
                    if constexpr (F8C) { int w0 = __builtin_amdgcn_cvt_pk_fp8_f32(o0[0], o0[1], 0, false); w0 = __builtin_amdgcn_cvt_pk_fp8_f32(o0[2], o0[3], w0, true);
                        int w1 = __builtin_amdgcn_cvt_pk_fp8_f32(o1[0], o1[1], 0, false); w1 = __builtin_amdgcn_cvt_pk_fp8_f32(o1[2], o1[3], w1, true);
                        *(unsigned long long*)(h8 + off) = (unsigned long long)(unsigned)w0 | ((unsigned long long)(unsigned)w1 << 32); }
                    ss += hsum4(o0 * o0) + hsum4(o1 * o1); }
                ss = sum_rows4(ss);
                if (fq == 0) ssq[(size_t)row * 16 + u.pn * 4 + wc] = ss; } }
#undef PG8_NLOAD
    }
};
struct EpiE {
    static constexpr bool PERM = true, AFTER_DRAIN = false, MIDSCALE = false;
    bf16_t* E; float* ssq; const float* ge;
    __device__ __forceinline__ void operator()(const f32x4 (&acc)[2][2][4][2], const Unit& u, int wr, int wc, int fr, int fq) const {
        const int row0 = u.pm * BM + wr * 64 + fr, col0 = u.pn * BM + wc * 32 + 8 * fq;
        f32x4 gv[2][2];
#pragma unroll
        for (int bj = 0; bj < 2; ++bj) { gv[bj][0] = *(const f32x4*)(ge + col0 + bj * HALF); gv[bj][1] = *(const f32x4*)(ge + col0 + bj * HALF + 4); }
#pragma unroll
        for (int ai = 0; ai < 2; ++ai)
#pragma unroll
            for (int m = 0; m < 4; ++m) { const int row = row0 + ai * HALF + m * 16; float ss = 0.f;
#pragma unroll
                for (int bj = 0; bj < 2; ++bj) { const size_t off = (size_t)row * 1024 + col0 + bj * HALF; const f32x4 o0 = acc[ai][bj][m][0], o1 = acc[ai][bj][m][1];
                    *(u32x4*)(E + off) = pack8(o0 * gv[bj][0], o1 * gv[bj][1]); ss += hsum4(o0 * o0) + hsum4(o1 * o1); }
                ss = sum_rows4(ss);
                if (fq == 0) ssq[(size_t)row * 16 + u.pn * 4 + wc] = ss; }
    }
};
struct EpiPle {
    static constexpr bool PERM = true, AFTER_DRAIN = false, MIDSCALE = false;
    float* out; const bf16_t* hb; const bf16_t* E; const float* ssq3; const float* ssqe;
    __device__ __forceinline__ void operator()(const f32x4 (&acc)[2][2][4][2], const Unit& u, int wr, int wc, int fr, int fq) const {
        const int row0 = u.pm * BM + wr * 64 + fr, col0 = u.pn * BM + wc * 32 + 8 * fq;
        float r3[2][4], re[2][4];
        { f32x4 s3[2][4], se[2][4];
#pragma unroll
          for (int ai = 0; ai < 2; ++ai)
#pragma unroll
              for (int m = 0; m < 4; ++m) { s3[ai][m] = ssq_part(ssq3, row0 + ai * HALF + m * 16, fq); se[ai][m] = ssq_part(ssqe, row0 + ai * HALF + m * 16, fq); }
#pragma unroll
          for (int ai = 0; ai < 2; ++ai)
#pragma unroll
              for (int m = 0; m < 4; ++m) { r3[ai][m] = rstd_fin(s3[ai][m], 1.f / 1024.f); re[ai][m] = rstd_fin(se[ai][m], 1.f / 1024.f); } }
        u32x4 eb[2][2][2], hh[2][2][2];
#define PG8_PLOAD(g, buf) do { _Pragma("unroll") for (int mm = 0; mm < 2; ++mm) _Pragma("unroll") for (int bj = 0; bj < 2; ++bj) { \
            const size_t off_ = (size_t)(row0 + ((g) >> 1) * HALF + (((g) & 1) * 2 + mm) * 16) * 1024 + col0 + bj * HALF; \
            eb[buf][mm][bj] = *(const u32x4*)(E + off_); hh[buf][mm][bj] = *(const u32x4*)(hb + off_); } } while (0)
        PG8_PLOAD(0, 0);
#pragma unroll
        for (int g = 0; g < 4; ++g) { const int ai = g >> 1;
            if (g + 1 < 4) PG8_PLOAD(g + 1, (g + 1) & 1);
#pragma unroll
            for (int mm = 0; mm < 2; ++mm) { const int m = (g & 1) * 2 + mm, row = row0 + ai * HALF + m * 16;
#pragma unroll
                for (int bj = 0; bj < 2; ++bj) { const size_t off = (size_t)row * 1024 + col0 + bj * HALF;
                    f32x4 e0, e1, h0, h1; unpack8(eb[g & 1][mm][bj], e0, e1); unpack8(hh[g & 1][mm][bj], h0, h1);
                    const f32x4 o0 = h0 + sigmoid4(acc[ai][bj][m][0] * r3[ai][m]) * (e0 * re[ai][m]);
                    const f32x4 o1 = h1 + sigmoid4(acc[ai][bj][m][1] * r3[ai][m]) * (e1 * re[ai][m]);
                    __builtin_nontemporal_store(o0, (f32x4*)(out + off)); __builtin_nontemporal_store(o1, (f32x4*)(out + off + 4)); } } }
#undef PG8_PLOAD
    }
};
struct EpiQKV {
    static constexpr bool PERM = true, AFTER_DRAIN = false, MIDSCALE = false;
    bf16_t* QKV; float* gates; float* logf; const float* ssq1; const float* rope; const float* gq_nsa; const float* gk_slc; const float* gk_win; const float* gq_fox; const float* gk_fox; const float* bforget;
    __device__ __forceinline__ void operator()(const f32x4 (&acc)[2][2][4][2], const Unit& u, int wr, int wc, int fr, int fq) const {
        const int row0 = u.pm * BM + wr * 64 + fr;
        if (u.pn == 11) {
            if (wc != 0) return;
            f32x4 bf0 = *(const f32x4*)(bforget), bf1 = *(const f32x4*)(bforget + 4);
            float rq[2][4];
            { f32x4 sp[2][4];
#pragma unroll
              for (int ai = 0; ai < 2; ++ai)
#pragma unroll
                  for (int m = 0; m < 4; ++m) sp[ai][m] = ssq_part(ssq1, row0 + ai * HALF + m * 16, fq);
#pragma unroll
              for (int ai = 0; ai < 2; ++ai)
#pragma unroll
                  for (int m = 0; m < 4; ++m) rq[ai][m] = rstd_fin(sp[ai][m], 1.f / 1024.f); }
#pragma unroll
            for (int ai = 0; ai < 2; ++ai)
#pragma unroll
                for (int m = 0; m < 4; ++m) { const int row = row0 + ai * HALF + m * 16; const float r1 = rq[ai][m];
                    const f32x4 v0 = acc[ai][0][m][0] * r1, v1 = acc[ai][0][m][1] * r1;
                    if (fq < 3) { *(f32x4*)(gates + (size_t)row * 24 + 8 * fq) = sigmoid4(v0); *(f32x4*)(gates + (size_t)row * 24 + 8 * fq + 4) = sigmoid4(v1); }
                    else { f32x4 x0 = v0 + bf0, x1 = v1 + bf1, l0, l1;
#pragma unroll
                        for (int e = 0; e < 4; ++e) { l0[e] = fminf(x0[e], 0.f) - __logf(1.0f + __expf(-fabsf(x0[e]))); l1[e] = fminf(x1[e], 0.f) - __logf(1.0f + __expf(-fabsf(x1[e]))); }
                        *(f32x4*)(logf + (size_t)row * 8) = l0; *(f32x4*)(logf + (size_t)row * 8 + 4) = l1; } }
            return;
        }
        const int c0 = u.pn * 256 + wc * 64;
        const float* gain = nullptr; bool dorope = false; float scale = 1.f;
        if (c0 < 512) { gain = gq_nsa; dorope = true; scale = 0.125f * 1.4426950408889634f; }
        else if (c0 < 640) { dorope = true; }
        else if (c0 < 768) {}
        else if (c0 < 896) { gain = gk_slc; dorope = true; }
        else if (c0 < 1024) {}
        else if (c0 < 1152) { gain = gk_win; dorope = true; }
        else if (c0 < 1280) {}
        else if (c0 < 1792) { gain = gq_fox; scale = 0.125f * 1.4426950408889634f; }
        else if (c0 < 2304) { gain = gk_fox; }
        f32x4 gv[2][2];
#pragma unroll
        for (int bj = 0; bj < 2; ++bj)
#pragma unroll
            for (int n = 0; n < 2; ++n) gv[bj][n] = (gain ? *(const f32x4*)(gain + 32 * bj + 8 * fq + 4 * n) : (f32x4){1.f, 1.f, 1.f, 1.f}) * scale;
        float rq[2][4];
        { f32x4 sp[2][4];
#pragma unroll
          for (int ai = 0; ai < 2; ++ai)
#pragma unroll
              for (int m = 0; m < 4; ++m) sp[ai][m] = ssq_part(ssq1, row0 + ai * HALF + m * 16, fq);
#pragma unroll
          for (int ai = 0; ai < 2; ++ai)
#pragma unroll
              for (int m = 0; m < 4; ++m) rq[ai][m] = rstd_fin(sp[ai][m], 1.f / 1024.f); }
#pragma unroll
        for (int ai = 0; ai < 2; ++ai) {
#pragma unroll
            for (int m = 0; m < 4; ++m) { const int row = row0 + ai * HALF + m * 16, t = row & 4095; const float r1 = rq[ai][m];
                float rs = r1;
                if (gain) { float ss = (hsum4(acc[ai][0][m][0] * acc[ai][0][m][0]) + hsum4(acc[ai][0][m][1] * acc[ai][0][m][1])) + (hsum4(acc[ai][1][m][0] * acc[ai][1][m][0]) + hsum4(acc[ai][1][m][1] * acc[ai][1][m][1]));
                    ss = sum_rows4(ss);
                    rs = r1 * __builtin_amdgcn_rsqf(ss * (r1 * r1) * (1.f / 64.f) + 1e-6f); }
                f32x4 v[2][2];
#pragma unroll
                for (int bj = 0; bj < 2; ++bj)
#pragma unroll
                    for (int n = 0; n < 2; ++n) v[bj][n] = acc[ai][bj][m][n] * (gv[bj][n] * rs);
                if (dorope) { f32x4 p0, p1;
#pragma unroll
                    for (int e = 0; e < 4; ++e) { p0[e] = xor16(v[0][0][e], fq); p1[e] = xor16(v[0][1][e], fq); }
                    if (fq < 2) { const f32x4 cs0 = *(const f32x4*)(rope + t * 16), cs1 = *(const f32x4*)(rope + t * 16 + 4), sn0 = *(const f32x4*)(rope + t * 16 + 8), sn1 = *(const f32x4*)(rope + t * 16 + 12);
                        if (fq == 0) { v[0][0] = v[0][0] * cs0 - p0 * sn0; v[0][1] = v[0][1] * cs1 - p1 * sn1; }
                        else { v[0][0] = v[0][0] * cs0 + p0 * sn0; v[0][1] = v[0][1] * cs1 + p1 * sn1; } } }
#pragma unroll
                for (int bj = 0; bj < 2; ++bj) *(u32x4*)(QKV + (size_t)(c0 >> 6) * (32768 * 64) + (size_t)row * 64 + 32 * bj + 8 * fq) = pack8(v[bj][0], v[bj][1]);
            }
        }
    }
};

struct EpiCompress {
    static constexpr bool PERM = true, AFTER_DRAIN = true, MIDSCALE = false;
    const float* posb; const bf16_t* w2t; const float* gk; bf16_t* KC; bf16_t* VC;
    __device__ __forceinline__ void fused(f32x4 (&acc)[2][2][4][2], const Unit& u, int wr, int wc, int fr, int fq, PG8_LAS unsigned char* lds, int wid, int lane) const {
        typedef float f32x16 __attribute__((ext_vector_type(16))); typedef unsigned u32x2v __attribute__((ext_vector_type(2)));
        const int which = u.pn, bk = u.pm;
        {
            const int col0 = wc * 32 + 8 * fq;
#pragma unroll
            for (int bj = 0; bj < 2; ++bj) { const f32x4 b0 = *(const f32x4*)(posb + which * 256 + col0 + bj * HALF), b1 = *(const f32x4*)(posb + which * 256 + col0 + bj * HALF + 4);
#pragma unroll
                for (int ai = 0; ai < 2; ++ai)
#pragma unroll
                    for (int m = 0; m < 4; ++m) { const int row = ai * HALF + wr * 64 + m * 16 + fr; const f32x4 g0 = acc[ai][bj][m][0] + b0, g1 = acc[ai][bj][m][1] + b1;
                        *(PG8_LAS u32x4*)(lds + row * 528 + (col0 + bj * HALF) * 2) = pack8(g0 * sigmoid4(g0), g1 * sigmoid4(g1)); } }
        }
        asm volatile("s_waitcnt lgkmcnt(0)" ::: "memory"); __builtin_amdgcn_s_barrier(); asm volatile("" ::: "memory");
        const int r32 = lane & 31, hi = lane >> 5, n = wid * 32 + r32;
        f32x16 o[2]; o[0] = f32x16{}; o[1] = f32x16{};
        { const PG8_LAS unsigned char* hp = lds + n * 528 + hi * 16; const bf16_t* wp = w2t + (size_t)(which * 64 + r32) * 256 + hi * 8;
#pragma unroll 4
          for (int ks = 0; ks < 16; ++ks) { const bf16x8 bfr = *(const PG8_LAS bf16x8*)(hp + ks * 32);
              const bf16x8 a0 = *(const bf16x8*)(wp + ks * 16), a1 = *(const bf16x8*)(wp + 32 * 256 + ks * 16);
              o[0] = __builtin_amdgcn_mfma_f32_32x32x16_bf16(a0, bfr, o[0], 0, 0, 0); o[1] = __builtin_amdgcn_mfma_f32_32x32x16_bf16(a1, bfr, o[1], 0, 0, 0); } }
        if (which == 0) {
            float ss = 0.f;
#pragma unroll
            for (int dt = 0; dt < 2; ++dt)
#pragma unroll
                for (int r = 0; r < 16; ++r) ss += o[dt][r] * o[dt][r];
            { auto rr = __builtin_amdgcn_permlane32_swap(__float_as_uint(ss), __float_as_uint(ss), false, false); ss = __uint_as_float(rr[0]) + __uint_as_float(rr[1]); }
            const float rn = __builtin_amdgcn_rsqf(ss * (1.f / 64.f) + 1e-6f);
#pragma unroll
            for (int dt = 0; dt < 2; ++dt)
#pragma unroll
                for (int k = 0; k < 4; ++k) { const f32x4 gv = *(const f32x4*)(gk + 32 * dt + 8 * k + 4 * hi);
#pragma unroll
                    for (int e2 = 0; e2 < 4; ++e2) o[dt][4 * k + e2] = o[dt][4 * k + e2] * rn * gv[e2]; }
        }
        bf16_t* outp = (which ? VC : KC) + ((size_t)bk * 256 + n) * 64 + 4 * hi;
        const bool live = n < 255;
#pragma unroll
        for (int dt = 0; dt < 2; ++dt)
#pragma unroll
            for (int k = 0; k < 4; ++k) { u32x2v w; w.x = cvt_pk_bf16(o[dt][4 * k], o[dt][4 * k + 1]); w.y = cvt_pk_bf16(o[dt][4 * k + 2], o[dt][4 * k + 3]);
                if (!live) { w.x = 0u; w.y = 0u; }
                *(u32x2v*)(outp + 32 * dt + 8 * k) = w; }
    }
};
typedef int v4i_t __attribute__((ext_vector_type(4))); typedef int v8i_t __attribute__((ext_vector_type(8)));
template <class Epi, class Sched, bool ALIGN_EPI = false, bool SP2 = false, bool MX8 = false>
__device__ __forceinline__ void gemm_phase(PG8_LAS unsigned char* lds, const Gemm g, const Sched& S, const Epi& E, const int wv) {
    const int tid = opaque_tid(wv), wid = wv, lane = tid & 63, wr = wid >> 2, wc = wid & 3, fr = lane & 15, fq = lane >> 4;
    const int K = g.K, nt = K / BK;
    unsigned voffA[2], voffB[2];
#pragma unroll
    for (int i = 0; i < 2; ++i) { int R, C; stage_rc(tid * 16 + i * 8192, R, C); const int Rb = Epi::PERM ? ((R & ~31) + perm32(R & 31)) : R;
        voffA[i] = (unsigned)(R * (g.rsA ? g.rsA : K * 2) + C * 2); voffB[i] = (unsigned)(Rb * K + C) * 2u; }
    const size_t kstep = (size_t)(BK * 2);
    const size_t hstep = (size_t)HALF * K * 2;
    const size_t tstep = 2 * hstep;
    const size_t rsA = g.rsA ? (size_t)g.rsA : (size_t)K * 2, kstepA = (size_t)g.ksA, hstepA = (size_t)HALF * rsA;
    const unsigned ldsw = (unsigned)wid * 1024u;
    const int aoff = lds_byte(wr * 64 + fr, fq * 8), boff = lds_byte(wc * 32 + fr, fq * 8);
#define PG8_SA(b, h) (((b) * 2 + (h)) * HTB)
#define PG8_SB(b, h) ((4 + (b) * 2 + (h)) * HTB)
#define PG8_STAGE(bufoff, gbase, voff) do { _Pragma("unroll") for (int _i = 0; _i < 2; ++_i) { unsigned vo_ = (voff)[_i]; if constexpr (MX8) asm volatile("" : "+v"(vo_));     \
        __builtin_amdgcn_global_load_lds((const unsigned*)((const char*)(gbase) + vo_), (PG8_LAS unsigned*)(lds + (bufoff) + ldsw + _i * 8192), 16, 0, 0); } } while (0)
#define PG8_LDA(dst, b, h) do { _Pragma("unroll") for (int m = 0; m < 4; ++m) { if constexpr (MX8) { const v4i_t lo_ = *(const PG8_LAS v4i_t*)(lds + PG8_SA(b, h) + aoff + m * 2048), hi_ = *(const PG8_LAS v4i_t*)(lds + PG8_SA(b, h) + aoff + m * 2048 + 1024); dst##8[m] = __builtin_shufflevector(lo_, hi_, 0, 1, 2, 3, 4, 5, 6, 7); } \
        else { _Pragma("unroll") for (int k = 0; k < 2; ++k) dst[m][k] = *(const PG8_LAS bf16x8*)(lds + PG8_SA(b, h) + aoff + m * 2048 + k * 1024); } } } while (0)
#define PG8_LDB(dst, b, h) do { _Pragma("unroll") for (int n = 0; n < 2; ++n) { if constexpr (MX8) { const v4i_t lo_ = *(const PG8_LAS v4i_t*)(lds + PG8_SB(b, h) + boff + n * 2048), hi_ = *(const PG8_LAS v4i_t*)(lds + PG8_SB(b, h) + boff + n * 2048 + 1024); dst##8[n] = __builtin_shufflevector(lo_, hi_, 0, 1, 2, 3, 4, 5, 6, 7); } \
        else { _Pragma("unroll") for (int k = 0; k < 2; ++k) dst[n][k] = *(const PG8_LAS bf16x8*)(lds + PG8_SB(b, h) + boff + n * 2048 + k * 1024); } } } while (0)
#define PG8_MMA(ai, bj, At, Bt) do { if constexpr (MX8) __builtin_amdgcn_sched_barrier(0); __builtin_amdgcn_s_setprio(1); _Pragma("unroll") for (int m = 0; m < 4; ++m) _Pragma("unroll") for (int n = 0; n < 2; ++n) { \
        if constexpr (MX8) acc[ai][bj][m][n] = __builtin_amdgcn_mfma_scale_f32_16x16x128_f8f6f4(Bt##8[n], At##8[m], acc[ai][bj][m][n], 0, 0, 0, 0x7F7F7F7F, 0, 0x7F7F7F7F); \
        else { _Pragma("unroll") for (int k = 0; k < 2; ++k) acc[ai][bj][m][n] = __builtin_amdgcn_mfma_f32_16x16x32_bf16(Bt[n][k], At[m][k], acc[ai][bj][m][n], 0, 0, 0); } } \
        __builtin_amdgcn_s_setprio(0); if constexpr (MX8) __builtin_amdgcn_sched_barrier(0); } while (0)
#define PG8_WAIT_V(n) asm volatile("s_waitcnt vmcnt(" #n ")" ::: "memory")
#define PG8_WAIT_L(n) asm volatile("s_waitcnt lgkmcnt(" #n ")" ::: "memory")
#define PG8_BAR __builtin_amdgcn_s_barrier()
#define PG8_SCHED __builtin_amdgcn_sched_barrier(0)
    Unit cur, nxt; int ui = 0;
    if (!S.next(0, cur)) return;
    f32x4 acc[2][2][4][2];
#pragma unroll
    for (int a = 0; a < 2; ++a)
#pragma unroll
        for (int b = 0; b < 2; ++b)
#pragma unroll
            for (int m = 0; m < 4; ++m)
#pragma unroll
                for (int n = 0; n < 2; ++n) acc[a][b][m][n] = (f32x4){0.f, 0.f, 0.f, 0.f};
    bf16x8 At[4][2], B0[2][2], B1[2][2]; v8i_t At8[4], B08[2], B18[2];
    const char* cA = a_tile(g, cur); const char* cB = (const char*)g.Bt + (size_t)cur.pn * tstep;
    S.a_ready(cur);
    if constexpr (SP2) {
        PG8_STAGE(PG8_SB(0, 0), cB, voffB); PG8_STAGE(PG8_SB(0, 1), cB + hstep, voffB); PG8_STAGE(PG8_SA(0, 0), cA, voffA); PG8_STAGE(PG8_SA(0, 1), cA + hstepA, voffA);
        if (wr == 1) PG8_BAR;
        PG8_WAIT_V(2); PG8_BAR;
        PG8_STAGE(PG8_SB(1, 0), cB + kstep, voffB); PG8_STAGE(PG8_SA(1, 0), cA + kstepA, voffA); PG8_STAGE(PG8_SB(1, 1), cB + hstep + kstep, voffB);
        PG8_WAIT_V(6); PG8_BAR;
    } else {
        PG8_STAGE(PG8_SB(0, 0), cB, voffB); PG8_STAGE(PG8_SA(0, 0), cA, voffA); PG8_STAGE(PG8_SB(0, 1), cB + hstep, voffB); PG8_STAGE(PG8_SA(0, 1), cA + hstepA, voffA);
        if (wr == 1) PG8_BAR;
        PG8_WAIT_V(4); PG8_BAR;
        PG8_STAGE(PG8_SB(1, 0), cB + kstep, voffB); PG8_STAGE(PG8_SA(1, 0), cA + kstepA, voffA); PG8_STAGE(PG8_SB(1, 1), cB + hstep + kstep, voffB);
        PG8_WAIT_V(6); PG8_BAR;
    }
    for (;;) {
        const bool has_next = S.next(ui + 1, nxt);
        const char* nA = has_next ? a_tile(g, nxt) : cA; const char* nB = has_next ? (const char*)g.Bt + (size_t)nxt.pn * tstep : cB;
#pragma unroll 1
        for (int t = 0; t < nt; t += 2) {
            if constexpr (Epi::MIDSCALE) { if (t == 8) { const int l4_ = opaque_tid(wv) & 63; E.midscale(acc, cur, wr, l4_ & 15, l4_ >> 4); } }
            const bool last = (t == nt - 2);
            const char* a1 = cA + (size_t)(t + 1) * kstepA;
            const char* a2 = last ? nA : cA + (size_t)(t + 2) * kstepA; const char* b2 = last ? nB : cB + (size_t)(t + 2) * kstep;
            const char* a3 = a2 + kstepA; const char* b3 = b2 + kstep;
            if (last && has_next) S.a_ready(nxt);
            if constexpr (SP2) {
            PG8_LDB(B0, 0, 0); PG8_LDB(B1, 0, 1); PG8_SCHED; PG8_LDA(At, 0, 0); PG8_STAGE(PG8_SA(1, 1), a1 + hstepA, voffA);
            PG8_WAIT_V(8); PG8_WAIT_L(0); PG8_BAR; PG8_MMA(0, 0, At, B0); PG8_MMA(0, 1, At, B1); PG8_BAR; PG8_SCHED;
            PG8_LDA(At, 0, 1); PG8_STAGE(PG8_SB(0, 0), b2, voffB); PG8_STAGE(PG8_SB(0, 1), b2 + hstep, voffB); PG8_STAGE(PG8_SA(0, 0), a2, voffA);
            PG8_WAIT_V(8); PG8_WAIT_L(0); PG8_BAR; PG8_MMA(1, 0, At, B0); PG8_MMA(1, 1, At, B1); PG8_BAR; PG8_SCHED;
            PG8_LDB(B0, 1, 0); PG8_LDB(B1, 1, 1); PG8_SCHED; PG8_LDA(At, 1, 0); PG8_STAGE(PG8_SA(0, 1), a2 + hstepA, voffA);
            PG8_WAIT_V(8); PG8_WAIT_L(0); PG8_BAR; PG8_MMA(0, 0, At, B0); PG8_MMA(0, 1, At, B1); PG8_BAR; PG8_SCHED;
            PG8_LDA(At, 1, 1); PG8_STAGE(PG8_SB(1, 0), b3, voffB); PG8_STAGE(PG8_SB(1, 1), b3 + hstep, voffB); PG8_STAGE(PG8_SA(1, 0), a3, voffA);
            PG8_WAIT_V(8); PG8_WAIT_L(0); PG8_BAR; PG8_MMA(1, 0, At, B0); PG8_MMA(1, 1, At, B1); PG8_BAR; PG8_SCHED;
            } else {
            PG8_LDB(B0, 0, 0); PG8_SCHED; PG8_LDA(At, 0, 0); PG8_STAGE(PG8_SA(1, 1), a1 + hstepA, voffA);
            PG8_WAIT_L(8); PG8_BAR; PG8_WAIT_L(0); PG8_MMA(0, 0, At, B0); PG8_BAR; PG8_SCHED;
            PG8_LDB(B1, 0, 1); PG8_STAGE(PG8_SB(0, 0), b2, voffB);
            PG8_BAR; PG8_WAIT_L(0); PG8_MMA(0, 1, At, B1); PG8_BAR;
            PG8_LDA(At, 0, 1); PG8_STAGE(PG8_SA(0, 0), a2, voffA);
            PG8_BAR; PG8_WAIT_L(0); PG8_MMA(1, 0, At, B0); PG8_BAR; PG8_SCHED;
            PG8_STAGE(PG8_SB(0, 1), b2 + hstep, voffB);
            PG8_WAIT_V(6); PG8_BAR; PG8_MMA(1, 1, At, B1); PG8_BAR;
            PG8_LDB(B0, 1, 0); PG8_SCHED; PG8_LDA(At, 1, 0); PG8_STAGE(PG8_SA(0, 1), a2 + hstepA, voffA);
            PG8_WAIT_L(8); PG8_BAR; PG8_WAIT_L(0); PG8_MMA(0, 0, At, B0); PG8_BAR; PG8_SCHED;
            PG8_LDB(B1, 1, 1); PG8_STAGE(PG8_SB(1, 0), b3, voffB);
            PG8_BAR; PG8_WAIT_L(0); PG8_MMA(0, 1, At, B1); PG8_BAR;
            PG8_LDA(At, 1, 1); PG8_STAGE(PG8_SA(1, 0), a3, voffA);
            PG8_BAR; PG8_WAIT_L(0); PG8_MMA(1, 0, At, B0); PG8_BAR; PG8_SCHED;
            PG8_STAGE(PG8_SB(1, 1), b3 + hstep, voffB);
            PG8_WAIT_V(6); PG8_BAR; PG8_MMA(1, 1, At, B1); PG8_BAR;
            }
        }
        if constexpr (ALIGN_EPI) { if (wr == 0) PG8_BAR; }
        if constexpr (!Epi::AFTER_DRAIN) { const int l2_ = opaque_tid(wv) & 63; E(acc, cur, wr, wc, l2_ & 15, l2_ >> 4); S.done(cur); }
        if (!has_next) break;
#pragma unroll
        for (int a = 0; a < 2; ++a)
#pragma unroll
            for (int b = 0; b < 2; ++b)
#pragma unroll
                for (int m = 0; m < 4; ++m)
#pragma unroll
                    for (int n = 0; n < 2; ++n) acc[a][b][m][n] = (f32x4){0.f, 0.f, 0.f, 0.f};
        cur = nxt; cA = nA; cB = nB; ++ui;
        if constexpr (ALIGN_EPI) { if (wr == 1) PG8_BAR; }
    }
    PG8_WAIT_V(0);
    if constexpr (!ALIGN_EPI) { if (wr == 0) PG8_BAR; }
    PG8_BAR;
    if constexpr (Epi::AFTER_DRAIN) { const int l3_ = opaque_tid(wv) & 63; E.fused(acc, cur, wr, wc, l3_ & 15, l3_ >> 4, lds, wid, l3_); S.done(cur); }
#undef PG8_SA
#undef PG8_SB
#undef PG8_STAGE
#undef PG8_LDA
#undef PG8_LDB
#undef PG8_MMA
#undef PG8_WAIT_V
#undef PG8_WAIT_L
#undef PG8_BAR
#undef PG8_SCHED
}
}

#include <hip/hip_bf16.h>
namespace att {
using bf16x8=__attribute__((ext_vector_type(8)))short;
using s16x4=__attribute__((ext_vector_type(4)))short;
using f32x16=__attribute__((ext_vector_type(16)))float;
using u32x4=__attribute__((ext_vector_type(4)))unsigned;
using u32x2=__attribute__((ext_vector_type(2)))unsigned;
using bf16x4=__attribute__((ext_vector_type(4)))short;
constexpr int NW=8,QBLK=32,KVBLK=64;
__device__ __forceinline__ int crow(int r,int hi){return (r&3)+8*(r>>2)+4*hi;}
#define SBAR() __builtin_amdgcn_sched_barrier(0)
template<int VAR> __device__ __forceinline__ void amask(f32x16&p0,f32x16&p1,int keybase,int qpos,int lower,int hi){
  const float NEG=-INFINITY; int kb=keybase+4*hi; asm volatile("":"+v"(kb)); asm volatile("":"+v"(qpos)); if(VAR==2) asm volatile("":"+v"(lower));
  #pragma unroll
  for(int r=0;r<16;++r){const int kv=kb+(r&3)+8*(r>>2); bool m0=kv>qpos,m1=kv+32>qpos; if(VAR==2){m0=m0||(kv<lower);m1=m1||(kv+32<lower);} if(m0)p0[r]=NEG; if(m1)p1[r]=NEG;}
}
constexpr int NSLOT=4, SLOTB=8192;
constexpr int LDS_K=0, LDS_V=NSLOT*SLOTB, LDS_WS=2*NSLOT*SLOTB, LDS_OST=LDS_WS+NW*64*4, LDS_CB=LDS_OST+NW*4096, LDS_BYTES_ATT=LDS_CB+32768;
__device__ __forceinline__ void glds16(const void*gsrc,unsigned lds_dst){unsigned keep;
  asm volatile("s_mov_b32 %0, m0\n\ts_mov_b32 m0, %2\n\ts_nop 0\n\tglobal_load_lds_dwordx4 %1, off\n\ts_mov_b32 m0, %0":"=&s"(keep):"v"(gsrc),"s"(lds_dst):"memory");}
__device__ __forceinline__ float max3f(float a,float b,float c){float r;asm("v_max3_f32 %0, %1, %2, %3":"=v"(r):"v"(a),"v"(b),"v"(c));return r;}
__device__ __forceinline__ float max2f(float a,float b){float r;asm("v_max_f32_e32 %0, %1, %2":"=v"(r):"v"(a),"v"(b));return r;}
__device__ __forceinline__ float fadd_s(float a,float b){float r;asm("v_add_f32_e32 %0, %1, %2":"=v"(r):"v"(a),"v"(b));return r;}
__device__ __forceinline__ float fsub_s(float a,float b){float r;asm("v_sub_f32_e32 %0, %1, %2":"=v"(r):"v"(a),"v"(b));return r;}
typedef float f32x2_t __attribute__((ext_vector_type(2))); typedef __bf16 bf16x2_t __attribute__((ext_vector_type(2)));
__device__ __forceinline__ unsigned cvtpk_s(float lo,float hi){f32x2_t v={lo,hi};bf16x2_t b=__builtin_convertvector(v,bf16x2_t);return __builtin_bit_cast(unsigned,b);}
#define WAIT_BAR(N) asm volatile("s_waitcnt vmcnt(" #N ") lgkmcnt(0)\n\ts_barrier":::"memory")
typedef __attribute__((address_space(3))) const char* lds_cptr;
typedef short v4i16_t __attribute__((ext_vector_type(4)));
template<int VAR> __device__ __forceinline__ void qkt(f32x16&p0,f32x16&p1,const char*Kslot,const bf16x8*qr,int r32,int hi,bf16x4 kb0,bf16x4 kb1,bf16x4 qone){
  const f32x16 negm=f32x16{};
  const char*kb=Kslot+hi*1024+r32*16;
  #pragma unroll
  for(int d0=0;d0<4;++d0){
    const bf16x8 b0=*reinterpret_cast<const bf16x8*>(kb+d0*2048);
    const bf16x8 b1=*reinterpret_cast<const bf16x8*>(kb+d0*2048+512);
    if(d0==0){p0=__builtin_amdgcn_mfma_f32_32x32x16_bf16(b0,qr[0],negm,0,0,0);p1=__builtin_amdgcn_mfma_f32_32x32x16_bf16(b1,qr[0],negm,0,0,0);}
    else{p0=__builtin_amdgcn_mfma_f32_32x32x16_bf16(b0,qr[d0],p0,0,0,0);p1=__builtin_amdgcn_mfma_f32_32x32x16_bf16(b1,qr[d0],p1,0,0,0);}}
  if(VAR==0){p0=__builtin_amdgcn_mfma_f32_32x32x8bf16_1k(kb0,qone,p0,0,0,0);p1=__builtin_amdgcn_mfma_f32_32x32x8bf16_1k(kb1,qone,p1,0,0,0);}
}
__device__ __forceinline__ void kload8(bf16x8*kf,lds_cptr kp){
  kf[0]=*(const __attribute__((address_space(3))) bf16x8*)(kp);      kf[1]=*(const __attribute__((address_space(3))) bf16x8*)(kp+512);
  kf[2]=*(const __attribute__((address_space(3))) bf16x8*)(kp+2048); kf[3]=*(const __attribute__((address_space(3))) bf16x8*)(kp+2560);
  kf[4]=*(const __attribute__((address_space(3))) bf16x8*)(kp+4096); kf[5]=*(const __attribute__((address_space(3))) bf16x8*)(kp+4608);
  kf[6]=*(const __attribute__((address_space(3))) bf16x8*)(kp+6144); kf[7]=*(const __attribute__((address_space(3))) bf16x8*)(kp+6656);
}
__device__ __forceinline__ void kload2(bf16x8*kf,lds_cptr kp,int j){ kf[2*j]=*(const __attribute__((address_space(3))) bf16x8*)(kp+j*2048); kf[2*j+1]=*(const __attribute__((address_space(3))) bf16x8*)(kp+j*2048+512); }
__device__ __forceinline__ s16x4 vtr(lds_cptr p){ return __builtin_bit_cast(s16x4,__builtin_amdgcn_ds_read_tr16_b64_v4i16((__attribute__((address_space(3))) v4i16_t*)p)); }
__device__ __forceinline__ float rowmax(const f32x16&p0,const f32x16&p1){
  float a=max3f(p0[0],p0[1],p1[0]),b=max3f(p0[2],p0[3],p1[1]);a=max3f(a,p1[2],p1[3]);
  #pragma unroll
  for(int r=4;r<16;r+=4){a=max3f(a,p0[r],p0[r+1]);b=max3f(b,p0[r+2],p0[r+3]);a=max3f(a,p1[r],p1[r+1]);b=max3f(b,p1[r+2],p1[r+3]);}
  const float m=max2f(a,b);
  auto rr=__builtin_amdgcn_permlane32_swap(__float_as_uint(m),__float_as_uint(m),false,false);
  return max2f(__uint_as_float(rr[0]),__uint_as_float(rr[1]));
}
__device__ __forceinline__ void pv(f32x16*o,int vb,bf16x8 pa0,bf16x8 pa1,bf16x8 pa2,bf16x8 pa3){
  #pragma unroll
  for(int d0=0;d0<2;++d0){s16x4 lo[4],hi[4];
    #pragma unroll
    for(int ks=0;ks<4;++ks){
      asm volatile("ds_read_b64_tr_b16 %0,%1 offset:%c2":"=&v"(lo[ks]):"v"(vb),"i"(d0*4096+ks*1024):"memory");
      asm volatile("ds_read_b64_tr_b16 %0,%1 offset:%c2":"=&v"(hi[ks]):"v"(vb),"i"(d0*4096+ks*1024+512):"memory");}
    asm volatile("s_waitcnt lgkmcnt(0)":::"memory");SBAR();
    #define PK(k) (bf16x8){lo[k][0],lo[k][1],lo[k][2],lo[k][3],hi[k][0],hi[k][1],hi[k][2],hi[k][3]}
    o[d0]=__builtin_amdgcn_mfma_f32_32x32x16_bf16(pa0,PK(0),o[d0],0,0,0);
    o[d0]=__builtin_amdgcn_mfma_f32_32x32x16_bf16(pa1,PK(1),o[d0],0,0,0);
    o[d0]=__builtin_amdgcn_mfma_f32_32x32x16_bf16(pa2,PK(2),o[d0],0,0,0);
    o[d0]=__builtin_amdgcn_mfma_f32_32x32x16_bf16(pa3,PK(3),o[d0],0,0,0);
    #undef PK
  }
}
template<int VAR,int THRL> __device__ __forceinline__ void attn_unit(int b,int hx,int ux,const bf16*QKVb,bf16*Ob,const float*gates,const float*Cc,const unsigned long long*SEL,float*SSQO,char*shm,const int wv,const bf16*nxK,const bf16*nxV,const bool pf){
  int tid_=opaque_tid(wv);
  const int tid=tid_,lane=tid&63,r32=lane&31,hi=lane>>5; const int wid=wv;
  const long rowbase=(long)b*SEQ;
  const int head=(VAR==0)?hx:(hx*4+(wid>>1));
  const int row0=(VAR==0)?(ux*256+wid*32):(ux*64+(wid&1)*32);
  const int qcol=(VAR==0)?(C_QF+hx*HS):(C_QA+head*HS);
  const int kcol=(VAR==0)?(C_KF+hx*HS):(VAR==1)?(C_SK+hx*HS):(C_WK+hx*HS);
  const int vcol=(VAR==0)?(C_VF+hx*HS):(VAR==1)?(C_SV+hx*HS):(C_WV+hx*HS);
  const int NTreal=(VAR==0)?(4*ux+4):(VAR==1)?(ux+1):((ux<8?ux:8)+1);
  const int NT=NTreal<4?4:NTreal;
  const int tdiag=ux;
  #define TNOM(t) ((VAR==2)?(tdiag-(t)):(t))
  #define TACT(t) ((VAR==2)?((tdiag-(t))<0?0:(tdiag-(t))):(t))
  const bf16*Qw=QKVb+(rowbase+row0)*QP+qcol;
  const bf16*Kh=QKVb+rowbase*QP+kcol,*Vh=QKVb+rowbase*QP+vcol;
  const unsigned lds0=(unsigned)(uintptr_t)shm;
  float*wsf=(float*)(shm+LDS_WS)+wid*64;
  const bf16*ksrc=Kh+(long)lane*QP+wid*8;
  const bf16*vsrc=Vh+(long)(16*(wid&3)+(lane>>2))*QP+(wid>>2)*32+(lane&3)*8;
  const unsigned kdst=lds0+LDS_K+wid*1024, vdst=lds0+LDS_V+wid*1024;
  #define DMA_K(t,slot) glds16(ksrc+(long)TACT(t)*KVBLK*QP,(unsigned)__builtin_amdgcn_readfirstlane(kdst+(slot)))
  #define DMA_V(t,slot) glds16(vsrc+(long)TACT(t)*KVBLK*QP,(unsigned)__builtin_amdgcn_readfirstlane(vdst+(slot)))
  const int vb0=(int)(lds0+LDS_V)+((lane>>4)&1)*32+(lane&3)*8+(4*hi+((lane&15)>>2))*64;
  const char*Kbase=shm+LDS_K; bf16x8 kf[8];
  const lds_cptr shm3=(lds_cptr)shm; const lds_cptr kp0=shm3+LDS_K+hi*1024+r32*16; const lds_cptr vp0=shm3+LDS_V+((lane>>4)&1)*32+(lane&3)*8+(4*hi+((lane&15)>>2))*64;
  const __attribute__((address_space(3))) u32x2* cb3=(const __attribute__((address_space(3))) u32x2*)(shm3+LDS_CB);
  if(!pf){DMA_K(0,0);DMA_V(0,0);DMA_K(1,SLOTB);}
  bf16x8 qr[4];
  #pragma unroll
  for(int d0=0;d0<4;++d0)qr[d0]=*reinterpret_cast<const bf16x8*>(&Qw[(long)r32*QP+d0*16+hi*8]);
  const int qpos=row0+r32; const int lower=(VAR==2)?((qpos-511)<0?0:(qpos-511)):0;
  unsigned long long sel=~0ull; if(VAR==1)sel=SEL[(size_t)(rowbase+qpos)*2+hx];
  bf16x4 qone=bf16x4{};
  #define QONE() do{ if(VAR==0){ int hi_=hi; asm volatile("":"+v"(hi_)); u32x2 q1=(hi_==0)?u32x2{0x3F803F80u,0x00003F80u}:u32x2{0u,0u}; qone=__builtin_bit_cast(bf16x4,q1);} }while(0)
  bf16x4 kb0=bf16x4{},kb1=bf16x4{};
  #define KBLOAD(t) do{ if(VAR==0){ const u32x2 w0_=cb3[64*(t)+r32], w1_=cb3[64*(t)+32+r32]; \
      u32x2 a0_=(hi==0)?w0_:u32x2{0u,0u}; u32x2 a1_=(hi==0)?w1_:u32x2{0u,0u}; \
      kb0=__builtin_bit_cast(bf16x4,a0_); kb1=__builtin_bit_cast(bf16x4,a1_);} }while(0)
  float mhat=0.f,l_reg=0.f;f32x16 o[2];o[0]=f32x16{};o[1]=f32x16{};const f32x16 zero16=f32x16{};
  #define CMASK(P0,P1,t) do{ amask<VAR>(P0,P1,64*TNOM(t),qpos,lower,hi); }while(0)
  bool resc=false;
  #define START(P0,P1) do{ const float rm=rowmax(P0,P1); resc=false; mhat=rm; \
      _Pragma("unroll") for(int r=0;r<16;++r){P0[r]=fsub_s(P0[r],rm);P1[r]=fsub_s(P1[r],rm);} \
    _Pragma("unroll") for(int r=0;r<16;++r)P0[r]=__builtin_amdgcn_exp2f(P0[r]); }while(0)
  #define RESC() do{ if(resc){ asm volatile("s_waitcnt lgkmcnt(0)":::"memory"); const float*wq_=wsf+4*hi; asm volatile("":"+v"(wq_)); \
      _Pragma("unroll") for(int d_=0;d_<2;++d_) _Pragma("unroll") for(int r=0;r<16;++r)o[d_][r]*=wq_[(r&3)+8*(r>>2)]; } }while(0)
  f32x16 pA0,pA1,pB0,pB1;
  int sl_prev=0,sl_cur=0,sl_next=SLOTB,sl_nn=2*SLOTB;
  #define ROT() do{sl_prev=sl_cur;sl_cur=sl_next;sl_next=sl_nn;sl_nn=(sl_nn==(NSLOT-1)*SLOTB)?0:sl_nn+SLOTB;}while(0)
  if(!pf){DMA_K(2,2*SLOTB);}
  DMA_K(3,3*SLOTB);DMA_V(1,SLOTB);
  WAIT_BAR(5);
  KBLOAD(0); QONE();
  qkt<VAR>(pA0,pA1,Kbase,qr,r32,hi,kb0,kb1,qone);asm volatile("s_nop 15\n\ts_nop 7":"+v"(pA0),"+v"(pA1));CMASK(pA0,pA1,0);
  START(pA0,pA1);
  _Pragma("unroll") for(int r=0;r<16;++r)pA1[r]=__builtin_amdgcn_exp2f(pA1[r]);
  WAIT_BAR(2);
  if(4<NT){DMA_K(4,0);} DMA_V(2,2*SLOTB);
  ROT();
  kload8(kf,kp0+sl_cur);
  WAIT_BAR(4);
  s16x4 vlo[8],vhi[8]; u32x4 pw0,pw1,pw2,pw3;
  #define PKW(P,B) cvtpk_s(P[B],P[B+1])
  #define PAF(k) __builtin_bit_cast(bf16x8,pw##k)
  #define VFR(i) (bf16x8){vlo[i][0],vlo[i][1],vlo[i][2],vlo[i][3],vhi[i][0],vhi[i][1],vhi[i][2],vhi[i][3]}
  #define PIN(x) asm volatile("":"+v"(x))
  #define MX3(a,b,c) __builtin_fmaxf(__builtin_fmaxf((a),(b)),(c))
  #define GAPA(MF,A0,A1,A2,A3,W0,W1,PW) do{ MF; sacc+=A0; sacc+=A1; sacc+=A2; sacc+=A3; PIN(sacc); W0; W1; PIN(PW); SBAR(); }while(0)
  #define EX(v) __builtin_amdgcn_exp2f(v)
  #define GAPB(MF,X,B) do{ MF; X[B]=EX(X[B]-mhe); X[B+1]=EX(X[B+1]-mhe); X[B+2]=EX(X[B+2]-mhe); X[B+3]=EX(X[B+3]-mhe); PIN(X); SBAR(); }while(0)
  #define VRD(i) do{ vlo[i]=vtr(vp_+(((i)>>2)*4096+((i)&3)*1024)); vhi[i]=vtr(vp_+(((i)>>2)*4096+((i)&3)*1024+512)); }while(0)
  #define KRD(G,j) do{ if(G){ kload2(kf,kp0+sl_next,j); SBAR(); } }while(0)
  #define STEP(C0,C1,P0,P1,t,GK,GV,GL) do{ SBAR(); \
    const lds_cptr vp_=vp0+sl_prev; \
    VRD(0); SBAR(); float sacc=(P0[0]+P0[1]); \
    GAPA(C0=__builtin_amdgcn_mfma_f32_32x32x16_bf16(kf[0],qr[0],zero16,0,0,0), P0[2],P0[3],P0[4],P0[5],     pw0[0]=PKW(P0,0), pw0[1]=PKW(P0,2), pw0); \
    VRD(4); SBAR(); GAPA(C1=__builtin_amdgcn_mfma_f32_32x32x16_bf16(kf[1],qr[0],zero16,0,0,0), P0[6],P0[7],P0[8],P0[9],     pw0[2]=PKW(P0,4), pw0[3]=PKW(P0,6), pw0); \
    VRD(1); SBAR(); GAPA(C0=__builtin_amdgcn_mfma_f32_32x32x16_bf16(kf[2],qr[1],C0,0,0,0),   P0[10],P0[11],P0[12],P0[13], pw1[0]=PKW(P0,8), pw1[1]=PKW(P0,10), pw1); \
    VRD(5); SBAR(); GAPA(C1=__builtin_amdgcn_mfma_f32_32x32x16_bf16(kf[3],qr[1],C1,0,0,0),   P0[14],P0[15],P1[0],P1[1],   pw1[2]=PKW(P0,12),pw1[3]=PKW(P0,14), pw1); \
    VRD(2); SBAR(); GAPA(C0=__builtin_amdgcn_mfma_f32_32x32x16_bf16(kf[4],qr[2],C0,0,0,0),   P1[2],P1[3],P1[4],P1[5],     pw2[0]=PKW(P1,0), pw2[1]=PKW(P1,2), pw2); \
    VRD(6); SBAR(); GAPA(C1=__builtin_amdgcn_mfma_f32_32x32x16_bf16(kf[5],qr[2],C1,0,0,0),   P1[6],P1[7],P1[8],P1[9],     pw2[2]=PKW(P1,4), pw2[3]=PKW(P1,6), pw2); \
    KBLOAD(t); \
    VRD(3); SBAR(); GAPA(C0=__builtin_amdgcn_mfma_f32_32x32x16_bf16(kf[6],qr[3],C0,0,0,0),   P1[10],P1[11],P1[12],P1[13], pw3[0]=PKW(P1,8), pw3[1]=PKW(P1,10), pw3); \
    VRD(7); SBAR(); GAPA(C1=__builtin_amdgcn_mfma_f32_32x32x16_bf16(kf[7],qr[3],C1,0,0,0),   P1[14],P1[15],0.f,0.f,       pw3[2]=PKW(P1,12),pw3[3]=PKW(P1,14), pw3); \
    l_reg+=sacc; \
    if(VAR==0){ QONE(); C0=__builtin_amdgcn_mfma_f32_32x32x8bf16_1k(kb0,qone,C0,0,0,0); C1=__builtin_amdgcn_mfma_f32_32x32x8bf16_1k(kb1,qone,C1,0,0,0); SBAR(); } \
    if(GK){DMA_K((t)+4,sl_cur);} if(GV){DMA_V((t)+2,sl_nn);} \
    CMASK(C0,C1,t); \
    float mhe; \
    { float a=MX3(C0[0],C0[1],C1[0]),b=MX3(C0[2],C0[3],C1[1]); a=MX3(a,C1[2],C1[3]); \
      _Pragma("unroll") for(int r=4;r<16;r+=4){a=MX3(a,C0[r],C0[r+1]);b=MX3(b,C0[r+2],C0[r+3]);a=MX3(a,C1[r],C1[r+1]);b=MX3(b,C1[r+2],C1[r+3]);} \
      float rm=__builtin_fmaxf(a,b); { auto rr=__builtin_amdgcn_permlane32_swap(__float_as_uint(rm),__float_as_uint(rm),false,false); rm=__builtin_fmaxf(__uint_as_float(rr[0]),__uint_as_float(rr[1])); } \
      bool on_=true; if(VAR==1) on_=((sel>>(t))&1ull)!=0ull; \
      rm=on_?(rm-mhat):-INFINITY; \
      resc=false; \
      if(__builtin_expect(__any(rm>(float)THRL),0)){ const float dl=__builtin_fmaxf(rm,0.f); mhat+=dl; \
        const float f=__builtin_amdgcn_exp2f(-dl); l_reg*=f; if(hi==0)wsf[r32]=f; resc=true; } \
      mhe=on_?mhat:INFINITY; } \
    SBAR(); \
    GAPB(o[0]=__builtin_amdgcn_mfma_f32_32x32x16_bf16(PAF(0),VFR(0),o[0],0,0,0), C0,0); \
    GAPB(o[1]=__builtin_amdgcn_mfma_f32_32x32x16_bf16(PAF(0),VFR(4),o[1],0,0,0), C0,4); \
    KRD(GL,0); GAPB(o[0]=__builtin_amdgcn_mfma_f32_32x32x16_bf16(PAF(1),VFR(1),o[0],0,0,0), C0,8); \
    KRD(GL,1); GAPB(o[1]=__builtin_amdgcn_mfma_f32_32x32x16_bf16(PAF(1),VFR(5),o[1],0,0,0), C0,12); \
    KRD(GL,2); GAPB(o[0]=__builtin_amdgcn_mfma_f32_32x32x16_bf16(PAF(2),VFR(2),o[0],0,0,0), C1,0); \
    KRD(GL,3); GAPB(o[1]=__builtin_amdgcn_mfma_f32_32x32x16_bf16(PAF(2),VFR(6),o[1],0,0,0), C1,4); \
    GAPB(o[0]=__builtin_amdgcn_mfma_f32_32x32x16_bf16(PAF(3),VFR(3),o[0],0,0,0), C1,8); \
    GAPB(o[1]=__builtin_amdgcn_mfma_f32_32x32x16_bf16(PAF(3),VFR(7),o[1],0,0,0), C1,12); \
    }while(0)
  int t=1;
  #undef CMASK
  #define CMASK(P0,P1,t) do{}while(0)
  for(;t+5<NT;t+=2){
    STEP(pB0,pB1,pA0,pA1,t,true,true,true);     WAIT_BAR(4); RESC(); ROT();
    STEP(pA0,pA1,pB0,pB1,t+1,true,true,true);   WAIT_BAR(4); RESC(); ROT();
  }
  #undef CMASK
  #define CMASK(P0,P1,t) do{ amask<VAR>(P0,P1,64*TNOM(t),qpos,lower,hi); }while(0)
  #define CNT_(s_) (((s_)<=0)?((4<NT?1:0)+1):((((s_)+4<NT)?1:0)+(((s_)+2<NT)?1:0)))
  #define ENDW(tt) do{ const int a_=((tt)==NT-2)?0:(CNT_(tt)+CNT_((tt)-1)); if(a_>=4){WAIT_BAR(4);} else if(a_==3){WAIT_BAR(3);} else if(a_==2){WAIT_BAR(2);} else if(a_==1){WAIT_BAR(1);} else {WAIT_BAR(0);} }while(0)
  float gv_=1.f; if(VAR!=0) gv_=gates[(size_t)(rowbase+qpos)*24+head*3+VAR];
  for(;t+1<NT;t+=2){
    STEP(pB0,pB1,pA0,pA1,t,(t+4<NT),(t+2<NT),(t+1<NT));       ENDW(t);   RESC(); ROT();
    STEP(pA0,pA1,pB0,pB1,t+1,(t+5<NT),(t+3<NT),(t+2<NT));     ENDW(t+1); RESC(); ROT();
  }
  #define DRAIN(X0,X1,slot) do{ float sacc=X0[0]+X0[1]; _Pragma("unroll") for(int r=2;r<16;++r)sacc+=X0[r]; _Pragma("unroll") for(int r=0;r<16;++r)sacc+=X1[r]; l_reg+=sacc; \
    pw0=(u32x4){PKW(X0,0),PKW(X0,2),PKW(X0,4),PKW(X0,6)};pw1=(u32x4){PKW(X0,8),PKW(X0,10),PKW(X0,12),PKW(X0,14)};pw2=(u32x4){PKW(X1,0),PKW(X1,2),PKW(X1,4),PKW(X1,6)};pw3=(u32x4){PKW(X1,8),PKW(X1,10),PKW(X1,12),PKW(X1,14)}; \
    SBAR(); pv(o,vb0+(slot),PAF(0),PAF(1),PAF(2),PAF(3)); }while(0)
  if(t<NT){
    STEP(pB0,pB1,pA0,pA1,NT-1,false,false,false); RESC();
    DRAIN(pB0,pB1,sl_cur);
  } else {
    DRAIN(pA0,pA1,sl_prev);
  }
  #undef DRAIN
  float rg_=1.f; if(VAR!=0){ rg_=__builtin_amdgcn_rcpf(gv_); asm volatile("":"+v"(rg_)); }
  if(nxK){ const bf16*kn_=nxK+(long)lane*QP+wid*8; glds16(kn_,(unsigned)__builtin_amdgcn_readfirstlane(kdst)); glds16(kn_+(long)KVBLK*QP,(unsigned)__builtin_amdgcn_readfirstlane(kdst+SLOTB)); glds16(kn_+(long)2*KVBLK*QP,(unsigned)__builtin_amdgcn_readfirstlane(kdst+2*SLOTB)); }
  #undef PKW
  #undef PAF
  #undef VFR
  #undef PIN
  #undef MX3
  #undef GAPA
  #undef GAPB
  #undef EX
  #undef VRD
  #undef KRD
  #undef STEP
  #undef ENDW
  #undef CNT_
  {auto rr=__builtin_amdgcn_permlane32_swap(__float_as_uint(l_reg),__float_as_uint(l_reg),false,false);l_reg=__uint_as_float(rr[0])+__uint_as_float(rr[1]);}
  if(VAR!=0){ l_reg=l_reg*rg_; }
  if(hi==0)wsf[32+r32]=l_reg;asm volatile("s_waitcnt lgkmcnt(0)":::"memory");
  float rli[16];
  { const float*wq_=wsf+32+4*hi; asm volatile("":"+v"(wq_));
  #pragma unroll
  for(int r=0;r<16;++r)rli[r]=__builtin_amdgcn_rcpf(wq_[(r&3)+8*(r>>2)]); }
  bf16*Ow=Ob+(rowbase+row0)*1024+((VAR==0)?(512+hx*64):head*64);
  const bf16*Oc=(const bf16*)((const char*)Ob-(WS_OMIX-WS_O))+(rowbase+row0)*1024+head*64;
  { bf16*stg=(bf16*)(shm+LDS_OST)+wid*2048; bf16*sq_=stg+(4*hi)*64+r32; asm volatile("":"+v"(sq_));
    #pragma unroll
    for(int r=0;r<16;++r){const int orow=(r&3)+8*(r>>2);
      #pragma unroll
      for(int d0=0;d0<2;++d0)sq_[orow*64+d0*32]=f2bf(o[d0][r]*rli[r]);}
    asm volatile("s_waitcnt lgkmcnt(0)":::"memory");
    float*sqp=SSQO+(size_t)(rowbase+row0)*16+((VAR==0)?(8+hx):head);
    u32x4 pvv[4],pcv[4];
    if(VAR==1){
      #pragma unroll
      for(int i=0;i<4;++i){const int row=i*8+(lane>>3),ch=lane&7; pvv[i]=*(const u32x4*)(Ow+(long)row*1024+ch*8); pcv[i]=*(const u32x4*)(Oc+(long)row*1024+ch*8);} }
    #pragma unroll
    for(int i=0;i<4;++i){const int row=i*8+(lane>>3),ch=lane&7; u32x4 v=*(const u32x4*)(stg+row*64+ch*8);
      if(VAR==1){ const u32x4 pv_=pvv[i]; const u32x4 pc_=pcv[i];
        #pragma unroll
        for(int q=0;q<4;++q){ const float lo_=__uint_as_float(v[q]<<16)+(__uint_as_float(pv_[q]<<16)+__uint_as_float(pc_[q]<<16)), hi_=__uint_as_float(v[q]&0xffff0000u)+(__uint_as_float(pv_[q]&0xffff0000u)+__uint_as_float(pc_[q]&0xffff0000u)); v[q]=cvtpk_s(lo_,hi_); } }
      *(u32x4*)(Ow+(long)row*1024+ch*8)=v;
      if(VAR!=2){ float ss=0.f;
        #pragma unroll
        for(int q=0;q<4;++q){ const float lo_=__uint_as_float(v[q]<<16), hi_=__uint_as_float(v[q]&0xffff0000u); ss+=lo_*lo_+hi_*hi_; }
        ss+=__shfl_xor(ss,1); ss+=__shfl_xor(ss,2); ss+=__shfl_xor(ss,4);
        if(ch==0)sqp[(size_t)row*16]=ss; } } }
  asm volatile("s_waitcnt lgkmcnt(0)\n\ts_barrier":::"memory");
  if(nxV){ const bf16*vn_=nxV+(long)(16*(wid&3)+(lane>>2))*QP+(wid>>2)*32+(lane&3)*8; glds16(vn_,(unsigned)__builtin_amdgcn_readfirstlane(vdst)); }
  #undef DMA_K
  #undef DMA_V
  #undef CMASK
  #undef SELMASK
  #undef START
  #undef RESC
  #undef ROT
  #undef KBLOAD
  #undef QONE
  #undef TNOM
  #undef TACT
}
#undef SBAR
#undef WAIT_BAR
}
namespace cmpx {
using att::bf16x8; using att::s16x4; using att::f32x16; using att::u32x4; using att::lds_cptr;
constexpr int TKS = 9;
constexpr int L_KI = 0, L_VI = 32768, L_IMP = 65536, IMP_ROW = 65, IMP_WAVE = 32 * IMP_ROW * 4, LDS_BYTES_CMP = L_IMP + 8 * IMP_WAVE;
__device__ __forceinline__ float swap_half(float x, int hi) {
    auto rr = __builtin_amdgcn_permlane32_swap(__float_as_uint(x), __float_as_uint(x), false, false);
    return __uint_as_float(hi ? rr[0] : rr[1]);
}
__device__ __forceinline__ unsigned bcnt64(unsigned long long m) { unsigned n; asm("s_bcnt1_i32_b64 %0, %1" : "=s"(n) : "s"(m) : "scc"); return n; }
__device__ __forceinline__ void load_kv(int bk, const bf16* KC, const bf16* VC, char* shm, int tid) {
    const bf16* kc = KC + (size_t)bk * 256 * 64; const bf16* vc = VC + (size_t)bk * 256 * 64;
#pragma unroll
    for (int u = 0; u < 4; ++u) { const int i = tid + 512 * u, r = i >> 3, c = i & 7;
        const u32x4 kv = *(const u32x4*)(kc + r * 64 + c * 8), vv = *(const u32x4*)(vc + r * 64 + c * 8);
        *(u32x4*)(shm + L_KI + c * 4096 + r * 16) = kv;
        *(u32x4*)(shm + L_VI + (c >> 2) * 16384 + r * 64 + (c & 3) * 16) = vv; }
}
__device__ __forceinline__ void cmp_unit(int bk, int blk, const bf16* QKVb, const float* gates, bf16* OC, unsigned long long* SEL, char* shm, const int wv) {
    const int tid = opaque_tid(wv), lane = tid & 63, r32 = lane & 31, hi = lane >> 5, wid = wv;
    const int g = wid >> 1, th = wid & 1, b = bk >> 1, kvh = bk & 1, head = kvh * 4 + g;
    const long rowbase = (long)b * SEQ;
    const int tok0 = blk * 64 + th * 32, t = tok0 + r32;
    const bf16* Qw = QKVb + (rowbase + tok0) * QP + C_QA + (long)head * HS;
    bf16x8 qr[4];
#pragma unroll
    for (int d0 = 0; d0 < 4; ++d0) qr[d0] = *reinterpret_cast<const bf16x8*>(&Qw[(long)r32 * QP + d0 * 16 + hi * 8]);
    float gvv[16];
    { const float* gp = gates + (size_t)(rowbase + tok0 + 4 * hi) * 24 + head * 3; asm volatile("" : "+v"(gp));
#pragma unroll
      for (int r = 0; r < 16; ++r) gvv[r] = gp[((r & 3) + 8 * (r >> 2)) * 24]; }
    const int ntile = (4 * blk + 3 + 31) >> 5;
    const lds_cptr shm3 = (lds_cptr)shm;
    f32x16 S[8];
    { const lds_cptr kp = shm3 + L_KI + hi * 4096 + r32 * 16;
#pragma unroll
      for (int j = 0; j < 8; ++j) {
          if (j < ntile) { f32x16 a = f32x16{};
#pragma unroll
              for (int d0 = 0; d0 < 4; ++d0) a = __builtin_amdgcn_mfma_f32_32x32x16_bf16(*(const __attribute__((address_space(3))) bf16x8*)(kp + d0 * 8192 + j * 512), qr[d0], a, 0, 0, 0);
              S[j] = a; }
          else S[j] = f32x16{}; } }
    const int nlim = (t - 31) >> 4;
    const int nl0 = (tok0 - 31) >> 4;
    float m = -INFINITY;
    { int nb = 4 * hi; asm volatile("" : "+v"(nb));
#pragma unroll
      for (int j = 0; j < 8; ++j) if (j < ntile) {
          if (32 * j + 31 > nl0) {
#pragma unroll
              for (int r = 0; r < 16; ++r) { const int n = nb + 32 * j + (r & 3) + 8 * (r >> 2); if (n > nlim) S[j][r] = -INFINITY; } }
          float a = att::max3f(S[j][0], S[j][1], S[j][2]), c = att::max3f(S[j][3], S[j][4], S[j][5]);
          a = att::max3f(a, S[j][6], S[j][7]); c = att::max3f(c, S[j][8], S[j][9]); a = att::max3f(a, S[j][10], S[j][11]); c = att::max3f(c, S[j][12], S[j][13]);
          a = att::max3f(a, S[j][14], S[j][15]); m = att::max3f(m, a, c); } }
    m = fmaxf(m, swap_half(m, hi));
    if (m == -INFINITY) m = 0.f;
    float l = 0.f;
#pragma unroll
    for (int j = 0; j < 8; ++j) if (j < ntile) {
#pragma unroll
        for (int r = 0; r < 16; ++r) { S[j][r] = __builtin_amdgcn_exp2f(S[j][r] - m); l += S[j][r]; } }
    l += swap_half(l, hi);
    const float rl = l > 0.f ? 1.0f / l : 0.f;
#pragma unroll
    for (int j = 0; j < 8; ++j) if (j < ntile) S[j] = S[j] * rl;
    { float* impw = (float*)(shm + L_IMP + wid * IMP_WAVE) + r32 * IMP_ROW + hi;
      float carry = 0.f;
#pragma unroll
      for (int j = 0; j < 8; ++j) if (j < ntile)
#pragma unroll
          for (int k = 0; k < 4; ++k) {
              const float G = (S[j][4 * k] + S[j][4 * k + 1]) + (S[j][4 * k + 2] + S[j][4 * k + 3]);
              const float LP = swap_half(S[j][4 * k + 3], hi);
              impw[2 * (4 * j + k)] = G + (hi ? LP : carry);
              carry = LP; } }
    __syncthreads();
    {
      if (blk < 16) {
          if (lane < 8) SEL[(size_t)(rowbase + blk * 64 + wid * 8 + lane) * 2 + kvh] = (2ull << blk) - 1ull;
      } else {
#pragma unroll 1
      for (int i = 0; i < 8; i += 4) {
          const int cur = blk; unsigned kb[4]; bool vld[4];
#pragma unroll
          for (int u = 0; u < 4; ++u) { const int tl = wid * 8 + i + u, th2 = tl >> 5, q2 = tl & 31;
              const float* ip = (const float*)(shm + L_IMP) + q2 * IMP_ROW + lane;
              float val = (ip[(0 + th2) * (IMP_WAVE / 4)] + ip[(2 + th2) * (IMP_WAVE / 4)]) + (ip[(4 + th2) * (IMP_WAVE / 4)] + ip[(6 + th2) * (IMP_WAVE / 4)]);
              if (lane > cur) val = -1.f; else if (lane == 0 || lane == cur || lane == cur - 1) val = 1e6f;
              vld[u] = val >= 0.f; kb[u] = vld[u] ? __float_as_uint(val) : 0u; }
          unsigned T[4] = {0u, 0u, 0u, 0u};
#pragma unroll
          for (int bit = 30; bit >= TKS; --bit) {
#pragma unroll
              for (int u = 0; u < 4; ++u) { const unsigned c = T[u] | (1u << bit); T[u] = bcnt64(__ballot(kb[u] >= c)) >= 16u ? c : T[u]; } }
          bool more = false;
#pragma unroll
          for (int u = 0; u < 4; ++u) { const unsigned hi1 = T[u] + (1u << TKS);
              const unsigned n_eq = bcnt64(__ballot(kb[u] >= T[u] && kb[u] < hi1 && vld[u])), n_gt = bcnt64(__ballot(kb[u] >= hi1));
              more = more || (n_gt + n_eq != 16u); }
          if (more) {
#pragma unroll
              for (int bit = TKS - 1; bit >= 0; --bit) {
#pragma unroll
                  for (int u = 0; u < 4; ++u) { const unsigned c = T[u] | (1u << bit); T[u] = bcnt64(__ballot(kb[u] >= c)) >= 16u ? c : T[u]; } } }
#pragma unroll
          for (int u = 0; u < 4; ++u) { const int tl = wid * 8 + i + u;
              const bool gt_ = kb[u] > T[u], eq_ = (kb[u] == T[u]) && vld[u];
              const unsigned long long eqm = __ballot(eq_); const int need = 16 - (int)bcnt64(__ballot(gt_));
              const int below = (int)__builtin_amdgcn_mbcnt_hi((unsigned)(eqm >> 32), __builtin_amdgcn_mbcnt_lo((unsigned)eqm, 0u));
              const unsigned long long selmask = __ballot(gt_ || (eq_ && below < need));
              if (lane == 0) SEL[(size_t)(rowbase + blk * 64 + tl) * 2 + kvh] = selmask; } } } }
    __syncthreads();
    f32x16 o[2]; o[0] = f32x16{}; o[1] = f32x16{};
    { const lds_cptr vp0 = shm3 + L_VI + ((lane >> 4) & 1) * 32 + (lane & 3) * 8 + (4 * hi + ((lane & 15) >> 2)) * 64;
#pragma unroll
      for (int j = 0; j < 8; ++j) if (j < ntile) {
#pragma unroll
          for (int s = 0; s < 2; ++s) {
              u32x4 pw; pw[0] = att::cvtpk_s(S[j][8 * s], S[j][8 * s + 1]); pw[1] = att::cvtpk_s(S[j][8 * s + 2], S[j][8 * s + 3]); pw[2] = att::cvtpk_s(S[j][8 * s + 4], S[j][8 * s + 5]); pw[3] = att::cvtpk_s(S[j][8 * s + 6], S[j][8 * s + 7]);
#pragma unroll
              for (int d0 = 0; d0 < 2; ++d0) { const s16x4 lo = att::vtr(vp0 + d0 * 16384 + j * 2048 + s * 1024), hh = att::vtr(vp0 + d0 * 16384 + j * 2048 + s * 1024 + 512);
                  const bf16x8 vf = (bf16x8){lo[0], lo[1], lo[2], lo[3], hh[0], hh[1], hh[2], hh[3]};
                  o[d0] = __builtin_amdgcn_mfma_f32_32x32x16_bf16(__builtin_bit_cast(bf16x8, pw), vf, o[d0], 0, 0, 0); } } } }
    { bf16* stg = (bf16*)(shm + L_IMP + wid * IMP_WAVE); bf16* sq_ = stg + (4 * hi) * 64 + r32; asm volatile("" : "+v"(sq_));
#pragma unroll
      for (int r = 0; r < 16; ++r) { const int orow = (r & 3) + 8 * (r >> 2); const float gv = gvv[r];
#pragma unroll
          for (int d0 = 0; d0 < 2; ++d0) sq_[orow * 64 + d0 * 32] = f2bf(o[d0][r] * gv); }
      asm volatile("s_waitcnt lgkmcnt(0)" ::: "memory");
      bf16* Ow = OC + (rowbase + tok0) * 1024 + head * 64;
#pragma unroll
      for (int i = 0; i < 4; ++i) { const int row = i * 8 + (lane >> 3), ch = lane & 7; const u32x4 v = *(const u32x4*)(stg + row * 64 + ch * 8);
          *(u32x4*)(Ow + (long)row * 1024 + ch * 8) = v; } }
    __syncthreads();
}
}
#define LAS __attribute__((address_space(3)))
typedef unsigned v4u __attribute__((ext_vector_type(4)));
typedef float f32x4 __attribute__((ext_vector_type(4)));
constexpr int NWAVES = 8;
constexpr int RING_BYTES = 131072, LDS_BYTES = 147456;

__device__ __forceinline__ unsigned pk2(float lo, float hi) { return (unsigned)f2bf(lo) | ((unsigned)f2bf(hi) << 16); }
__device__ __forceinline__ int src_win(int np) {
    const int tile = np >> 8, w = np & 255;
    if (tile == 11) { if (w < 24) return 1280 + w; if (w < 32) return 2840 + (w - 24); return -1; }
    const int half = w >> 7, head = (w >> 5) & 3, i = w & 31;
    const int c = tile * 256 + head * 64 + half * 32 + i;
    return c < 1280 ? c : c + 24;
}
template <bool F8 = false> __device__ __forceinline__ void transpose_item(const float* W, int N, int K, const float* gain, bf16* WT, int n0, int k0, int sc4, LAS float* scr, int lane) {
    const int kr = lane >> 3, c4 = (lane & 7) * 4;
    f32x4 v[8];
#pragma unroll
    for (int i = 0; i < 8; ++i) v[i] = sc4 >= 0 ? __builtin_nontemporal_load((const f32x4*)(W + (size_t)(k0 + 8 * i + kr) * N + sc4)) : (f32x4){0.f, 0.f, 0.f, 0.f};
#pragma unroll
    for (int i = 0; i < 8; ++i) { const int kk = 8 * i + kr; const float gg = gain ? gain[k0 + kk] : 1.f;
#pragma unroll
        for (int e = 0; e < 4; ++e) scr[kk * 33 + c4 + e] = v[i][e] * gg; }
    asm volatile("s_waitcnt lgkmcnt(0)" ::: "memory");
    const int c = lane & 7;
#pragma unroll
    for (int j = 0; j < 4; ++j) { const int n = (lane >> 3) + 8 * j; const LAS float* s = scr + (8 * c) * 33 + n;
        if (F8) { int w0 = __builtin_amdgcn_cvt_pk_fp8_f32(s[0 * 33], s[1 * 33], 0, false); w0 = __builtin_amdgcn_cvt_pk_fp8_f32(s[2 * 33], s[3 * 33], w0, true);
            int w1 = __builtin_amdgcn_cvt_pk_fp8_f32(s[4 * 33], s[5 * 33], 0, false); w1 = __builtin_amdgcn_cvt_pk_fp8_f32(s[6 * 33], s[7 * 33], w1, true);
            *(unsigned long long*)((unsigned char*)WT + (size_t)(n0 + n) * K + k0 + 8 * c) = (unsigned long long)(unsigned)w0 | ((unsigned long long)(unsigned)w1 << 32); }
        else { v4u o; o.x = pk2(s[0 * 33], s[1 * 33]); o.y = pk2(s[2 * 33], s[3 * 33]); o.z = pk2(s[4 * 33], s[5 * 33]); o.w = pk2(s[6 * 33], s[7 * 33]);
            *(v4u*)(WT + (size_t)(n0 + n) * K + k0 + 8 * c) = o; } }
    asm volatile("s_waitcnt lgkmcnt(0)" ::: "memory");
}
template <int PART> __device__ __forceinline__ void ph_prep(const P& p, LAS unsigned char* lds, const int wv, const int vb, const int nvb) {
    const int tid = opaque_tid(wv), lane = tid & 63, wave = wv;
    const int gw = vb * NWAVES + wave, NGW = nvb * NWAVES;
    LAS float* scr = (LAS float*)(lds + wave * 16384);
    constexpr int I_GU = 176 * 16, I_D = 32 * 44, I_IN = 96 * 16, I_SQ = 32 * 16, I_PR = 32 * 4, I_C1 = 512, I_C2 = 16, I_PB = 128;
    constexpr int NITEMS = PART == 0 ? (I_GU + I_D + I_IN + I_C1 + I_C2 + I_PB) : (I_GU + I_D + 2 * I_SQ + I_PR);
    for (int it = gw; it < NITEMS; it += NGW) {
        int r = it;
        if (r < I_GU) {
            const int ng = r / 16, kb = r % 16, n0 = ng * 32, tile = n0 >> 8, w = n0 & 255;
            const float* W = PART ? (w < 128 ? p.in[25] : p.in[26]) : (w < 128 ? p.in[3] : p.in[4]);
            if (PART == 0) transpose_item<F8_G1>(W, DFF, D, nullptr, (bf16*)(p.ws + WS_WGU1), n0, kb * 64, tile * 128 + (w & 127) + 4 * (lane & 7), scr, lane);
            else transpose_item<F8_G5>(W, DFF, D, p.in[24], (bf16*)(p.ws + WS_WGU2), n0, kb * 64, tile * 128 + (w & 127) + 4 * (lane & 7), scr, lane);
            continue; }
        r -= I_GU;
        if (r < I_D) {
            const int ng = r / 44, kb = r % 44;
            if (PART == 0) transpose_item<F8_G2>(p.in[5], D, DFF, nullptr, (bf16*)(p.ws + WS_WD1), ng * 32, kb * 64, ng * 32 + 4 * (lane & 7), scr, lane);
            else transpose_item<F8_G6>(p.in[27], D, DFF, nullptr, (bf16*)(p.ws + WS_WD2), ng * 32, kb * 64, ng * 32 + 4 * (lane & 7), scr, lane);
            continue; }
        r -= I_D;
        if (PART == 0) {
            if (r < I_IN) { const int ng = r / 16, kb = r % 16;
                transpose_item(p.in[7], INW, D, p.in[6], (bf16*)(p.ws + WS_WIN), ng * 32, kb * 64, src_win(ng * 32 + 4 * (lane & 7)), scr, lane);
                continue; }
            r -= I_IN;
            if (r < I_C1) { const int ng = r >> 5, kb = r & 31, which = ng >> 3;
                transpose_item(which ? p.in[17] : p.in[15], 256, 2048, nullptr, (bf16*)(p.ws + WS_WC1), ng * 32, kb * 64, (ng & 7) * 32 + 4 * (lane & 7), scr, lane);
                continue; }
            r -= I_C1;
            if (r < I_C2) { const int ng = r >> 2, kb = r & 3, which = ng >> 1;
                transpose_item(which ? p.in[18] : p.in[16], 64, 256, nullptr, (bf16*)(p.ws + WS_WC2), ng * 32, kb * 64, (ng & 1) * 32 + 4 * (lane & 7), scr, lane);
                continue; }
            r -= I_C2;
            {
                const int which = r >> 6, p64 = r & 63; const float* pos = which ? p.in[14] : p.in[13]; const float* w1 = which ? p.in[17] : p.in[15];
                f32x4 acc = (f32x4){0.f, 0.f, 0.f, 0.f};
#pragma unroll 1
                for (int r0 = 0; r0 < 32; r0 += 8) { f32x4 wv_[8];
#pragma unroll
                    for (int q = 0; q < 8; ++q) wv_[q] = __builtin_nontemporal_load((const f32x4*)(w1 + (size_t)(32 * p64 + r0 + q) * 256) + lane);
#pragma unroll
                    for (int q = 0; q < 8; ++q) acc = acc + wv_[q] * pos[32 * p64 + r0 + q]; }
                *((f32x4*)(p.ws + WS_POSBP) + (size_t)(which * 64 + p64) * 64 + lane) = acc; }
        } else {
            if (r < 2 * I_SQ) { const int second = r >= I_SQ; if (second) r -= I_SQ;
                const int ng = r / 16, kb = r % 16;
                transpose_item(second ? p.in[29] : p.in[23], D, D, second ? p.in[28] : (const float*)(p.ws + WS_GOUT), (bf16*)(p.ws + (second ? WS_WGATE : WS_WOUT)), ng * 32, kb * 64, ng * 32 + 4 * (lane & 7), scr, lane);
                continue; }
            r -= 2 * I_SQ;
            { const int ng = r / 4, kb = r % 4;
              transpose_item(p.in[30], D, DPLE, nullptr, (bf16*)(p.ws + WS_WPROJ), ng * 32, kb * 64, ng * 32 + 4 * (lane & 7), scr, lane); }
        }
    }
    if (PART == 0) {
    for (int i = vb * 512 + tid; i < 1024; i += nvb * 512) ((float*)(p.ws + WS_GOUT))[i] = i < 512 ? p.in[21][i] : p.in[22][i - 512];
    { bf16* XN = (bf16*)(p.ws + (F8_G1 ? WS_O : WS_XN)); const float* g1 = p.in[2];
      f32x4 gg[4];
#pragma unroll
      for (int j = 0; j < 4; ++j) gg[j] = *((const f32x4*)g1 + lane + 64 * j);
      for (int m0 = gw * 8; m0 < M; m0 += NGW * 8) {
          f32x4 v[8][4];
#pragma unroll
          for (int r = 0; r < 8; ++r) { const f32x4* xr = (const f32x4*)(p.in[0] + (size_t)(m0 + r) * D) + lane;
#pragma unroll
              for (int j = 0; j < 4; ++j) v[r][j] = __builtin_nontemporal_load(xr + 64 * j); }
#pragma unroll
          for (int r = 0; r < 8; ++r) { float s = 0.f;
#pragma unroll
              for (int j = 0; j < 4; ++j) s += (v[r][j][0] * v[r][j][0] + v[r][j][1] * v[r][j][1]) + (v[r][j][2] * v[r][j][2] + v[r][j][3] * v[r][j][3]);
              s = wave_sum(s);
              const float rs = 1.0f / sqrtf(s * (1.f / D) + EPS);
              if constexpr (F8_G1) { unsigned* o4 = (unsigned*)((unsigned char*)XN + (size_t)(m0 + r) * D) + lane;
#pragma unroll
                  for (int j = 0; j < 4; ++j) { int w = __builtin_amdgcn_cvt_pk_fp8_f32(v[r][j][0] * rs * gg[j][0], v[r][j][1] * rs * gg[j][1], 0, false);
                      w = __builtin_amdgcn_cvt_pk_fp8_f32(v[r][j][2] * rs * gg[j][2], v[r][j][3] * rs * gg[j][3], w, true); o4[64 * j] = (unsigned)w; } }
              else { unsigned long long* o8 = (unsigned long long*)(XN + (size_t)(m0 + r) * D) + lane;
#pragma unroll
                  for (int j = 0; j < 4; ++j) o8[64 * j] = (unsigned long long)pk2(v[r][j][0] * rs * gg[j][0], v[r][j][1] * rs * gg[j][1]) | ((unsigned long long)pk2(v[r][j][2] * rs * gg[j][2], v[r][j][3] * rs * gg[j][3]) << 32); } }
      } }
    { float* rope = (float*)(p.ws + WS_ROPE);
      for (int t = vb * 16 + tid; tid < 16 && t < SEQ; t += nvb * 16) {
#pragma unroll
        for (int f = 0; f < 8; ++f) {
          const double ang = (double)t * p.rc[f];
          const double kq = __builtin_rint(ang * p.rc[8]);
          double r = __builtin_fma(-kq, p.rc[9], ang); r = __builtin_fma(-kq, p.rc[10], r);
          const float x = (float)r, x2 = x * x; const int q = (int)kq & 3;
          const float sn = x + x * x2 * (-1.6666667e-1f + x2 * (8.3333333e-3f + x2 * (-1.9841270e-4f + x2 * 2.7557319e-6f)));
          const float cs = 1.0f + x2 * (-0.5f + x2 * (4.1666667e-2f + x2 * (-1.3888889e-3f + x2 * (2.4801587e-5f + x2 * -2.7557319e-7f))));
          const float c = q == 0 ? cs : q == 1 ? -sn : q == 2 ? -cs : sn;
          const float s = q == 0 ? sn : q == 1 ? cs : q == 2 ? -sn : -cs;
          rope[t * 16 + f] = c; rope[t * 16 + 8 + f] = s; } } }
    }
    if (PART == 1) {
    { const f32x4* src = (const f32x4*)p.in[1]; unsigned long long* dst = (unsigned long long*)(p.ws + WS_PB);
      for (size_t i = (size_t)vb * 512 + tid; i < (size_t)M * DPLE / 4; i += (size_t)nvb * 512) { const f32x4 v = __builtin_nontemporal_load(src + i); dst[i] = (unsigned long long)pk2(v[0], v[1]) | ((unsigned long long)pk2(v[2], v[3]) << 32); } }
    }
}

#define RLX_AGENT __ATOMIC_RELAXED, __HIP_MEMORY_SCOPE_AGENT
#define XB_TMO      128
#define XB_XCNT(j)  (256  + 64 * (j))
#define XB_XSUB(j)  (1280 + 64 * (j))
#define XB_XGEN(j)  (2304 + 64 * (j))
#define XB_TOP      3328
#define XB_TOPGEN   3392
#define XCD_BAR_WORDS 3456
#define XB_SPIN_CAP (1u << 18)

__device__ __forceinline__ unsigned xb_ld(unsigned* p)              { return __hip_atomic_load(p, __ATOMIC_RELAXED, __HIP_MEMORY_SCOPE_AGENT); }
__device__ __forceinline__ unsigned xb_add(unsigned* p, unsigned v) { return __hip_atomic_fetch_add(p, v, __ATOMIC_RELAXED, __HIP_MEMORY_SCOPE_AGENT); }
__device__ __forceinline__ unsigned xb_xcc_id() { return (unsigned)__builtin_amdgcn_s_getreg((3 << 11) | 20) & 0xFu; }
#define XB_SPIN(cond, bar) do { unsigned _sp = 0; while (cond) { __builtin_amdgcn_s_sleep(1); \
    if ((++_sp & 255u) == 0u) { if (xb_ld(&(bar)[XB_TMO])) break; if (_sp > XB_SPIN_CAP) { atomicAdd(&(bar)[XB_TMO], 1u); break; } } } } while (0)

struct XcdBarrier {
    unsigned* bar; unsigned x;
    volatile LAS unsigned* st;
};

__device__ __forceinline__ XcdBarrier xcd_barrier_post(unsigned* bar, volatile LAS unsigned* st, bool leader) {
    XcdBarrier b; b.bar = bar; b.x = xb_xcc_id(); b.st = st;
    if (leader) st[2] = xb_add(&bar[XB_XCNT(b.x)], 1u);
    return b;
}
__device__ __forceinline__ void xcd_barrier_complete(unsigned* bar, unsigned x, unsigned& nloc, unsigned& nx) {
    const unsigned G = gridDim.x * gridDim.y * gridDim.z;
    unsigned sum, cnt, mine, sp = 0u;
    for (;;) {
        sum = 0u; cnt = 0u; mine = 0u;
#pragma unroll
        for (unsigned j = 0; j < 16; ++j) { const unsigned c = xb_ld(&bar[XB_XCNT(j)]); sum += c; cnt += (c > 0u) ? 1u : 0u; mine = (j == x) ? c : mine; }
        if (sum == G) break;
        __builtin_amdgcn_s_sleep(1);
        if ((++sp & 255u) == 0u) { if (xb_ld(&bar[XB_TMO])) break; if (sp > XB_SPIN_CAP) { atomicAdd(&bar[XB_TMO], 1u); break; } }
    }
    nloc = mine > 0u ? mine : 1u; nx = cnt > 0u ? cnt : 1u;
}

__device__ __forceinline__ void xcd_barrier(const XcdBarrier& b, bool leader) {
    asm volatile("s_waitcnt vmcnt(0)" ::: "memory");
    __syncthreads();
    if (leader) {
        unsigned* bar = b.bar;
        __builtin_amdgcn_s_waitcnt(0);
        unsigned nloc = b.st[0], nx = b.st[1];
        if (nloc == 0u) { xcd_barrier_complete(bar, b.x, nloc, nx); b.st[0] = nloc; b.st[1] = nx; }
        const unsigned old = xb_add(&bar[XB_XSUB(b.x)], 1u);
        const unsigned gen = old / nloc;
        if (old + 1u == (gen + 1u) * nloc) {
            __builtin_amdgcn_fence(__ATOMIC_RELEASE, "agent");
            asm volatile("s_waitcnt vmcnt(0)" ::: "memory");
            const unsigned og = xb_add(&bar[XB_TOP], 1u);
            const unsigned tg = og / nx;
            if (og + 1u == (tg + 1u) * nx) xb_add(&bar[XB_TOPGEN], 1u);
            else XB_SPIN(xb_ld(&bar[XB_TOPGEN]) == tg, bar);
            __builtin_amdgcn_fence(__ATOMIC_ACQUIRE, "agent");
            xb_add(&bar[XB_XGEN(b.x)], 1u);
            asm volatile("s_waitcnt vmcnt(0)" ::: "memory");
        } else {
            XB_SPIN(xb_ld(&bar[XB_XGEN(b.x)]) == gen, bar);
            __builtin_amdgcn_fence(__ATOMIC_ACQUIRE, "agent");
            asm volatile("s_waitcnt vmcnt(0)" ::: "memory");
        }
    }
    __syncthreads();
}
__device__ __forceinline__ void xcd_barrier_local(const XcdBarrier& b, bool leader) {
    asm volatile("s_waitcnt vmcnt(0)" ::: "memory");
    __syncthreads();
    if (leader) {
        unsigned* bar = b.bar;
        __builtin_amdgcn_s_waitcnt(0);
        unsigned nloc = b.st[0], nx = b.st[1];
        if (nloc == 0u) { xcd_barrier_complete(bar, b.x, nloc, nx); b.st[0] = nloc; b.st[1] = nx; }
        const unsigned old = xb_add(&bar[XB_XSUB(b.x)], 1u);
        const unsigned gen = old / nloc;
        if (old + 1u == (gen + 1u) * nloc) {
            __builtin_amdgcn_fence(__ATOMIC_ACQUIRE, "agent");
            xb_add(&bar[XB_XGEN(b.x)], 1u);
            asm volatile("s_waitcnt vmcnt(0)" ::: "memory");
        } else {
            XB_SPIN(xb_ld(&bar[XB_XGEN(b.x)]) == gen, bar);
            __builtin_amdgcn_fence(__ATOMIC_ACQUIRE, "agent");
            asm volatile("s_waitcnt vmcnt(0)" ::: "memory");
        }
    }
    __syncthreads();
}

template <int VAR> __device__ __forceinline__ void ph_attn(const P& p, LAS unsigned char* lds, const int wv) {
    char* shm = (char*)lds;
    const bf16* QKV = (const bf16*)(p.ws + WS_BIG);
    bf16* Ob = (bf16*)(p.ws + WS_OMIX); float* SSQO = (float*)(p.ws + WS_SSQO);
    const float* gates = (const float*)(p.ws + WS_GATES);
    const float* Cc = (const float*)(p.ws + WS_C);
    const unsigned long long* SEL = (const unsigned long long*)(p.ws + WS_SEL);
    const int G = gridDim.x, bx = blockIdx.x;
    const int vcu0 = (G == 256) ? (bx % 8) * (G / 8) + bx / 8 : bx;
    int cur_bh = -1;
    for (int i = 0;; ++i) {
        const int L = i * G + vcu0; if (L >= 1024) break;
        const int vcu = L & 255, rnd = L >> 8;
        if (VAR == 0) {
            const int bh = vcu >> 2, s = vcu & 3, qb = rnd == 0 ? s : rnd == 1 ? 7 - s : rnd == 2 ? 8 + s : 15 - s;
            if (bh != cur_bh) {
                cur_bh = bh;
                __syncthreads();
                LAS unsigned* cb = (LAS unsigned*)(lds + att::LDS_CB);
                const int k0_ = opaque_tid(wv);
                float cv_[8];
#pragma unroll
                for (int u = 0; u < 8; ++u) cv_[u] = Cc[(size_t)bh * SEQ + k0_ + 512 * u];
#pragma unroll
                for (int u = 0; u < 8; ++u) { const int k = k0_ + 512 * u; const float v = -cv_[u] * LOG2E;
                    const bf16 h1 = f2bf(v); const float r1 = v - bf2f(h1); const bf16 h2 = f2bf(r1); const float r2 = r1 - bf2f(h2); const bf16 h3 = f2bf(r2);
                    cb[2 * k] = (unsigned)h1 | ((unsigned)h2 << 16); cb[2 * k + 1] = (unsigned)h3; }
                __syncthreads();
            }
            att::attn_unit<0, 8>(bh >> 3, bh & 7, qb, QKV, Ob, gates, Cc, SEL, SSQO, shm, wv, nullptr, nullptr, false);
        } else {
            const int bk = vcu >> 4, s = vcu & 15, blk = rnd == 0 ? s : rnd == 1 ? 31 - s : rnd == 2 ? 32 + s : 63 - s;
            att::attn_unit<VAR, 8>(bk >> 1, bk & 1, blk, QKV, Ob, gates, Cc, SEL, SSQO, shm, wv, nullptr, nullptr, false);
        }
    }
}

__device__ __forceinline__ void ph_cmpsel2(const P& p, LAS unsigned char* lds, const int wv) {
    char* shm = (char*)lds;
    const int G = gridDim.x, bx = blockIdx.x;
    const int vcu0 = (G == 256) ? (bx % 8) * (G / 8) + bx / 8 : bx;
    int cur_bk = -1;
    for (int i = 0;; ++i) {
        const int L = i * G + vcu0; if (L >= 1024) break;
        const int vcu = L & 255, rnd = L >> 8, bk = vcu >> 4, s = vcu & 15, blk = rnd == 0 ? s : rnd == 1 ? 31 - s : rnd == 2 ? 32 + s : 63 - s;
        if (bk != cur_bk) { cur_bk = bk; __syncthreads(); cmpx::load_kv(bk, (const bf16*)(p.ws + WS_KCMP), (const bf16*)(p.ws + WS_VCMP), shm, opaque_tid(wv)); __syncthreads(); }
        cmpx::cmp_unit(bk, blk, (const bf16*)(p.ws + WS_BIG), (const float*)(p.ws + WS_GATES), (bf16*)(p.ws + WS_O), (unsigned long long*)(p.ws + WS_SEL), shm, wv);
    }
}

__device__ __forceinline__ void ph_attn_fs(const P& p, LAS unsigned char* lds, const int wv, const int bx) {
    char* shm = (char*)lds;
    const bf16* QKV = (const bf16*)(p.ws + WS_BIG); bf16* Ob = (bf16*)(p.ws + WS_OMIX); float* SSQO = (float*)(p.ws + WS_SSQO);
    const float* gates = (const float*)(p.ws + WS_GATES); const float* Cc = (const float*)(p.ws + WS_C); const unsigned long long* SEL = (const unsigned long long*)(p.ws + WS_SEL);
    const int vcu = (bx % 8) * 32 + bx / 8;
    const int bh = vcu >> 2, sf = vcu & 3, bk = vcu >> 4, ss = vcu & 15;
    const bf16* fK = QKV + (size_t)(bh >> 3) * SEQ * QP + C_KF + (size_t)(bh & 7) * HS; const bf16* fV = QKV + (size_t)(bh >> 3) * SEQ * QP + C_VF + (size_t)(bh & 7) * HS;
    const bf16* sK = QKV + (size_t)(bk >> 1) * SEQ * QP + C_SK + (size_t)(bk & 1) * HS; const bf16* sV = QKV + (size_t)(bk >> 1) * SEQ * QP + C_SV + (size_t)(bk & 1) * HS;
    { __syncthreads(); cmpx::load_kv(bk, (const bf16*)(p.ws + WS_KCMP), (const bf16*)(p.ws + WS_VCMP), shm, opaque_tid(wv)); __syncthreads();
#pragma unroll 1
      for (int i = 0; i < 4; ++i) { const int blk = i == 0 ? ss : i == 1 ? 31 - ss : i == 2 ? 32 + ss : 63 - ss;
          cmpx::cmp_unit(bk, blk, QKV, gates, (bf16*)(p.ws + WS_O), (unsigned long long*)(p.ws + WS_SEL), shm, wv); }
      __syncthreads(); }
    {
        LAS unsigned* cb = (LAS unsigned*)(lds + att::LDS_CB);
        const int k0_ = opaque_tid(wv);
        float cv_[8];
#pragma unroll
        for (int u = 0; u < 8; ++u) cv_[u] = Cc[(size_t)bh * SEQ + k0_ + 512 * u];
#pragma unroll
        for (int u = 0; u < 8; ++u) { const int k = k0_ + 512 * u; const float v = -cv_[u] * LOG2E;
            const bf16 h1 = f2bf(v); const float r1 = v - bf2f(h1); const bf16 h2 = f2bf(r1); const float r2 = r1 - bf2f(h2); const bf16 h3 = f2bf(r2);
            cb[2 * k] = (unsigned)h1 | ((unsigned)h2 << 16); cb[2 * k + 1] = (unsigned)h3; }
        __syncthreads();
    }
#pragma unroll 1
    for (int i = 0; i < 4; ++i) { const int qb = i == 0 ? sf : i == 1 ? 7 - sf : i == 2 ? 8 + sf : 15 - sf;
        att::attn_unit<0, 8>(bh >> 3, bh & 7, qb, QKV, Ob, gates, Cc, SEL, SSQO, shm, wv, i < 3 ? fK : sK, i < 3 ? fV : sV, i > 0); }
#pragma unroll 1
    for (int i = 0; i < 4; ++i) { const int blk = i == 0 ? ss : i == 1 ? 31 - ss : i == 2 ? 32 + ss : 63 - ss;
        att::attn_unit<1, 8>(bk >> 1, bk & 1, blk, QKV, Ob, gates, Cc, SEL, SSQO, shm, wv, i < 3 ? sK : nullptr, i < 3 ? sV : nullptr, true); }
}

__device__ __forceinline__ void ph_win_queue(const P& p, LAS unsigned char* lds, const int wv) {
    unsigned* qctr = (unsigned*)(p.ws + WS_CTL) + 8192;
    volatile LAS unsigned* qslot = (volatile LAS unsigned*)(lds + LDS_BYTES - 128);
    const bool leader = opaque_tid(wv) == 0;
    for (;;) {
        if (leader) *qslot = __hip_atomic_fetch_add(qctr, 1u, __ATOMIC_RELAXED, __HIP_MEMORY_SCOPE_AGENT);
        __syncthreads();
        const unsigned idx = *qslot;
        __syncthreads();
        if (idx >= 1024u) break;
        const int blk = 63 - (int)(idx >> 4), bk = (int)(idx & 15u);
        att::attn_unit<2, 8>(bk >> 1, bk & 1, blk, (const bf16*)(p.ws + WS_BIG), (bf16*)(p.ws + WS_OMIX), (const float*)(p.ws + WS_GATES), (const float*)(p.ws + WS_C), (const unsigned long long*)(p.ws + WS_SEL), (float*)(p.ws + WS_SSQO), (char*)lds, wv, nullptr, nullptr, false);
    }
}

enum { PH_PREP = 0, PH_G1, PH_G2, PH_G3, PH_CMPR, PH_ATTN, PH_G4, PH_G5, PH_G6, PH_G7, PH_N };

__global__ void __launch_bounds__(512, 2) k_main(P p, int ph_lo, int ph_hi) {
    extern __shared__ __attribute__((aligned(16))) unsigned char lds_raw[];
    using namespace pg8;
    cg::grid_group grid = cg::this_grid();
    const int wv = __builtin_amdgcn_readfirstlane((int)(threadIdx.x >> 6));
    LAS unsigned char* lds = (LAS unsigned char*)lds_raw;
    const int G = gridDim.x, c = blockIdx.x;
    volatile LAS unsigned* MISC = (volatile LAS unsigned*)(lds + LDS_BYTES - 64);
    const bool leader = opaque_tid(wv) == 0;
    if (leader) { MISC[0] = 0u; MISC[1] = 0u; }
    __syncthreads();
    XcdBarrier bar = xcd_barrier_post((unsigned*)(p.ws + WS_CTL) + 4096, MISC, leader);
    __syncthreads();
    const int xrank = __builtin_amdgcn_readfirstlane((int)MISC[2]), xcc = (int)bar.x;
    if (ph_lo < 0) grid.sync();
#define IN(k) (ph_lo <= (k) && (k) < ph_hi)
#define SEAM(k) do { if (IN(k) && IN((k) + 1)) xcd_barrier(bar, leader); } while (0)
#define SEAML(k) do { if (IN(k) && IN((k) + 1)) { if (xl_ok) xcd_barrier_local(bar, leader); else xcd_barrier(bar, leader); } } while (0)
#define WSP(T, off) ((T*)(p.ws + (off)))
    if (IN(PH_PREP)) { ph_prep<0>(p, lds, wv, c, G); } SEAM(PH_PREP);
    bool xl_ok = false;
    int cz = c;
    if (G == 256 && IN(PH_PREP)) { const unsigned* xc = (const unsigned*)(p.ws + WS_CTL) + 4096; bool ok = true;
#pragma unroll
        for (int j = 0; j < 8; ++j) ok = ok && (__hip_atomic_load(xc + XB_XCNT(j), __ATOMIC_RELAXED, __HIP_MEMORY_SCOPE_AGENT) == 32u);
        if (ok) { cz = xrank * 8 + xcc; xl_ok = true; } }
    if (IN(PH_G1)) { Gemm g{WSP(bf16, F8_G1 ? WS_O : WS_XN), WSP(const bf16, WS_WGU1), M, 5632, F8_G1 ? D / 2 : D}; StaticOrder S; S.init(M, 5632, G, cz); EpiSwiglu<false, F8_G2> E{WSP(bf16, WS_BIG), nullptr, nullptr};
        gemm_phase<EpiSwiglu<false, F8_G2>, StaticOrder, true, true, F8_G1>(lds, g, S, E, wv); } SEAML(PH_G1);
    if (IN(PH_G2)) { Gemm g{WSP(bf16, WS_BIG), WSP(const bf16, WS_WD1), M, D, F8_G2 ? DFF / 2 : DFF, 128, HS * 2, 0}; StaticOrder S; S.init(M, D, G, cz, 1); EpiResid<true> E{p.in[0], WSP(bf16, WS_XN), WSP(float, WS_SSQ1), 0.5f};
        gemm_phase<EpiResid<true>, StaticOrder, true, true, F8_G2>(lds, g, S, E, wv); } SEAML(PH_G2);
    if (IN(PH_G3)) { Gemm g{WSP(bf16, WS_XN), WSP(const bf16, WS_WIN), M, 3072, D}; StaticOrder S; S.init(M, 3072, G, cz);
        EpiQKV E{WSP(bf16, WS_BIG), WSP(float, WS_GATES), WSP(float, WS_LOGF), WSP(float, WS_SSQ1), WSP(const float, WS_ROPE), p.in[9], p.in[11], p.in[12], p.in[19], p.in[20], p.in[8]};
        gemm_phase<EpiQKV, StaticOrder, true, true>(lds, g, S, E, wv); } SEAM(PH_G3);
    if (IN(PH_CMPR)) { { Gemm g{WSP(bf16, WS_BIG), WSP(const bf16, WS_WC1), 4096, 512, 2048, 16 * QP * 2, QP * 2, 1}; StaticOrder S; S.init(4096, 512, G, cz);
          float* posb = WSP(float, WS_POSBS) + (size_t)c * 512;
          { if (cz < 32) { const int t_ = opaque_tid(wv);
                const float* pp = WSP(const float, WS_POSBP) + (size_t)(t_ >> 8) * 64 * 256 + (t_ & 255); float s_ = 0.f;
#pragma unroll 8
              for (int q = 0; q < 64; ++q) s_ += pp[q * 256];
              posb[t_] = s_; } __syncthreads(); }
          EpiCompress E{posb, WSP(const bf16, WS_WC2), p.in[10], WSP(bf16, WS_KCMP), WSP(bf16, WS_VCMP)};
          gemm_phase<EpiCompress, StaticOrder, false, true>(lds, g, S, E, wv); }
        ph_cumsum(p, cz, G, wv);
        if (G == 256) { if (cz >= 32 && cz < 248) ph_prep<1>(p, lds, wv, cz - 32, 216); } else ph_prep<1>(p, lds, wv, cz, G);
        __syncthreads();
        ph_win_queue(p, lds, wv); } SEAM(PH_CMPR);
    if (IN(PH_ATTN)) { if (G == 256) ph_attn_fs(p, lds, wv, cz); else { ph_cmpsel2(p, lds, wv); xcd_barrier(bar, leader); ph_attn<0>(p, lds, wv); ph_attn<1>(p, lds, wv); } } SEAML(PH_ATTN);
    if (IN(PH_G4)) { Gemm g{WSP(bf16, WS_OMIX), WSP(const bf16, WS_WOUT), M, D, D}; StaticOrder S; S.init(M, D, G, cz); EpiResidNorm<F8_G5> E{WSP(const bf16, WS_XN), WSP(bf16, WS_O), WSP(float, WS_SSQ2), WSP(const float, WS_SSQO), p.ws + WS_H2F8};
        gemm_phase<EpiResidNorm<F8_G5>, StaticOrder, true, true>(lds, g, S, E, wv); } SEAML(PH_G4);
    if (IN(PH_G5)) { Gemm g{WSP(bf16, F8_G5 ? WS_H2F8 : WS_O), WSP(const bf16, WS_WGU2), M, 5632, F8_G5 ? D / 2 : D}; StaticOrder S; S.init(M, 5632, G, cz, 1); EpiSwiglu<true, F8_G6> E{WSP(bf16, WS_BIG), WSP(float, WS_SSQ2), (LDSF*)(lds + RING_BYTES)};
        { if (opaque_tid(wv) < 8) ((LDSI*)(lds + RING_BYTES) + 1024)[opaque_tid(wv)] = -1; __syncthreads(); }
        gemm_phase<EpiSwiglu<true, F8_G6>, StaticOrder, true, true, F8_G5>(lds, g, S, E, wv); } SEAML(PH_G5);
    if (IN(PH_G6)) { Gemm g{WSP(bf16, WS_BIG), WSP(const bf16, WS_WD2), M, D, F8_G6 ? DFF / 2 : DFF, 128, HS * 2, 0}; StaticOrder S; S.init(M, D, G, cz); EpiResid<false> E{WSP(const bf16, WS_O), WSP(bf16, WS_XN), WSP(float, WS_SSQ3), 0.5f};
        gemm_phase<EpiResid<false>, StaticOrder, true, true, F8_G6>(lds, g, S, E, wv);
        { Gemm g2{WSP(const bf16, WS_PB), WSP(const bf16, WS_WPROJ), M, D, DPLE}; StaticOrder S2; S2.init(M, D, G, cz); EpiE E2{WSP(bf16, WS_E), WSP(float, WS_SSQE), p.in[31]};
          gemm_phase<EpiE, StaticOrder, true, true>(lds, g2, S2, E2, wv); } } SEAML(PH_G6);
    if (IN(PH_G7)) { Gemm g{WSP(bf16, WS_XN), WSP(const bf16, WS_WGATE), M, D, D}; StaticOrder S; S.init(M, D, G, cz, 1); EpiPle E{p.out, WSP(const bf16, WS_XN), WSP(const bf16, WS_E), WSP(float, WS_SSQ3), WSP(float, WS_SSQE)};
        gemm_phase<EpiPle, StaticOrder, true, true>(lds, g, S, E, wv); }
#undef IN
#undef SEAML
#undef SEAM
#undef WSP
}

#ifndef ONE_LAUNCH
#define ONE_LAUNCH 1
#endif
extern "C" void kernel_launch(void* const* d_in, const int* in_sizes, int n_in, void* d_out, int out_size, void* d_ws, size_t ws_size, hipStream_t stream) {
    static int grid = 0;
    if (grid == 0) {
        if (n_in != 32 || out_size != M * D || ws_size < WS_END) { fprintf(stderr, "kernel_launch: unexpected sizes n_in %d out %d ws %zu\n", n_in, out_size, ws_size); grid = -1; return; }
        int dev = 0, cus = 0, per_cu = 0;
        (void)hipGetDevice(&dev); (void)hipDeviceGetAttribute(&cus, hipDeviceAttributeMultiprocessorCount, dev);
        if (hipFuncSetAttribute((const void*)k_main, hipFuncAttributeMaxDynamicSharedMemorySize, LDS_BYTES) != hipSuccess) { fprintf(stderr, "hipFuncSetAttribute failed\n"); grid = -1; return; }
        if (hipOccupancyMaxActiveBlocksPerMultiprocessor(&per_cu, (const void*)k_main, 512, LDS_BYTES) != hipSuccess || per_cu < 1) { fprintf(stderr, "occupancy query: %d blocks per CU\n", per_cu); }
        (void)hipGetLastError();
        grid = cus;
    }
    if (grid < 0) return;
    P p{};
    for (int i = 0; i < 32; ++i) p.in[i] = (const float*)d_in[i];
    p.out = (float*)d_out; p.ws = (unsigned char*)d_ws;
    { const double rc[12] = {1.0, 0.19392274474868576, 0.03760603093086393, 0.007292664737217109, 0.001414213562373095, 0.0002742481756762073, 5.318295896944988e-05, 1.031338537721246e-05,
                             0.6366197723675814, 1.5707963267948966, 6.123233995736766e-17, 0.0};
      for (int i = 0; i < 12; ++i) p.rc[i] = rc[i]; }
    (void)hipMemsetAsync((char*)d_ws + WS_CTL, 0, 64 * 1024, stream);
#if ONE_LAUNCH
    int lo = 0, hi = PH_N;
    void* args[] = {&p, &lo, &hi};
    hipError_t e = hipLaunchCooperativeKernel((const void*)k_main, dim3(grid), dim3(512), args, LDS_BYTES, stream);
    if (e != hipSuccess) fprintf(stderr, "cooperative launch failed: %s (grid %d)\n", hipGetErrorString(e), grid);
#else
    for (int ph = 0; ph < PH_N; ++ph) hipLaunchKernelGGL(k_main, dim3(grid), dim3(512), LDS_BYTES, stream, p, ph, ph + 1);
#endif
}
```

```cpp
#include <hip/hip_runtime.h>
#include <hip/hip_cooperative_groups.h>
#include <cstdint>
#include <cstdio>
namespace cg = cooperative_groups;

typedef unsigned short bf16;
constexpr int BATCH = 8, SEQ = 4096, M = BATCH * SEQ, D = 1024, DFF = 2816, INW = 2848, DPLE = 256;
constexpr int QP = 64;
constexpr int HS = M * 64;
constexpr float EPS = 1e-6f;
constexpr float C2 = 0.125f * 1.4426950408889634f;
constexpr float LOG2E = 1.4426950408889634f;
constexpr int C_QA = 0, C_CK = 8 * HS, C_CV = 10 * HS, C_SK = 12 * HS, C_SV = 14 * HS, C_WK = 16 * HS, C_WV = 18 * HS, C_QF = 20 * HS, C_KF = 28 * HS, C_VF = 36 * HS;

constexpr size_t MiB = 1u << 20;
constexpr size_t WS_CTL = 0;
constexpr size_t WS_WGU1 = 2 * MiB, WS_WD1 = 13 * MiB, WS_WIN = 19 * MiB, WS_WOUT = 25 * MiB, WS_WGU2 = 27 * MiB, WS_WD2 = 38 * MiB, WS_WGATE = 44 * MiB, WS_WPROJ = 46 * MiB;
constexpr size_t WS_WC1 = 47 * MiB, WS_WC2 = 49 * MiB, WS_POSBP = 49 * MiB + 512 * 1024;
constexpr size_t WS_KCMP = 50 * MiB, WS_VCMP = 51 * MiB, WS_C = 52 * MiB, WS_GATES = 53 * MiB, WS_LOGF = 56 * MiB, WS_ROPE = 57 * MiB;
constexpr size_t WS_SSQ1 = 58 * MiB, WS_SSQ2 = 60 * MiB, WS_SSQ3 = 62 * MiB, WS_SSQE = 64 * MiB, WS_SEL = 66 * MiB;
constexpr size_t WS_POSBS = 66 * MiB + 512 * 1024;
constexpr size_t WS_SSQO = 67 * MiB;
constexpr size_t WS_GOUT = 49 * MiB + 768 * 1024;
constexpr size_t WS_PB = 70 * MiB;
constexpr size_t WS_XN = 88 * MiB;
constexpr size_t WS_O = 152 * MiB;
constexpr size_t WS_BIG = 216 * MiB;
constexpr size_t WS_E = 408 * MiB;
constexpr size_t WS_OMIX = WS_E;
constexpr size_t WS_H2F8 = 472 * MiB;
constexpr size_t WS_END = 504 * MiB;
constexpr bool F8_G1 = true, F8_G2 = false, F8_G5 = true, F8_G6 = true, F8_G7 = true;

struct P {
    const float* in[32];
    float* out;
    unsigned char* ws;
    double rc[12];
};

__device__ __forceinline__ int opaque_tid(int wv) { int l; asm volatile("v_mbcnt_lo_u32_b32 %0, -1, 0\n\tv_mbcnt_hi_u32_b32 %0, -1, %0" : "=v"(l)); return (wv << 6) | l; }

__device__ __forceinline__ float bf2f(bf16 v) { return __uint_as_float((unsigned)v << 16); }
__device__ __forceinline__ bf16 f2bf(float f) { unsigned u = __float_as_uint(f); return (bf16)((u + 0x7fffu + ((u >> 16) & 1u)) >> 16); }
__device__ __forceinline__ float wave_sum(float v) {
#pragma unroll
    for (int o = 1; o < 64; o <<= 1) v += __shfl_xor(v, o);
    return v;
}
__device__ __forceinline__ float wave_max(float v) {
#pragma unroll
    for (int o = 1; o < 64; o <<= 1) v = fmaxf(v, __shfl_xor(v, o));
    return v;
}
__device__ __forceinline__ float sigmoidf_(float x) { return 1.f / (1.f + __expf(-x)); }
__device__ __forceinline__ float siluf_(float x) { return x / (1.f + __expf(-x)); }

__device__ __forceinline__ void ph_cumsum(const P& p, int bid, int nb, const int wv) {
    const float* logf_ = (const float*)(p.ws + WS_LOGF);
    float* C = (float*)(p.ws + WS_C);
    const int tid = opaque_tid(wv), lane = tid & 63, w = tid >> 6;
    for (int item = (nb - 1 - bid) * 8 + w; item < BATCH * 8; item += nb * 8) {
        const int b = item >> 3, h = item & 7;
        float carry = 0.f;
        for (int t0 = 0; t0 < SEQ; t0 += 256) {
            float v[4];
#pragma unroll
            for (int u = 0; u < 4; ++u) v[u] = logf_[(size_t)(b * SEQ + t0 + 64 * u + lane) * 8 + h];
#pragma unroll
            for (int u = 0; u < 4; ++u) {
#pragma unroll
                for (int o = 1; o < 64; o <<= 1) { const float x = __shfl_up(v[u], o); if (lane >= o) v[u] += x; }
                v[u] += carry;
                C[(size_t)item * SEQ + t0 + 64 * u + lane] = v[u];
                carry = __shfl(v[u], 63);
            }
        }
    }
}
namespace pg8 {
#define PG8_LAS __attribute__((address_space(3)))
typedef unsigned short bf16_t;
typedef short bf16x8 __attribute__((ext_vector_type(8)));
typedef float f32x4 __attribute__((ext_vector_type(4)));
typedef unsigned u32x4 __attribute__((ext_vector_type(4)));
constexpr int BM = 256, BK = 64, HALF = 128, HTB = HALF * BK * 2  , STAGE_BYTES = 8 * HTB, NXCD = 8, WGM = 8;

__host__ __device__ __forceinline__ int lds_byte(int r, int c) { const int st = (r >> 4) * 2 + (c >> 5), rr = r & 15, cc = c & 31, ob = rr * 64 + cc * 2; return st * 1024 + (ob ^ (((ob >> 9) & 1) << 5)); }
__host__ __device__ __forceinline__ void stage_rc(int b, int& R, int& C) { const int st = b / 1024, sb = b % 1024, swz = sb ^ (((sb >> 9) & 1) << 5); R = (st >> 1) * 16 + swz / 64; C = (st & 1) * 32 + (swz % 64) / 2; }
__host__ __device__ __forceinline__ int perm32(int rho) { const int n = rho >> 4, i = rho & 15; return 8 * (i >> 2) + 4 * n + (i & 3); }

struct Unit { int pm, pn; };
struct Gemm { const bf16_t* A; const bf16_t* Bt; int M, N, K; int rsA = 0, ksA = BK * 2, amode = 0; };
__device__ __forceinline__ const char* a_tile(const Gemm& g, const Unit& u) {
    if (g.amode == 0) return (const char*)g.A + (size_t)u.pm * BM * (g.rsA ? (size_t)g.rsA : (size_t)g.K * 2);
    const int b = u.pm >> 1, kvh = u.pm & 1;
    return (const char*)g.A + ((size_t)((u.pn ? 10 : 8) + kvh) * (32768 * 64) + (size_t)b * 4096 * 64) * 2;
}

struct StaticOrder {
    int nM, nN, nwg, G, c, rev;
    __host__ __device__ void init(int M, int N, int G_, int c_, int rev_ = 0) { nM = M / BM; nN = N / BM; nwg = nM * nN; G = G_; c = c_; rev = rev_; }
    __host__ __device__ bool next(int i, Unit& u) const {
        const long L = (long)i * G + c; if (L >= nwg) return false;
        int wgid = (int)L; { const int q = nwg / NXCD, r = nwg % NXCD, xcd = wgid % NXCD; int off = wgid / NXCD; if (rev && r == 0) off = q - 1 - off; wgid = (xcd < r ? xcd * (q + 1) : r * (q + 1) + (xcd - r) * q) + off; }
        const int nig = WGM * nN, gid = wgid / nig, fm = gid * WGM, gsz = (nM - fm) < WGM ? (nM - fm) : WGM;
        u.pm = fm + ((wgid % nig) % gsz); u.pn = (wgid % nig) / gsz; return true;
    }
    __device__ __forceinline__ void a_ready(const Unit&) const {}
    __device__ __forceinline__ void done(const Unit&) const {}
};

__device__ __forceinline__ unsigned cvt_pk_bf16(float lo, float hi) { unsigned r; asm volatile("v_cvt_pk_bf16_f32 %0, %1, %2" : "=v"(r) : "v"(lo), "v"(hi)); return r; }
__device__ __forceinline__ float hsum4(const f32x4 a) { return (a[0] + a[1]) + (a[2] + a[3]); }
__device__ __forceinline__ float sum_rows4(float x) {
    auto a = __builtin_amdgcn_permlane16_swap(__float_as_uint(x), __float_as_uint(x), false, false); const float s = __uint_as_float(a[0]) + __uint_as_float(a[1]);
    auto b = __builtin_amdgcn_permlane32_swap(__float_as_uint(s), __float_as_uint(s), false, false); return __uint_as_float(b[0]) + __uint_as_float(b[1]); }
__device__ __forceinline__ float xor16(float x, int fq) { auto a = __builtin_amdgcn_permlane16_swap(__float_as_uint(x), __float_as_uint(x), false, false); return __uint_as_float((fq & 1) ? a[0] : a[1]); }
__device__ __forceinline__ float rstd16(const float* ssq, int row, float invn) {
    const f32x4* s = (const f32x4*)(ssq + (size_t)row * 16);
    const float t = (hsum4(s[0]) + hsum4(s[1])) + (hsum4(s[2]) + hsum4(s[3]));
    return __builtin_amdgcn_rsqf(t * invn + 1e-6f);
}
__device__ __forceinline__ f32x4 ssq_part(const float* ssq, int row, int fq) { return *((const f32x4*)(ssq + (size_t)row * 16) + fq); }
__device__ __forceinline__ float rstd_fin(const f32x4 s, float invn) { return __builtin_amdgcn_rsqf(sum_rows4(hsum4(s)) * invn + 1e-6f); }
__device__ __forceinline__ float xor32(float x, int fq) { auto a = __builtin_amdgcn_permlane32_swap(__float_as_uint(x), __float_as_uint(x), false, false); return __uint_as_float((fq & 2) ? a[0] : a[1]); }
__device__ __forceinline__ f32x4 sigmoid4(const f32x4 x) { f32x4 r;
#pragma unroll
    for (int e = 0; e < 4; ++e) r[e] = __builtin_amdgcn_rcpf(1.0f + __builtin_amdgcn_exp2f(-1.4426950408889634f * x[e]));
    return r; }
__device__ __forceinline__ u32x4 pack8(const f32x4 a, const f32x4 b) { u32x4 w; w.x = cvt_pk_bf16(a[0], a[1]); w.y = cvt_pk_bf16(a[2], a[3]); w.z = cvt_pk_bf16(b[0], b[1]); w.w = cvt_pk_bf16(b[2], b[3]); return w; }
__device__ __forceinline__ void unpack8(const u32x4 w, f32x4& a, f32x4& b) {
    a[0] = __uint_as_float(w.x << 16); a[1] = __uint_as_float(w.x & 0xffff0000u); a[2] = __uint_as_float(w.y << 16); a[3] = __uint_as_float(w.y & 0xffff0000u);
    b[0] = __uint_as_float(w.z << 16); b[1] = __uint_as_float(w.z & 0xffff0000u); b[2] = __uint_as_float(w.w << 16); b[3] = __uint_as_float(w.w & 0xffff0000u); }

typedef __attribute__((address_space(3))) float LDSF; typedef __attribute__((address_space(3))) int LDSI; typedef __attribute__((address_space(3))) f32x4 LDSV4;
template <bool HAS_SSQ, bool F8OUT = false> struct EpiSwiglu {
    static constexpr bool PERM = true, AFTER_DRAIN = false, MIDSCALE = false;
    bf16_t* H; const float* ssq; LDSF* cache;
    __device__ __forceinline__ void operator()(const f32x4 (&acc)[2][2][4][2], const Unit& u, int wr, int wc, int fr, int fq) const {
        const int row0 = u.pm * BM + wr * 64 + fr, col0 = u.pn * 128 + wc * 32 + 8 * fq;
        float rr[2][4];
        if (HAS_SSQ) {
            LDSF* cw = cache + (wr * 4 + wc) * 128 + fr * 8; LDSI* tag = (LDSI*)(cache + 1024) + (wr * 4 + wc);
            const int have = __builtin_amdgcn_readfirstlane(*tag);
            if (have == u.pm) {
                const f32x4 c0 = *(const LDSV4*)cw, c1 = *(const LDSV4*)(cw + 4);
#pragma unroll
                for (int m = 0; m < 4; ++m) { rr[0][m] = c0[m]; rr[1][m] = c1[m]; }
            } else { f32x4 sp[2][4];
#pragma unroll
                for (int ai = 0; ai < 2; ++ai)
#pragma unroll
                    for (int m = 0; m < 4; ++m) sp[ai][m] = ssq_part(ssq, row0 + ai * HALF + m * 16, fq);
#pragma unroll
                for (int ai = 0; ai < 2; ++ai)
#pragma unroll
                    for (int m = 0; m < 4; ++m) rr[ai][m] = rstd_fin(sp[ai][m], 1.f / 1024.f);
                if (fq == 0) { *(LDSV4*)cw = (f32x4){rr[0][0], rr[0][1], rr[0][2], rr[0][3]}; *(LDSV4*)(cw + 4) = (f32x4){rr[1][0], rr[1][1], rr[1][2], rr[1][3]}; }
                *tag = u.pm; } }
#pragma unroll
        for (int ai = 0; ai < 2; ++ai)
#pragma unroll
            for (int m = 0; m < 4; ++m) { const int row = row0 + ai * HALF + m * 16;
                const float r = HAS_SSQ ? rr[ai][m] : 1.f, k1 = -1.4426950408889634f * r, r2 = r * r;
                f32x4 o[2];
#pragma unroll
                for (int n = 0; n < 2; ++n) {
                    const f32x4 g4 = acc[ai][0][m][n], u4 = acc[ai][1][m][n], x4 = g4 * k1;
                    f32x4 e4;
#pragma unroll
                    for (int e2 = 0; e2 < 4; ++e2) e4[e2] = __builtin_amdgcn_exp2f(x4[e2]);
                    const f32x4 d4 = e4 + 1.0f; f32x4 rc4;
#pragma unroll
                    for (int e2 = 0; e2 < 4; ++e2) rc4[e2] = __builtin_amdgcn_rcpf(d4[e2]);
                    f32x4 t4 = g4 * u4; if (HAS_SSQ) t4 = t4 * r2;
                    o[n] = t4 * rc4; }
                if constexpr (F8OUT) { int w0 = __builtin_amdgcn_cvt_pk_fp8_f32(o[0][0], o[0][1], 0, false); w0 = __builtin_amdgcn_cvt_pk_fp8_f32(o[0][2], o[0][3], w0, true);
                    int w1 = __builtin_amdgcn_cvt_pk_fp8_f32(o[1][0], o[1][1], 0, false); w1 = __builtin_amdgcn_cvt_pk_fp8_f32(o[1][2], o[1][3], w1, true);
                    *(unsigned long long*)((unsigned char*)H + (size_t)(col0 >> 7) * (32768 * 128) + (size_t)row * 128 + (col0 & 127)) = (unsigned long long)(unsigned)w0 | ((unsigned long long)(unsigned)w1 << 32); }
                else *(u32x4*)(H + (size_t)(col0 >> 6) * (32768 * 64) + (size_t)row * 64 + (col0 & 63)) = pack8(o[0], o[1]); }
    }
};
template <bool RES_F32, bool F8C = false> struct EpiResid {
    static constexpr bool PERM = true, AFTER_DRAIN = false, MIDSCALE = false;
    const void* res; bf16_t* xb; float* ssq; float alpha;
    __device__ __forceinline__ void operator()(const f32x4 (&acc)[2][2][4][2], const Unit& u, int wr, int wc, int fr, int fq) const {
        const int row0 = u.pm * BM + wr * 64 + fr, col0 = u.pn * BM + wc * 32 + 8 * fq;
        if constexpr (!RES_F32) {
            u32x4 rb[2][2][2];
#define PG8_BLOAD(g, buf) do { _Pragma("unroll") for (int mm = 0; mm < 2; ++mm) _Pragma("unroll") for (int bj = 0; bj < 2; ++bj) \
                rb[buf][mm][bj] = *(const u32x4*)((const bf16_t*)res + (size_t)(row0 + ((g) >> 1) * HALF + (((g) & 1) * 2 + mm) * 16) * 1024 + col0 + bj * HALF); } while (0)
            PG8_BLOAD(0, 0);
#pragma unroll
            for (int g = 0; g < 4; ++g) { const int ai = g >> 1;
                if (g + 1 < 4) PG8_BLOAD(g + 1, (g + 1) & 1);
#pragma unroll
                for (int mm = 0; mm < 2; ++mm) { const int m = (g & 1) * 2 + mm, row = row0 + ai * HALF + m * 16; float ss = 0.f;
#pragma unroll
                    for (int bj = 0; bj < 2; ++bj) { const size_t off = (size_t)row * 1024 + col0 + bj * HALF;
                        f32x4 r0, r1; unpack8(rb[g & 1][mm][bj], r0, r1);
                        const f32x4 o0 = r0 + alpha * acc[ai][bj][m][0], o1 = r1 + alpha * acc[ai][bj][m][1];
                        *(u32x4*)(xb + off) = pack8(o0, o1);
                        if constexpr (F8C) { int w0 = __builtin_amdgcn_cvt_pk_fp8_f32(o0[0], o0[1], 0, false); w0 = __builtin_amdgcn_cvt_pk_fp8_f32(o0[2], o0[3], w0, true);
                            int w1 = __builtin_amdgcn_cvt_pk_fp8_f32(o1[0], o1[1], 0, false); w1 = __builtin_amdgcn_cvt_pk_fp8_f32(o1[2], o1[3], w1, true);
                            *((unsigned long long*)((unsigned char*)xb + ((long)WS_H2F8 - (long)WS_XN) + off)) = (unsigned long long)(unsigned)w0 | ((unsigned long long)(unsigned)w1 << 32); }
                        ss += hsum4(o0 * o0) + hsum4(o1 * o1); }
                    ss = sum_rows4(ss);
                    if (fq == 0) ssq[(size_t)row * 16 + u.pn * 4 + wc] = ss; } }
#undef PG8_BLOAD
        } else {
            f32x4 rf[2][2][2][2];
#define PG8_RLOAD(g, buf) do { _Pragma("unroll") for (int mm = 0; mm < 2; ++mm) _Pragma("unroll") for (int bj = 0; bj < 2; ++bj) { \
                const float* rp_ = (const float*)res + (size_t)(row0 + ((g) >> 1) * HALF + (((g) & 1) * 2 + mm) * 16) * 1024 + col0 + bj * HALF; \
                rf[buf][mm][bj][0] = *(const f32x4*)rp_; rf[buf][mm][bj][1] = *(const f32x4*)(rp_ + 4); } } while (0)
            PG8_RLOAD(0, 0);
#pragma unroll
            for (int g = 0; g < 4; ++g) { const int ai = g >> 1;
                if (g + 1 < 4) PG8_RLOAD(g + 1, (g + 1) & 1);
#pragma unroll
                for (int mm = 0; mm < 2; ++mm) { const int m = (g & 1) * 2 + mm, row = row0 + ai * HALF + m * 16; float ss = 0.f;
#pragma unroll
                    for (int bj = 0; bj < 2; ++bj) { const size_t off = (size_t)row * 1024 + col0 + bj * HALF;
                        const f32x4 o0 = rf[g & 1][mm][bj][0] + alpha * acc[ai][bj][m][0], o1 = rf[g & 1][mm][bj][1] + alpha * acc[ai][bj][m][1];
                        *(u32x4*)(xb + off) = pack8(o0, o1);
                        ss += hsum4(o0 * o0) + hsum4(o1 * o1); }
                    ss = sum_rows4(ss);
                    if (fq == 0) ssq[(size_t)row * 16 + u.pn * 4 + wc] = ss; } }
#undef PG8_RLOAD
        }
    }
};
template <bool F8C = false> struct EpiResidNorm {
    static constexpr bool PERM = true, AFTER_DRAIN = false, MIDSCALE = true;
    const bf16_t* res; bf16_t* xb; float* ssq; const float* ssqo; unsigned char* h8;
    __device__ __forceinline__ void rarb_fin(const f32x4 s, int fq, float& ra, float& rb) const {
        const float t = hsum4(s), t2 = t + xor16(t, fq), o2 = xor32(t2, fq);
        const float sa = (fq & 2) ? o2 : t2, sb = (fq & 2) ? t2 : o2;
        ra = __builtin_amdgcn_rsqf(sa * (1.f / 512.f) + 1e-6f); rb = __builtin_amdgcn_rsqf(sb * (1.f / 512.f) + 1e-6f); }
    __device__ __forceinline__ void midscale(f32x4 (&acc)[2][2][4][2], const Unit& u, int wr, int fr, int fq) const {
        const int row0 = u.pm * BM + wr * 64 + fr;
#pragma unroll
        for (int ai = 0; ai < 2; ++ai)
#pragma unroll
          for (int mh = 0; mh < 4; mh += 2) { f32x4 sp[2];
#pragma unroll
            for (int mm = 0; mm < 2; ++mm) sp[mm] = ssq_part(ssqo, row0 + ai * HALF + (mh + mm) * 16, fq);
#pragma unroll
            for (int mm = 0; mm < 2; ++mm) { const int m = mh + mm; float ra, rb; rarb_fin(sp[mm], fq, ra, rb); const float f = ra * __builtin_amdgcn_rcpf(rb);
#pragma unroll
                for (int bj = 0; bj < 2; ++bj)
#pragma unroll
                    for (int n = 0; n < 2; ++n) acc[ai][bj][m][n] = acc[ai][bj][m][n] * f; }
            asm volatile("" ::: "memory"); }
    }
    __device__ __forceinline__ void operator()(const f32x4 (&acc)[2][2][4][2], const Unit& u, int wr, int wc, int fr, int fq) const {
        const int row0 = u.pm * BM + wr * 64 + fr, col0 = u.pn * BM + wc * 32 + 8 * fq;
        u32x4 rbv[2][2][2]; float rbs[2][4];
#define PG8_NLOAD(g, buf) do { _Pragma("unroll") for (int mm = 0; mm < 2; ++mm) _Pragma("unroll") for (int bj = 0; bj < 2; ++bj) \
            rbv[buf][mm][bj] = *(const u32x4*)(res + (size_t)(row0 + ((g) >> 1) * HALF + (((g) & 1) * 2 + mm) * 16) * 1024 + col0 + bj * HALF); } while (0)
        { f32x4 sp[2][4];
#pragma unroll
          for (int ai = 0; ai < 2; ++ai)
#pragma unroll
              for (int m = 0; m < 4; ++m) sp[ai][m] = ssq_part(ssqo, row0 + ai * HALF + m * 16, fq);
          PG8_NLOAD(0, 0);
#pragma unroll
          for (int ai = 0; ai < 2; ++ai)
#pragma unroll
              for (int m = 0; m < 4; ++m) { float ra; rarb_fin(sp[ai][m], fq, ra, rbs[ai][m]); } }
#pragma unroll
        for (int g = 0; g < 4; ++g) { const int ai = g >> 1;
            if (g + 1 < 4) PG8_NLOAD(g + 1, (g + 1) & 1);
#pragma unroll
            for (int mm = 0; mm < 2; ++mm) { const int m = (g & 1) * 2 + mm, row = row0 + ai * HALF + m * 16; float ss = 0.f;
#pragma unroll
                for (int bj = 0; bj < 2; ++bj) { const size_t off = (size_t)row * 1024 + col0 + bj * HALF;
                    f32x4 r0, r1; unpack8(rbv[g & 1][mm][bj], r0, r1);
                    const f32x4 o0 = r0 + rbs[ai][m] * acc[ai][bj][m][0], o1 = r1 + rbs[ai][m] * acc[ai][bj][m][1];
                    *(u32x4*)(xb + off) = pack8(o0, o1);
                    if constexpr (F8C) { int w0 = __builtin_amdgcn_cvt_pk_fp8_f32(o0[0], o0[1], 0, false); w0 = __builtin_amdgcn_cvt_pk_fp8_f32(o0[2], o0[3], w0, true);
                        int w1 = __builtin_amdgcn_cvt_pk_fp8_f32(o1[0], o1[1], 0, false); w1 = __builtin_amdgcn_cvt_pk_fp8_f32(o1[2], o1[3], w1, true);
                        *(unsigned long long*)(h8 + off) = (unsigned long long)(unsigned)w0 | ((unsigned long long)(unsigned)w1 << 32); }
                    ss += hsum4(o0 * o0) + hsum4(o1 * o1); }
                ss = sum_rows4(ss);
                if (fq == 0) ssq[(size_t)row * 16 + u.pn * 4 + wc] = ss; } }
#undef PG8_NLOAD
    }
};
struct EpiE {
    static constexpr bool PERM = true, AFTER_DRAIN = false, MIDSCALE = false;
    bf16_t* E; float* ssq; const float* ge;
    __device__ __forceinline__ void operator()(const f32x4 (&acc)[2][2][4][2], const Unit& u, int wr, int wc, int fr, int fq) const {
        const int row0 = u.pm * BM + wr * 64 + fr, col0 = u.pn * BM + wc * 32 + 8 * fq;
        f32x4 gv[2][2];
#pragma unroll
        for (int bj = 0; bj < 2; ++bj) { gv[bj][0] = *(const f32x4*)(ge + col0 + bj * HALF); gv[bj][1] = *(const f32x4*)(ge + col0 + bj * HALF + 4); }
#pragma unroll
        for (int ai = 0; ai < 2; ++ai)
#pragma unroll
            for (int m = 0; m < 4; ++m) { const int row = row0 + ai * HALF + m * 16; float ss = 0.f;
#pragma unroll
                for (int bj = 0; bj < 2; ++bj) { const size_t off = (size_t)row * 1024 + col0 + bj * HALF; const f32x4 o0 = acc[ai][bj][m][0], o1 = acc[ai][bj][m][1];
                    *(u32x4*)(E + off) = pack8(o0 * gv[bj][0], o1 * gv[bj][1]); ss += hsum4(o0 * o0) + hsum4(o1 * o1); }
                ss = sum_rows4(ss);
                if (fq == 0) ssq[(size_t)row * 16 + u.pn * 4 + wc] = ss; }
    }
};
struct EpiPle {
    static constexpr bool PERM = true, AFTER_DRAIN = false, MIDSCALE = false;
    float* out; const bf16_t* hb; const bf16_t* E; const float* ssq3; const float* ssqe;
    __device__ __forceinline__ void operator()(const f32x4 (&acc)[2][2][4][2], const Unit& u, int wr, int wc, int fr, int fq) const {
        const int row0 = u.pm * BM + wr * 64 + fr, col0 = u.pn * BM + wc * 32 + 8 * fq;
        float r3[2][4], re[2][4];
        { f32x4 s3[2][4], se[2][4];
#pragma unroll
          for (int ai = 0; ai < 2; ++ai)
#pragma unroll
              for (int m = 0; m < 4; ++m) { s3[ai][m] = ssq_part(ssq3, row0 + ai * HALF + m * 16, fq); se[ai][m] = ssq_part(ssqe, row0 + ai * HALF + m * 16, fq); }
#pragma unroll
          for (int ai = 0; ai < 2; ++ai)
#pragma unroll
              for (int m = 0; m < 4; ++m) { r3[ai][m] = rstd_fin(s3[ai][m], 1.f / 1024.f); re[ai][m] = rstd_fin(se[ai][m], 1.f / 1024.f); } }
        u32x4 eb[2][2][2], hh[2][2][2];
#define PG8_PLOAD(g, buf) do { _Pragma("unroll") for (int mm = 0; mm < 2; ++mm) _Pragma("unroll") for (int bj = 0; bj < 2; ++bj) { \
            const size_t off_ = (size_t)(row0 + ((g) >> 1) * HALF + (((g) & 1) * 2 + mm) * 16) * 1024 + col0 + bj * HALF; \
            eb[buf][mm][bj] = *(const u32x4*)(E + off_); hh[buf][mm][bj] = *(const u32x4*)(hb + off_); } } while (0)
        PG8_PLOAD(0, 0);
#pragma unroll
        for (int g = 0; g < 4; ++g) { const int ai = g >> 1;
            if (g + 1 < 4) PG8_PLOAD(g + 1, (g + 1) & 1);
#pragma unroll
            for (int mm = 0; mm < 2; ++mm) { const int m = (g & 1) * 2 + mm, row = row0 + ai * HALF + m * 16;
#pragma unroll
                for (int bj = 0; bj < 2; ++bj) { const size_t off = (size_t)row * 1024 + col0 + bj * HALF;
                    f32x4 e0, e1, h0, h1; unpack8(eb[g & 1][mm][bj], e0, e1); unpack8(hh[g & 1][mm][bj], h0, h1);
                    const f32x4 o0 = h0 + sigmoid4(acc[ai][bj][m][0] * r3[ai][m]) * (e0 * re[ai][m]);
                    const f32x4 o1 = h1 + sigmoid4(acc[ai][bj][m][1] * r3[ai][m]) * (e1 * re[ai][m]);
                    __builtin_nontemporal_store(o0, (f32x4*)(out + off)); __builtin_nontemporal_store(o1, (f32x4*)(out + off + 4)); } } }
#undef PG8_PLOAD
    }
};
struct EpiQKV {
    static constexpr bool PERM = true, AFTER_DRAIN = false, MIDSCALE = false;
    bf16_t* QKV; float* gates; float* logf; const float* ssq1; const float* rope; const float* gq_nsa; const float* gk_slc; const float* gk_win; const float* gq_fox; const float* gk_fox; const float* bforget;
    __device__ __forceinline__ void operator()(const f32x4 (&acc)[2][2][4][2], const Unit& u, int wr, int wc, int fr, int fq) const {
        const int row0 = u.pm * BM + wr * 64 + fr;
        if (u.pn == 11) {
            if (wc != 0) return;
            f32x4 bf0 = *(const f32x4*)(bforget), bf1 = *(const f32x4*)(bforget + 4);
            float rq[2][4];
            { f32x4 sp[2][4];
#pragma unroll
              for (int ai = 0; ai < 2; ++ai)
#pragma unroll
                  for (int m = 0; m < 4; ++m) sp[ai][m] = ssq_part(ssq1, row0 + ai * HALF + m * 16, fq);
#pragma unroll
              for (int ai = 0; ai < 2; ++ai)
#pragma unroll
                  for (int m = 0; m < 4; ++m) rq[ai][m] = rstd_fin(sp[ai][m], 1.f / 1024.f); }
#pragma unroll
            for (int ai = 0; ai < 2; ++ai)
#pragma unroll
                for (int m = 0; m < 4; ++m) { const int row = row0 + ai * HALF + m * 16; const float r1 = rq[ai][m];
                    const f32x4 v0 = acc[ai][0][m][0] * r1, v1 = acc[ai][0][m][1] * r1;
                    if (fq < 3) { *(f32x4*)(gates + (size_t)row * 24 + 8 * fq) = sigmoid4(v0); *(f32x4*)(gates + (size_t)row * 24 + 8 * fq + 4) = sigmoid4(v1); }
                    else { f32x4 x0 = v0 + bf0, x1 = v1 + bf1, l0, l1;
#pragma unroll
                        for (int e = 0; e < 4; ++e) { l0[e] = fminf(x0[e], 0.f) - __logf(1.0f + __expf(-fabsf(x0[e]))); l1[e] = fminf(x1[e], 0.f) - __logf(1.0f + __expf(-fabsf(x1[e]))); }
                        *(f32x4*)(logf + (size_t)row * 8) = l0; *(f32x4*)(logf + (size_t)row * 8 + 4) = l1; } }
            return;
        }
        const int c0 = u.pn * 256 + wc * 64;
        const float* gain = nullptr; bool dorope = false; float scale = 1.f;
        if (c0 < 512) { gain = gq_nsa; dorope = true; scale = 0.125f * 1.4426950408889634f; }
        else if (c0 < 640) { dorope = true; }
        else if (c0 < 768) {}
        else if (c0 < 896) { gain = gk_slc; dorope = true; }
        else if (c0 < 1024) {}
        else if (c0 < 1152) { gain = gk_win; dorope = true; }
        else if (c0 < 1280) {}
        else if (c0 < 1792) { gain = gq_fox; scale = 0.125f * 1.4426950408889634f; }
        else if (c0 < 2304) { gain = gk_fox; }
        f32x4 gv[2][2];
#pragma unroll
        for (int bj = 0; bj < 2; ++bj)
#pragma unroll
            for (int n = 0; n < 2; ++n) gv[bj][n] = (gain ? *(const f32x4*)(gain + 32 * bj + 8 * fq + 4 * n) : (f32x4){1.f, 1.f, 1.f, 1.f}) * scale;
        float rq[2][4];
        { f32x4 sp[2][4];
#pragma unroll
          for (int ai = 0; ai < 2; ++ai)
#pragma unroll
              for (int m = 0; m < 4; ++m) sp[ai][m] = ssq_part(ssq1, row0 + ai * HALF + m * 16, fq);
#pragma unroll
          for (int ai = 0; ai < 2; ++ai)
#pragma unroll
              for (int m = 0; m < 4; ++m) rq[ai][m] = rstd_fin(sp[ai][m], 1.f / 1024.f); }
#pragma unroll
        for (int ai = 0; ai < 2; ++ai) {
#pragma unroll
            for (int m = 0; m < 4; ++m) { const int row = row0 + ai * HALF + m * 16, t = row & 4095; const float r1 = rq[ai][m];
                float rs = r1;
                if (gain) { float ss = (hsum4(acc[ai][0][m][0] * acc[ai][0][m][0]) + hsum4(acc[ai][0][m][1] * acc[ai][0][m][1])) + (hsum4(acc[ai][1][m][0] * acc[ai][1][m][0]) + hsum4(acc[ai][1][m][1] * acc[ai][1][m][1]));
                    ss = sum_rows4(ss);
                    rs = r1 * __builtin_amdgcn_rsqf(ss * (r1 * r1) * (1.f / 64.f) + 1e-6f); }
                f32x4 v[2][2];
#pragma unroll
                for (int bj = 0; bj < 2; ++bj)
#pragma unroll
                    for (int n = 0; n < 2; ++n) v[bj][n] = acc[ai][bj][m][n] * (gv[bj][n] * rs);
                if (dorope) { f32x4 p0, p1;
#pragma unroll
                    for (int e = 0; e < 4; ++e) { p0[e] = xor16(v[0][0][e], fq); p1[e] = xor16(v[0][1][e], fq); }
                    if (fq < 2) { const f32x4 cs0 = *(const f32x4*)(rope + t * 16), cs1 = *(const f32x4*)(rope + t * 16 + 4), sn0 = *(const f32x4*)(rope + t * 16 + 8), sn1 = *(const f32x4*)(rope + t * 16 + 12);
                        if (fq == 0) { v[0][0] = v[0][0] * cs0 - p0 * sn0; v[0][1] = v[0][1] * cs1 - p1 * sn1; }
                        else { v[0][0] = v[0][0] * cs0 + p0 * sn0; v[0][1] = v[0][1] * cs1 + p1 * sn1; } } }
#pragma unroll
                for (int bj = 0; bj < 2; ++bj) *(u32x4*)(QKV + (size_t)(c0 >> 6) * (32768 * 64) + (size_t)row * 64 + 32 * bj + 8 * fq) = pack8(v[bj][0], v[bj][1]);
            }
        }
    }
};

struct EpiCompress {
    static constexpr bool PERM = true, AFTER_DRAIN = true, MIDSCALE = false;
    const float* posb; const bf16_t* w2t; const float* gk; bf16_t* KC; bf16_t* VC;
    __device__ __forceinline__ void fused(f32x4 (&acc)[2][2][4][2], const Unit& u, int wr, int wc, int fr, int fq, PG8_LAS unsigned char* lds, int wid, int lane) const {
        typedef float f32x16 __attribute__((ext_vector_type(16))); typedef unsigned u32x2v __attribute__((ext_vector_type(2)));
        const int which = u.pn, bk = u.pm;
        {
            const int col0 = wc * 32 + 8 * fq;
#pragma unroll
            for (int bj = 0; bj < 2; ++bj) { const f32x4 b0 = *(const f32x4*)(posb + which * 256 + col0 + bj * HALF), b1 = *(const f32x4*)(posb + which * 256 + col0 + bj * HALF + 4);
#pragma unroll
                for (int ai = 0; ai < 2; ++ai)
#pragma unroll
                    for (int m = 0; m < 4; ++m) { const int row = ai * HALF + wr * 64 + m * 16 + fr; const f32x4 g0 = acc[ai][bj][m][0] + b0, g1 = acc[ai][bj][m][1] + b1;
                        *(PG8_LAS u32x4*)(lds + row * 528 + (col0 + bj * HALF) * 2) = pack8(g0 * sigmoid4(g0), g1 * sigmoid4(g1)); } }
        }
        asm volatile("s_waitcnt lgkmcnt(0)" ::: "memory"); __builtin_amdgcn_s_barrier(); asm volatile("" ::: "memory");
        const int r32 = lane & 31, hi = lane >> 5, n = wid * 32 + r32;
        f32x16 o[2]; o[0] = f32x16{}; o[1] = f32x16{};
        { const PG8_LAS unsigned char* hp = lds + n * 528 + hi * 16; const bf16_t* wp = w2t + (size_t)(which * 64 + r32) * 256 + hi * 8;
#pragma unroll 4
          for (int ks = 0; ks < 16; ++ks) { const bf16x8 bfr = *(const PG8_LAS bf16x8*)(hp + ks * 32);
              const bf16x8 a0 = *(const bf16x8*)(wp + ks * 16), a1 = *(const bf16x8*)(wp + 32 * 256 + ks * 16);
              o[0] = __builtin_amdgcn_mfma_f32_32x32x16_bf16(a0, bfr, o[0], 0, 0, 0); o[1] = __builtin_amdgcn_mfma_f32_32x32x16_bf16(a1, bfr, o[1], 0, 0, 0); } }
        if (which == 0) {
            float ss = 0.f;
#pragma unroll
            for (int dt = 0; dt < 2; ++dt)
#pragma unroll
                for (int r = 0; r < 16; ++r) ss += o[dt][r] * o[dt][r];
            { auto rr = __builtin_amdgcn_permlane32_swap(__float_as_uint(ss), __float_as_uint(ss), false, false); ss = __uint_as_float(rr[0]) + __uint_as_float(rr[1]); }
            const float rn = __builtin_amdgcn_rsqf(ss * (1.f / 64.f) + 1e-6f);
#pragma unroll
            for (int dt = 0; dt < 2; ++dt)
#pragma unroll
                for (int k = 0; k < 4; ++k) { const f32x4 gv = *(const f32x4*)(gk + 32 * dt + 8 * k + 4 * hi);
#pragma unroll
                    for (int e2 = 0; e2 < 4; ++e2) o[dt][4 * k + e2] = o[dt][4 * k + e2] * rn * gv[e2]; }
        }
        bf16_t* outp = (which ? VC : KC) + ((size_t)bk * 256 + n) * 64 + 4 * hi;
        const bool live = n < 255;
#pragma unroll
        for (int dt = 0; dt < 2; ++dt)
#pragma unroll
            for (int k = 0; k < 4; ++k) { u32x2v w; w.x = cvt_pk_bf16(o[dt][4 * k], o[dt][4 * k + 1]); w.y = cvt_pk_bf16(o[dt][4 * k + 2], o[dt][4 * k + 3]);
                if (!live) { w.x = 0u; w.y = 0u; }
                *(u32x2v*)(outp + 32 * dt + 8 * k) = w; }
    }
};
typedef int v4i_t __attribute__((ext_vector_type(4))); typedef int v8i_t __attribute__((ext_vector_type(8)));
template <class Epi, class Sched, bool ALIGN_EPI = false, bool SP2 = false, bool MX8 = false>
__device__ __forceinline__ void gemm_phase(PG8_LAS unsigned char* lds, const Gemm g, const Sched& S, const Epi& E, const int wv) {
    const int tid = opaque_tid(wv), wid = wv, lane = tid & 63, wr = wid >> 2, wc = wid & 3, fr = lane & 15, fq = lane >> 4;
    const int K = g.K, nt = K / BK;
    unsigned voffA[2], voffB[2];
#pragma unroll
    for (int i = 0; i < 2; ++i) { int R, C; stage_rc(tid * 16 + i * 8192, R, C); const int Rb = Epi::PERM ? ((R & ~31) + perm32(R & 31)) : R;
        voffA[i] = (unsigned)(R * (g.rsA ? g.rsA : K * 2) + C * 2); voffB[i] = (unsigned)(Rb * K + C) * 2u; }
    const size_t kstep = (size_t)(BK * 2);
    const size_t hstep = (size_t)HALF * K * 2;
    const size_t tstep = 2 * hstep;
    const size_t rsA = g.rsA ? (size_t)g.rsA : (size_t)K * 2, kstepA = (size_t)g.ksA, hstepA = (size_t)HALF * rsA;
    const unsigned ldsw = (unsigned)wid * 1024u;
    const int aoff = lds_byte(wr * 64 + fr, fq * 8), boff = lds_byte(wc * 32 + fr, fq * 8);
#define PG8_SA(b, h) (((b) * 2 + (h)) * HTB)
#define PG8_SB(b, h) ((4 + (b) * 2 + (h)) * HTB)
#define PG8_STAGE(bufoff, gbase, voff) do { _Pragma("unroll") for (int _i = 0; _i < 2; ++_i) { unsigned vo_ = (voff)[_i]; if constexpr (MX8) asm volatile("" : "+v"(vo_));     \
        __builtin_amdgcn_global_load_lds((const unsigned*)((const char*)(gbase) + vo_), (PG8_LAS unsigned*)(lds + (bufoff) + ldsw + _i * 8192), 16, 0, 0); } } while (0)
#define PG8_LDA(dst, b, h) do { _Pragma("unroll") for (int m = 0; m < 4; ++m) { if constexpr (MX8) { const v4i_t lo_ = *(const PG8_LAS v4i_t*)(lds + PG8_SA(b, h) + aoff + m * 2048), hi_ = *(const PG8_LAS v4i_t*)(lds + PG8_SA(b, h) + aoff + m * 2048 + 1024); dst##8[m] = __builtin_shufflevector(lo_, hi_, 0, 1, 2, 3, 4, 5, 6, 7); } \
        else { _Pragma("unroll") for (int k = 0; k < 2; ++k) dst[m][k] = *(const PG8_LAS bf16x8*)(lds + PG8_SA(b, h) + aoff + m * 2048 + k * 1024); } } } while (0)
#define PG8_LDB(dst, b, h) do { _Pragma("unroll") for (int n = 0; n < 2; ++n) { if constexpr (MX8) { const v4i_t lo_ = *(const PG8_LAS v4i_t*)(lds + PG8_SB(b, h) + boff + n * 2048), hi_ = *(const PG8_LAS v4i_t*)(lds + PG8_SB(b, h) + boff + n * 2048 + 1024); dst##8[n] = __builtin_shufflevector(lo_, hi_, 0, 1, 2, 3, 4, 5, 6, 7); } \
        else { _Pragma("unroll") for (int k = 0; k < 2; ++k) dst[n][k] = *(const PG8_LAS bf16x8*)(lds + PG8_SB(b, h) + boff + n * 2048 + k * 1024); } } } while (0)
#define PG8_MMA(ai, bj, At, Bt) do { if constexpr (MX8) __builtin_amdgcn_sched_barrier(0); __builtin_amdgcn_s_setprio(1); _Pragma("unroll") for (int m = 0; m < 4; ++m) _Pragma("unroll") for (int n = 0; n < 2; ++n) { \
        if constexpr (MX8) acc[ai][bj][m][n] = __builtin_amdgcn_mfma_scale_f32_16x16x128_f8f6f4(Bt##8[n], At##8[m], acc[ai][bj][m][n], 0, 0, 0, 0x7F7F7F7F, 0, 0x7F7F7F7F); \
        else { _Pragma("unroll") for (int k = 0; k < 2; ++k) acc[ai][bj][m][n] = __builtin_amdgcn_mfma_f32_16x16x32_bf16(Bt[n][k], At[m][k], acc[ai][bj][m][n], 0, 0, 0); } } \
        __builtin_amdgcn_s_setprio(0); if constexpr (MX8) __builtin_amdgcn_sched_barrier(0); } while (0)
#define PG8_WAIT_V(n) asm volatile("s_waitcnt vmcnt(" #n ")" ::: "memory")
#define PG8_WAIT_L(n) asm volatile("s_waitcnt lgkmcnt(" #n ")" ::: "memory")
#define PG8_BAR __builtin_amdgcn_s_barrier()
#define PG8_SCHED __builtin_amdgcn_sched_barrier(0)
    Unit cur, nxt; int ui = 0;
    if (!S.next(0, cur)) return;
    f32x4 acc[2][2][4][2];
#pragma unroll
    for (int a = 0; a < 2; ++a)
#pragma unroll
        for (int b = 0; b < 2; ++b)
#pragma unroll
            for (int m = 0; m < 4; ++m)
#pragma unroll
                for (int n = 0; n < 2; ++n) acc[a][b][m][n] = (f32x4){0.f, 0.f, 0.f, 0.f};
    bf16x8 At[4][2], B0[2][2], B1[2][2]; v8i_t At8[4], B08[2], B18[2];
    const char* cA = a_tile(g, cur); const char* cB = (const char*)g.Bt + (size_t)cur.pn * tstep;
    S.a_ready(cur);
    if constexpr (SP2) {
        PG8_STAGE(PG8_SB(0, 0), cB, voffB); PG8_STAGE(PG8_SB(0, 1), cB + hstep, voffB); PG8_STAGE(PG8_SA(0, 0), cA, voffA); PG8_STAGE(PG8_SA(0, 1), cA + hstepA, voffA);
        if (wr == 1) PG8_BAR;
        PG8_WAIT_V(2); PG8_BAR;
        PG8_STAGE(PG8_SB(1, 0), cB + kstep, voffB); PG8_STAGE(PG8_SA(1, 0), cA + kstepA, voffA); PG8_STAGE(PG8_SB(1, 1), cB + hstep + kstep, voffB);
        PG8_WAIT_V(6); PG8_BAR;
    } else {
        PG8_STAGE(PG8_SB(0, 0), cB, voffB); PG8_STAGE(PG8_SA(0, 0), cA, voffA); PG8_STAGE(PG8_SB(0, 1), cB + hstep, voffB); PG8_STAGE(PG8_SA(0, 1), cA + hstepA, voffA);
        if (wr == 1) PG8_BAR;
        PG8_WAIT_V(4); PG8_BAR;
        PG8_STAGE(PG8_SB(1, 0), cB + kstep, voffB); PG8_STAGE(PG8_SA(1, 0), cA + kstepA, voffA); PG8_STAGE(PG8_SB(1, 1), cB + hstep + kstep, voffB);
        PG8_WAIT_V(6); PG8_BAR;
    }
    for (;;) {
        const bool has_next = S.next(ui + 1, nxt);
        const char* nA = has_next ? a_tile(g, nxt) : cA; const char* nB = has_next ? (const char*)g.Bt + (size_t)nxt.pn * tstep : cB;
#pragma unroll 1
        for (int t = 0; t < nt; t += 2) {
            if constexpr (Epi::MIDSCALE) { if (t == 8) { const int l4_ = opaque_tid(wv) & 63; E.midscale(acc, cur, wr, l4_ & 15, l4_ >> 4); } }
            const bool last = (t == nt - 2);
            const char* a1 = cA + (size_t)(t + 1) * kstepA;
            const char* a2 = last ? nA : cA + (size_t)(t + 2) * kstepA; const char* b2 = last ? nB : cB + (size_t)(t + 2) * kstep;
            const char* a3 = a2 + kstepA; const char* b3 = b2 + kstep;
            if (last && has_next) S.a_ready(nxt);
            if constexpr (SP2) {
            PG8_LDB(B0, 0, 0); PG8_LDB(B1, 0, 1); PG8_SCHED; PG8_LDA(At, 0, 0); PG8_STAGE(PG8_SA(1, 1), a1 + hstepA, voffA);
            PG8_WAIT_V(8); PG8_WAIT_L(0); PG8_BAR; PG8_MMA(0, 0, At, B0); PG8_MMA(0, 1, At, B1); PG8_BAR; PG8_SCHED;
            PG8_LDA(At, 0, 1); PG8_STAGE(PG8_SB(0, 0), b2, voffB); PG8_STAGE(PG8_SB(0, 1), b2 + hstep, voffB); PG8_STAGE(PG8_SA(0, 0), a2, voffA);
            PG8_WAIT_V(8); PG8_WAIT_L(0); PG8_BAR; PG8_MMA(1, 0, At, B0); PG8_MMA(1, 1, At, B1); PG8_BAR; PG8_SCHED;
            PG8_LDB(B0, 1, 0); PG8_LDB(B1, 1, 1); PG8_SCHED; PG8_LDA(At, 1, 0); PG8_STAGE(PG8_SA(0, 1), a2 + hstepA, voffA);
            PG8_WAIT_V(8); PG8_WAIT_L(0); PG8_BAR; PG8_MMA(0, 0, At, B0); PG8_MMA(0, 1, At, B1); PG8_BAR; PG8_SCHED;
            PG8_LDA(At, 1, 1); PG8_STAGE(PG8_SB(1, 0), b3, voffB); PG8_STAGE(PG8_SB(1, 1), b3 + hstep, voffB); PG8_STAGE(PG8_SA(1, 0), a3, voffA);
            PG8_WAIT_V(8); PG8_WAIT_L(0); PG8_BAR; PG8_MMA(1, 0, At, B0); PG8_MMA(1, 1, At, B1); PG8_BAR; PG8_SCHED;
            } else {
            PG8_LDB(B0, 0, 0); PG8_SCHED; PG8_LDA(At, 0, 0); PG8_STAGE(PG8_SA(1, 1), a1 + hstepA, voffA);
            PG8_WAIT_L(8); PG8_BAR; PG8_WAIT_L(0); PG8_MMA(0, 0, At, B0); PG8_BAR; PG8_SCHED;
            PG8_LDB(B1, 0, 1); PG8_STAGE(PG8_SB(0, 0), b2, voffB);
            PG8_BAR; PG8_WAIT_L(0); PG8_MMA(0, 1, At, B1); PG8_BAR;
            PG8_LDA(At, 0, 1); PG8_STAGE(PG8_SA(0, 0), a2, voffA);
            PG8_BAR; PG8_WAIT_L(0); PG8_MMA(1, 0, At, B0); PG8_BAR; PG8_SCHED;
            PG8_STAGE(PG8_SB(0, 1), b2 + hstep, voffB);
            PG8_WAIT_V(6); PG8_BAR; PG8_MMA(1, 1, At, B1); PG8_BAR;
            PG8_LDB(B0, 1, 0); PG8_SCHED; PG8_LDA(At, 1, 0); PG8_STAGE(PG8_SA(0, 1), a2 + hstepA, voffA);
            PG8_WAIT_L(8); PG8_BAR; PG8_WAIT_L(0); PG8_MMA(0, 0, At, B0); PG8_BAR; PG8_SCHED;
            PG8_LDB(B1, 1, 1); PG8_STAGE(PG8_SB(1, 0), b3, voffB);
            PG8_BAR; PG8_WAIT_L(0); PG8_MMA(0, 1, At, B1); PG8_BAR;
            PG8_LDA(At, 1, 1); PG8_STAGE(PG8_SA(1, 0), a3, voffA);
            PG8_BAR; PG8_WAIT_L(0); PG8_MMA(1, 0, At, B0); PG8_BAR; PG8_SCHED;
            PG8_STAGE(PG8_SB(1, 1), b3 + hstep, voffB);
            PG8_WAIT_V(6); PG8_BAR; PG8_MMA(1, 1, At, B1); PG8_BAR;
            }
        }
        if constexpr (ALIGN_EPI) { if (wr == 0) PG8_BAR; }
        if constexpr (!Epi::AFTER_DRAIN) { const int l2_ = opaque_tid(wv) & 63; E(acc, cur, wr, wc, l2_ & 15, l2_ >> 4); S.done(cur); }
        if (!has_next) break;
#pragma unroll
        for (int a = 0; a < 2; ++a)
#pragma unroll
            for (int b = 0; b < 2; ++b)
#pragma unroll
                for (int m = 0; m < 4; ++m)
#pragma unroll
                    for (int n = 0; n < 2; ++n) acc[a][b][m][n] = (f32x4){0.f, 0.f, 0.f, 0.f};
        cur = nxt; cA = nA; cB = nB; ++ui;
        if constexpr (ALIGN_EPI) { if (wr == 1) PG8_BAR; }
    }
    PG8_WAIT_V(0);
    if constexpr (!ALIGN_EPI) { if (wr == 0) PG8_BAR; }
    PG8_BAR;
    if constexpr (Epi::AFTER_DRAIN) { const int l3_ = opaque_tid(wv) & 63; E.fused(acc, cur, wr, wc, l3_ & 15, l3_ >> 4, lds, wid, l3_); S.done(cur); }
#undef PG8_SA
#undef PG8_SB
#undef PG8_STAGE
#undef PG8_LDA
#undef PG8_LDB
#undef PG8_MMA
#undef PG8_WAIT_V
#undef PG8_WAIT_L
#undef PG8_BAR
#undef PG8_SCHED
}
}

#include <hip/hip_bf16.h>
namespace att {
using bf16x8=__attribute__((ext_vector_type(8)))short;
using s16x4=__attribute__((ext_vector_type(4)))short;
using f32x16=__attribute__((ext_vector_type(16)))float;
using u32x4=__attribute__((ext_vector_type(4)))unsigned;
using u32x2=__attribute__((ext_vector_type(2)))unsigned;
using bf16x4=__attribute__((ext_vector_type(4)))short;
constexpr int NW=8,QBLK=32,KVBLK=64;
__device__ __forceinline__ int crow(int r,int hi){return (r&3)+8*(r>>2)+4*hi;}
#define SBAR() __builtin_amdgcn_sched_barrier(0)
template<int VAR> __device__ __forceinline__ void amask(f32x16&p0,f32x16&p1,int keybase,int qpos,int lower,int hi){
  const float NEG=-INFINITY; int kb=keybase+4*hi; asm volatile("":"+v"(kb)); asm volatile("":"+v"(qpos)); if(VAR==2) asm volatile("":"+v"(lower));
  #pragma unroll
  for(int r=0;r<16;++r){const int kv=kb+(r&3)+8*(r>>2); bool m0=kv>qpos,m1=kv+32>qpos; if(VAR==2){m0=m0||(kv<lower);m1=m1||(kv+32<lower);} if(m0)p0[r]=NEG; if(m1)p1[r]=NEG;}
}
constexpr int NSLOT=4, SLOTB=8192;
constexpr int LDS_K=0, LDS_V=NSLOT*SLOTB, LDS_WS=2*NSLOT*SLOTB, LDS_OST=LDS_WS+NW*64*4, LDS_CB=LDS_OST+NW*4096, LDS_BYTES_ATT=LDS_CB+32768;
__device__ __forceinline__ void glds16(const void*gsrc,unsigned lds_dst){unsigned keep;
  asm volatile("s_mov_b32 %0, m0\n\ts_mov_b32 m0, %2\n\ts_nop 0\n\tglobal_load_lds_dwordx4 %1, off\n\ts_mov_b32 m0, %0":"=&s"(keep):"v"(gsrc),"s"(lds_dst):"memory");}
__device__ __forceinline__ float max3f(float a,float b,float c){float r;asm("v_max3_f32 %0, %1, %2, %3":"=v"(r):"v"(a),"v"(b),"v"(c));return r;}
__device__ __forceinline__ float max2f(float a,float b){float r;asm("v_max_f32_e32 %0, %1, %2":"=v"(r):"v"(a),"v"(b));return r;}
__device__ __forceinline__ float fadd_s(float a,float b){float r;asm("v_add_f32_e32 %0, %1, %2":"=v"(r):"v"(a),"v"(b));return r;}
__device__ __forceinline__ float fsub_s(float a,float b){float r;asm("v_sub_f32_e32 %0, %1, %2":"=v"(r):"v"(a),"v"(b));return r;}
typedef float f32x2_t __attribute__((ext_vector_type(2))); typedef __bf16 bf16x2_t __attribute__((ext_vector_type(2)));
__device__ __forceinline__ unsigned cvtpk_s(float lo,float hi){f32x2_t v={lo,hi};bf16x2_t b=__builtin_convertvector(v,bf16x2_t);return __builtin_bit_cast(unsigned,b);}
#define WAIT_BAR(N) asm volatile("s_waitcnt vmcnt(" #N ") lgkmcnt(0)\n\ts_barrier":::"memory")
typedef __attribute__((address_space(3))) const char* lds_cptr;
typedef short v4i16_t __attribute__((ext_vector_type(4)));
template<int VAR> __device__ __forceinline__ void qkt(f32x16&p0,f32x16&p1,const char*Kslot,const bf16x8*qr,int r32,int hi,bf16x4 kb0,bf16x4 kb1,bf16x4 qone){
  const f32x16 negm=f32x16{};
  const char*kb=Kslot+hi*1024+r32*16;
  #pragma unroll
  for(int d0=0;d0<4;++d0){
    const bf16x8 b0=*reinterpret_cast<const bf16x8*>(kb+d0*2048);
    const bf16x8 b1=*reinterpret_cast<const bf16x8*>(kb+d0*2048+512);
    if(d0==0){p0=__builtin_amdgcn_mfma_f32_32x32x16_bf16(b0,qr[0],negm,0,0,0);p1=__builtin_amdgcn_mfma_f32_32x32x16_bf16(b1,qr[0],negm,0,0,0);}
    else{p0=__builtin_amdgcn_mfma_f32_32x32x16_bf16(b0,qr[d0],p0,0,0,0);p1=__builtin_amdgcn_mfma_f32_32x32x16_bf16(b1,qr[d0],p1,0,0,0);}}
  if(VAR==0){p0=__builtin_amdgcn_mfma_f32_32x32x8bf16_1k(kb0,qone,p0,0,0,0);p1=__builtin_amdgcn_mfma_f32_32x32x8bf16_1k(kb1,qone,p1,0,0,0);}
}
__device__ __forceinline__ void kload8(bf16x8*kf,lds_cptr kp){
  kf[0]=*(const __attribute__((address_space(3))) bf16x8*)(kp);      kf[1]=*(const __attribute__((address_space(3))) bf16x8*)(kp+512);
  kf[2]=*(const __attribute__((address_space(3))) bf16x8*)(kp+2048); kf[3]=*(const __attribute__((address_space(3))) bf16x8*)(kp+2560);
  kf[4]=*(const __attribute__((address_space(3))) bf16x8*)(kp+4096); kf[5]=*(const __attribute__((address_space(3))) bf16x8*)(kp+4608);
  kf[6]=*(const __attribute__((address_space(3))) bf16x8*)(kp+6144); kf[7]=*(const __attribute__((address_space(3))) bf16x8*)(kp+6656);
}
__device__ __forceinline__ void kload2(bf16x8*kf,lds_cptr kp,int j){ kf[2*j]=*(const __attribute__((address_space(3))) bf16x8*)(kp+j*2048); kf[2*j+1]=*(const __attribute__((address_space(3))) bf16x8*)(kp+j*2048+512); }
__device__ __forceinline__ s16x4 vtr(lds_cptr p){ return __builtin_bit_cast(s16x4,__builtin_amdgcn_ds_read_tr16_b64_v4i16((__attribute__((address_space(3))) v4i16_t*)p)); }
__device__ __forceinline__ float rowmax(const f32x16&p0,const f32x16&p1){
  float a=max3f(p0[0],p0[1],p1[0]),b=max3f(p0[2],p0[3],p1[1]);a=max3f(a,p1[2],p1[3]);
  #pragma unroll
  for(int r=4;r<16;r+=4){a=max3f(a,p0[r],p0[r+1]);b=max3f(b,p0[r+2],p0[r+3]);a=max3f(a,p1[r],p1[r+1]);b=max3f(b,p1[r+2],p1[r+3]);}
  const float m=max2f(a,b);
  auto rr=__builtin_amdgcn_permlane32_swap(__float_as_uint(m),__float_as_uint(m),false,false);
  return max2f(__uint_as_float(rr[0]),__uint_as_float(rr[1]));
}
__device__ __forceinline__ void pv(f32x16*o,int vb,bf16x8 pa0,bf16x8 pa1,bf16x8 pa2,bf16x8 pa3){
  #pragma unroll
  for(int d0=0;d0<2;++d0){s16x4 lo[4],hi[4];
    #pragma unroll
    for(int ks=0;ks<4;++ks){
      asm volatile("ds_read_b64_tr_b16 %0,%1 offset:%c2":"=&v"(lo[ks]):"v"(vb),"i"(d0*4096+ks*1024):"memory");
      asm volatile("ds_read_b64_tr_b16 %0,%1 offset:%c2":"=&v"(hi[ks]):"v"(vb),"i"(d0*4096+ks*1024+512):"memory");}
    asm volatile("s_waitcnt lgkmcnt(0)":::"memory");SBAR();
    #define PK(k) (bf16x8){lo[k][0],lo[k][1],lo[k][2],lo[k][3],hi[k][0],hi[k][1],hi[k][2],hi[k][3]}
    o[d0]=__builtin_amdgcn_mfma_f32_32x32x16_bf16(pa0,PK(0),o[d0],0,0,0);
    o[d0]=__builtin_amdgcn_mfma_f32_32x32x16_bf16(pa1,PK(1),o[d0],0,0,0);
    o[d0]=__builtin_amdgcn_mfma_f32_32x32x16_bf16(pa2,PK(2),o[d0],0,0,0);
    o[d0]=__builtin_amdgcn_mfma_f32_32x32x16_bf16(pa3,PK(3),o[d0],0,0,0);
    #undef PK
  }
}
template<int VAR,int THRL> __device__ __forceinline__ void attn_unit(int b,int hx,int ux,const bf16*QKVb,bf16*Ob,const float*gates,const float*Cc,const unsigned long long*SEL,float*SSQO,char*shm,const int wv,const bf16*nxK,const bf16*nxV,const bool pf){
  int tid_=opaque_tid(wv);
  const int tid=tid_,lane=tid&63,r32=lane&31,hi=lane>>5; const int wid=wv;
  const long rowbase=(long)b*SEQ;
  const int head=(VAR==0)?hx:(hx*4+(wid>>1));
  const int row0=(VAR==0)?(ux*256+wid*32):(ux*64+(wid&1)*32);
  const int qcol=(VAR==0)?(C_QF+hx*HS):(C_QA+head*HS);
  const int kcol=(VAR==0)?(C_KF+hx*HS):(VAR==1)?(C_SK+hx*HS):(C_WK+hx*HS);
  const int vcol=(VAR==0)?(C_VF+hx*HS):(VAR==1)?(C_SV+hx*HS):(C_WV+hx*HS);
  const int NTreal=(VAR==0)?(4*ux+4):(VAR==1)?(ux+1):((ux<8?ux:8)+1);
  const int NT=NTreal<4?4:NTreal;
  const int tdiag=ux;
  #define TNOM(t) ((VAR==2)?(tdiag-(t)):(t))
  #define TACT(t) ((VAR==2)?((tdiag-(t))<0?0:(tdiag-(t))):(t))
  const bf16*Qw=QKVb+(rowbase+row0)*QP+qcol;
  const bf16*Kh=QKVb+rowbase*QP+kcol,*Vh=QKVb+rowbase*QP+vcol;
  const unsigned lds0=(unsigned)(uintptr_t)shm;
  float*wsf=(float*)(shm+LDS_WS)+wid*64;
  const bf16*ksrc=Kh+(long)lane*QP+wid*8;
  const bf16*vsrc=Vh+(long)(16*(wid&3)+(lane>>2))*QP+(wid>>2)*32+(lane&3)*8;
  const unsigned kdst=lds0+LDS_K+wid*1024, vdst=lds0+LDS_V+wid*1024;
  #define DMA_K(t,slot) glds16(ksrc+(long)TACT(t)*KVBLK*QP,(unsigned)__builtin_amdgcn_readfirstlane(kdst+(slot)))
  #define DMA_V(t,slot) glds16(vsrc+(long)TACT(t)*KVBLK*QP,(unsigned)__builtin_amdgcn_readfirstlane(vdst+(slot)))
  const int vb0=(int)(lds0+LDS_V)+((lane>>4)&1)*32+(lane&3)*8+(4*hi+((lane&15)>>2))*64;
  const char*Kbase=shm+LDS_K; bf16x8 kf[8];
  const lds_cptr shm3=(lds_cptr)shm; const lds_cptr kp0=shm3+LDS_K+hi*1024+r32*16; const lds_cptr vp0=shm3+LDS_V+((lane>>4)&1)*32+(lane&3)*8+(4*hi+((lane&15)>>2))*64;
  const __attribute__((address_space(3))) u32x2* cb3=(const __attribute__((address_space(3))) u32x2*)(shm3+LDS_CB);
  if(!pf){DMA_K(0,0);DMA_V(0,0);DMA_K(1,SLOTB);}
  bf16x8 qr[4];
  #pragma unroll
  for(int d0=0;d0<4;++d0)qr[d0]=*reinterpret_cast<const bf16x8*>(&Qw[(long)r32*QP+d0*16+hi*8]);
  const int qpos=row0+r32; const int lower=(VAR==2)?((qpos-511)<0?0:(qpos-511)):0;
  unsigned long long sel=~0ull; if(VAR==1)sel=SEL[(size_t)(rowbase+qpos)*2+hx];
  bf16x4 qone=bf16x4{};
  #define QONE() do{ if(VAR==0){ int hi_=hi; asm volatile("":"+v"(hi_)); u32x2 q1=(hi_==0)?u32x2{0x3F803F80u,0x00003F80u}:u32x2{0u,0u}; qone=__builtin_bit_cast(bf16x4,q1);} }while(0)
  bf16x4 kb0=bf16x4{},kb1=bf16x4{};
  #define KBLOAD(t) do{ if(VAR==0){ const u32x2 w0_=cb3[64*(t)+r32], w1_=cb3[64*(t)+32+r32]; \
      u32x2 a0_=(hi==0)?w0_:u32x2{0u,0u}; u32x2 a1_=(hi==0)?w1_:u32x2{0u,0u}; \
      kb0=__builtin_bit_cast(bf16x4,a0_); kb1=__builtin_bit_cast(bf16x4,a1_);} }while(0)
  float mhat=0.f,l_reg=0.f;f32x16 o[2];o[0]=f32x16{};o[1]=f32x16{};const f32x16 zero16=f32x16{};
  #define CMASK(P0,P1,t) do{ amask<VAR>(P0,P1,64*TNOM(t),qpos,lower,hi); }while(0)
  bool resc=false;
  #define START(P0,P1) do{ const float rm=rowmax(P0,P1); resc=false; mhat=rm; \
      _Pragma("unroll") for(int r=0;r<16;++r){P0[r]=fsub_s(P0[r],rm);P1[r]=fsub_s(P1[r],rm);} \
    _Pragma("unroll") for(int r=0;r<16;++r)P0[r]=__builtin_amdgcn_exp2f(P0[r]); }while(0)
  #define RESC() do{ if(resc){ asm volatile("s_waitcnt lgkmcnt(0)":::"memory"); const float*wq_=wsf+4*hi; asm volatile("":"+v"(wq_)); \
      _Pragma("unroll") for(int d_=0;d_<2;++d_) _Pragma("unroll") for(int r=0;r<16;++r)o[d_][r]*=wq_[(r&3)+8*(r>>2)]; } }while(0)
  f32x16 pA0,pA1,pB0,pB1;
  int sl_prev=0,sl_cur=0,sl_next=SLOTB,sl_nn=2*SLOTB;
  #define ROT() do{sl_prev=sl_cur;sl_cur=sl_next;sl_next=sl_nn;sl_nn=(sl_nn==(NSLOT-1)*SLOTB)?0:sl_nn+SLOTB;}while(0)
  if(!pf){DMA_K(2,2*SLOTB);}
  DMA_K(3,3*SLOTB);DMA_V(1,SLOTB);
  WAIT_BAR(5);
  KBLOAD(0); QONE();
  qkt<VAR>(pA0,pA1,Kbase,qr,r32,hi,kb0,kb1,qone);asm volatile("s_nop 15\n\ts_nop 7":"+v"(pA0),"+v"(pA1));CMASK(pA0,pA1,0);
  START(pA0,pA1);
  _Pragma("unroll") for(int r=0;r<16;++r)pA1[r]=__builtin_amdgcn_exp2f(pA1[r]);
  WAIT_BAR(2);
  if(4<NT){DMA_K(4,0);} DMA_V(2,2*SLOTB);
  ROT();
  kload8(kf,kp0+sl_cur);
  WAIT_BAR(4);
  s16x4 vlo[8],vhi[8]; u32x4 pw0,pw1,pw2,pw3;
  #define PKW(P,B) cvtpk_s(P[B],P[B+1])
  #define PAF(k) __builtin_bit_cast(bf16x8,pw##k)
  #define VFR(i) (bf16x8){vlo[i][0],vlo[i][1],vlo[i][2],vlo[i][3],vhi[i][0],vhi[i][1],vhi[i][2],vhi[i][3]}
  #define PIN(x) asm volatile("":"+v"(x))
  #define MX3(a,b,c) __builtin_fmaxf(__builtin_fmaxf((a),(b)),(c))
  #define GAPA(MF,A0,A1,A2,A3,W0,W1,PW) do{ MF; sacc+=A0; sacc+=A1; sacc+=A2; sacc+=A3; PIN(sacc); W0; W1; PIN(PW); SBAR(); }while(0)
  #define EX(v) __builtin_amdgcn_exp2f(v)
  #define GAPB(MF,X,B) do{ MF; X[B]=EX(X[B]-mhe); X[B+1]=EX(X[B+1]-mhe); X[B+2]=EX(X[B+2]-mhe); X[B+3]=EX(X[B+3]-mhe); PIN(X); SBAR(); }while(0)
  #define VRD(i) do{ vlo[i]=vtr(vp_+(((i)>>2)*4096+((i)&3)*1024)); vhi[i]=vtr(vp_+(((i)>>2)*4096+((i)&3)*1024+512)); }while(0)
  #define KRD(G,j) do{ if(G){ kload2(kf,kp0+sl_next,j); SBAR(); } }while(0)
  #define STEP(C0,C1,P0,P1,t,GK,GV,GL) do{ SBAR(); \
    const lds_cptr vp_=vp0+sl_prev; \
    VRD(0); SBAR(); float sacc=(P0[0]+P0[1]); \
    GAPA(C0=__builtin_amdgcn_mfma_f32_32x32x16_bf16(kf[0],qr[0],zero16,0,0,0), P0[2],P0[3],P0[4],P0[5],     pw0[0]=PKW(P0,0), pw0[1]=PKW(P0,2), pw0); \
    VRD(4); SBAR(); GAPA(C1=__builtin_amdgcn_mfma_f32_32x32x16_bf16(kf[1],qr[0],zero16,0,0,0), P0[6],P0[7],P0[8],P0[9],     pw0[2]=PKW(P0,4), pw0[3]=PKW(P0,6), pw0); \
    VRD(1); SBAR(); GAPA(C0=__builtin_amdgcn_mfma_f32_32x32x16_bf16(kf[2],qr[1],C0,0,0,0),   P0[10],P0[11],P0[12],P0[13], pw1[0]=PKW(P0,8), pw1[1]=PKW(P0,10), pw1); \
    VRD(5); SBAR(); GAPA(C1=__builtin_amdgcn_mfma_f32_32x32x16_bf16(kf[3],qr[1],C1,0,0,0),   P0[14],P0[15],P1[0],P1[1],   pw1[2]=PKW(P0,12),pw1[3]=PKW(P0,14), pw1); \
    VRD(2); SBAR(); GAPA(C0=__builtin_amdgcn_mfma_f32_32x32x16_bf16(kf[4],qr[2],C0,0,0,0),   P1[2],P1[3],P1[4],P1[5],     pw2[0]=PKW(P1,0), pw2[1]=PKW(P1,2), pw2); \
    VRD(6); SBAR(); GAPA(C1=__builtin_amdgcn_mfma_f32_32x32x16_bf16(kf[5],qr[2],C1,0,0,0),   P1[6],P1[7],P1[8],P1[9],     pw2[2]=PKW(P1,4), pw2[3]=PKW(P1,6), pw2); \
    KBLOAD(t); \
    VRD(3); SBAR(); GAPA(C0=__builtin_amdgcn_mfma_f32_32x32x16_bf16(kf[6],qr[3],C0,0,0,0),   P1[10],P1[11],P1[12],P1[13], pw3[0]=PKW(P1,8), pw3[1]=PKW(P1,10), pw3); \
    VRD(7); SBAR(); GAPA(C1=__builtin_amdgcn_mfma_f32_32x32x16_bf16(kf[7],qr[3],C1,0,0,0),   P1[14],P1[15],0.f,0.f,       pw3[2]=PKW(P1,12),pw3[3]=PKW(P1,14), pw3); \
    l_reg+=sacc; \
    if(VAR==0){ QONE(); C0=__builtin_amdgcn_mfma_f32_32x32x8bf16_1k(kb0,qone,C0,0,0,0); C1=__builtin_amdgcn_mfma_f32_32x32x8bf16_1k(kb1,qone,C1,0,0,0); SBAR(); } \
    if(GK){DMA_K((t)+4,sl_cur);} if(GV){DMA_V((t)+2,sl_nn);} \
    CMASK(C0,C1,t); \
    float mhe; \
    { float a=MX3(C0[0],C0[1],C1[0]),b=MX3(C0[2],C0[3],C1[1]); a=MX3(a,C1[2],C1[3]); \
      _Pragma("unroll") for(int r=4;r<16;r+=4){a=MX3(a,C0[r],C0[r+1]);b=MX3(b,C0[r+2],C0[r+3]);a=MX3(a,C1[r],C1[r+1]);b=MX3(b,C1[r+2],C1[r+3]);} \
      float rm=__builtin_fmaxf(a,b); { auto rr=__builtin_amdgcn_permlane32_swap(__float_as_uint(rm),__float_as_uint(rm),false,false); rm=__builtin_fmaxf(__uint_as_float(rr[0]),__uint_as_float(rr[1])); } \
      bool on_=true; if(VAR==1) on_=((sel>>(t))&1ull)!=0ull; \
      rm=on_?(rm-mhat):-INFINITY; \
      resc=false; \
      if(__builtin_expect(__any(rm>(float)THRL),0)){ const float dl=__builtin_fmaxf(rm,0.f); mhat+=dl; \
        const float f=__builtin_amdgcn_exp2f(-dl); l_reg*=f; if(hi==0)wsf[r32]=f; resc=true; } \
      mhe=on_?mhat:INFINITY; } \
    SBAR(); \
    GAPB(o[0]=__builtin_amdgcn_mfma_f32_32x32x16_bf16(PAF(0),VFR(0),o[0],0,0,0), C0,0); \
    GAPB(o[1]=__builtin_amdgcn_mfma_f32_32x32x16_bf16(PAF(0),VFR(4),o[1],0,0,0), C0,4); \
    KRD(GL,0); GAPB(o[0]=__builtin_amdgcn_mfma_f32_32x32x16_bf16(PAF(1),VFR(1),o[0],0,0,0), C0,8); \
    KRD(GL,1); GAPB(o[1]=__builtin_amdgcn_mfma_f32_32x32x16_bf16(PAF(1),VFR(5),o[1],0,0,0), C0,12); \
    KRD(GL,2); GAPB(o[0]=__builtin_amdgcn_mfma_f32_32x32x16_bf16(PAF(2),VFR(2),o[0],0,0,0), C1,0); \
    KRD(GL,3); GAPB(o[1]=__builtin_amdgcn_mfma_f32_32x32x16_bf16(PAF(2),VFR(6),o[1],0,0,0), C1,4); \
    GAPB(o[0]=__builtin_amdgcn_mfma_f32_32x32x16_bf16(PAF(3),VFR(3),o[0],0,0,0), C1,8); \
    GAPB(o[1]=__builtin_amdgcn_mfma_f32_32x32x16_bf16(PAF(3),VFR(7),o[1],0,0,0), C1,12); \
    }while(0)
  int t=1;
  #undef CMASK
  #define CMASK(P0,P1,t) do{}while(0)
  for(;t+5<NT;t+=2){
    STEP(pB0,pB1,pA0,pA1,t,true,true,true);     WAIT_BAR(4); RESC(); ROT();
    STEP(pA0,pA1,pB0,pB1,t+1,true,true,true);   WAIT_BAR(4); RESC(); ROT();
  }
  #undef CMASK
  #define CMASK(P0,P1,t) do{ amask<VAR>(P0,P1,64*TNOM(t),qpos,lower,hi); }while(0)
  #define CNT_(s_) (((s_)<=0)?((4<NT?1:0)+1):((((s_)+4<NT)?1:0)+(((s_)+2<NT)?1:0)))
  #define ENDW(tt) do{ const int a_=((tt)==NT-2)?0:(CNT_(tt)+CNT_((tt)-1)); if(a_>=4){WAIT_BAR(4);} else if(a_==3){WAIT_BAR(3);} else if(a_==2){WAIT_BAR(2);} else if(a_==1){WAIT_BAR(1);} else {WAIT_BAR(0);} }while(0)
  float gv_=1.f; if(VAR!=0) gv_=gates[(size_t)(rowbase+qpos)*24+head*3+VAR];
  for(;t+1<NT;t+=2){
    STEP(pB0,pB1,pA0,pA1,t,(t+4<NT),(t+2<NT),(t+1<NT));       ENDW(t);   RESC(); ROT();
    STEP(pA0,pA1,pB0,pB1,t+1,(t+5<NT),(t+3<NT),(t+2<NT));     ENDW(t+1); RESC(); ROT();
  }
  #define DRAIN(X0,X1,slot) do{ float sacc=X0[0]+X0[1]; _Pragma("unroll") for(int r=2;r<16;++r)sacc+=X0[r]; _Pragma("unroll") for(int r=0;r<16;++r)sacc+=X1[r]; l_reg+=sacc; \
    pw0=(u32x4){PKW(X0,0),PKW(X0,2),PKW(X0,4),PKW(X0,6)};pw1=(u32x4){PKW(X0,8),PKW(X0,10),PKW(X0,12),PKW(X0,14)};pw2=(u32x4){PKW(X1,0),PKW(X1,2),PKW(X1,4),PKW(X1,6)};pw3=(u32x4){PKW(X1,8),PKW(X1,10),PKW(X1,12),PKW(X1,14)}; \
    SBAR(); pv(o,vb0+(slot),PAF(0),PAF(1),PAF(2),PAF(3)); }while(0)
  if(t<NT){
    STEP(pB0,pB1,pA0,pA1,NT-1,false,false,false); RESC();
    DRAIN(pB0,pB1,sl_cur);
  } else {
    DRAIN(pA0,pA1,sl_prev);
  }
  #undef DRAIN
  float rg_=1.f; if(VAR!=0){ rg_=__builtin_amdgcn_rcpf(gv_); asm volatile("":"+v"(rg_)); }
  if(nxK){ const bf16*kn_=nxK+(long)lane*QP+wid*8; glds16(kn_,(unsigned)__builtin_amdgcn_readfirstlane(kdst)); glds16(kn_+(long)KVBLK*QP,(unsigned)__builtin_amdgcn_readfirstlane(kdst+SLOTB)); glds16(kn_+(long)2*KVBLK*QP,(unsigned)__builtin_amdgcn_readfirstlane(kdst+2*SLOTB)); }
  #undef PKW
  #undef PAF
  #undef VFR
  #undef PIN
  #undef MX3
  #undef GAPA
  #undef GAPB
  #undef EX
  #undef VRD
  #undef KRD
  #undef STEP
  #undef ENDW
  #undef CNT_
  {auto rr=__builtin_amdgcn_permlane32_swap(__float_as_uint(l_reg),__float_as_uint(l_reg),false,false);l_reg=__uint_as_float(rr[0])+__uint_as_float(rr[1]);}
  if(VAR!=0){ l_reg=l_reg*rg_; }
  if(hi==0)wsf[32+r32]=l_reg;asm volatile("s_waitcnt lgkmcnt(0)":::"memory");
  float rli[16];
  { const float*wq_=wsf+32+4*hi; asm volatile("":"+v"(wq_));
  #pragma unroll
  for(int r=0;r<16;++r)rli[r]=__builtin_amdgcn_rcpf(wq_[(r&3)+8*(r>>2)]); }
  bf16*Ow=Ob+(rowbase+row0)*1024+((VAR==0)?(512+hx*64):head*64);
  const bf16*Oc=(const bf16*)((const char*)Ob-(WS_OMIX-WS_O))+(rowbase+row0)*1024+head*64;
  { bf16*stg=(bf16*)(shm+LDS_OST)+wid*2048; bf16*sq_=stg+(4*hi)*64+r32; asm volatile("":"+v"(sq_));
    #pragma unroll
    for(int r=0;r<16;++r){const int orow=(r&3)+8*(r>>2);
      #pragma unroll
      for(int d0=0;d0<2;++d0)sq_[orow*64+d0*32]=f2bf(o[d0][r]*rli[r]);}
    asm volatile("s_waitcnt lgkmcnt(0)":::"memory");
    float*sqp=SSQO+(size_t)(rowbase+row0)*16+((VAR==0)?(8+hx):head);
    u32x4 pvv[4],pcv[4];
    if(VAR==1){
      #pragma unroll
      for(int i=0;i<4;++i){const int row=i*8+(lane>>3),ch=lane&7; pvv[i]=*(const u32x4*)(Ow+(long)row*1024+ch*8); pcv[i]=*(const u32x4*)(Oc+(long)row*1024+ch*8);} }
    #pragma unroll
    for(int i=0;i<4;++i){const int row=i*8+(lane>>3),ch=lane&7; u32x4 v=*(const u32x4*)(stg+row*64+ch*8);
      if(VAR==1){ const u32x4 pv_=pvv[i]; const u32x4 pc_=pcv[i];
        #pragma unroll
        for(int q=0;q<4;++q){ const float lo_=__uint_as_float(v[q]<<16)+(__uint_as_float(pv_[q]<<16)+__uint_as_float(pc_[q]<<16)), hi_=__uint_as_float(v[q]&0xffff0000u)+(__uint_as_float(pv_[q]&0xffff0000u)+__uint_as_float(pc_[q]&0xffff0000u)); v[q]=cvtpk_s(lo_,hi_); } }
      *(u32x4*)(Ow+(long)row*1024+ch*8)=v;
      if(VAR!=2){ float ss=0.f;
        #pragma unroll
        for(int q=0;q<4;++q){ const float lo_=__uint_as_float(v[q]<<16), hi_=__uint_as_float(v[q]&0xffff0000u); ss+=lo_*lo_+hi_*hi_; }
        ss+=__shfl_xor(ss,1); ss+=__shfl_xor(ss,2); ss+=__shfl_xor(ss,4);
        if(ch==0)sqp[(size_t)row*16]=ss; } } }
  asm volatile("s_waitcnt lgkmcnt(0)\n\ts_barrier":::"memory");
  if(nxV){ const bf16*vn_=nxV+(long)(16*(wid&3)+(lane>>2))*QP+(wid>>2)*32+(lane&3)*8; glds16(vn_,(unsigned)__builtin_amdgcn_readfirstlane(vdst)); }
  #undef DMA_K
  #undef DMA_V
  #undef CMASK
  #undef SELMASK
  #undef START
  #undef RESC
  #undef ROT
  #undef KBLOAD
  #undef QONE
  #undef TNOM
  #undef TACT
}
#undef SBAR
#undef WAIT_BAR
}
namespace cmpx {
using att::bf16x8; using att::s16x4; using att::f32x16; using att::u32x4; using att::lds_cptr;
constexpr int TKS = 9;
constexpr int L_KI = 0, L_VI = 32768, L_IMP = 65536, IMP_ROW = 65, IMP_WAVE = 32 * IMP_ROW * 4, LDS_BYTES_CMP = L_IMP + 8 * IMP_WAVE;
__device__ __forceinline__ float swap_half(float x, int hi) {
    auto rr = __builtin_amdgcn_permlane32_swap(__float_as_uint(x), __float_as_uint(x), false, false);
    return __uint_as_float(hi ? rr[0] : rr[1]);
}
__device__ __forceinline__ unsigned bcnt64(unsigned long long m) { unsigned n; asm("s_bcnt1_i32_b64 %0, %1" : "=s"(n) : "s"(m) : "scc"); return n; }
__device__ __forceinline__ void load_kv(int bk, const bf16* KC, const bf16* VC, char* shm, int tid) {
    const bf16* kc = KC + (size_t)bk * 256 * 64; const bf16* vc = VC + (size_t)bk * 256 * 64;
#pragma unroll
    for (int u = 0; u < 4; ++u) { const int i = tid + 512 * u, r = i >> 3, c = i & 7;
        const u32x4 kv = *(const u32x4*)(kc + r * 64 + c * 8), vv = *(const u32x4*)(vc + r * 64 + c * 8);
        *(u32x4*)(shm + L_KI + c * 4096 + r * 16) = kv;
        *(u32x4*)(shm + L_VI + (c >> 2) * 16384 + r * 64 + (c & 3) * 16) = vv; }
}
__device__ __forceinline__ void cmp_unit(int bk, int blk, const bf16* QKVb, const float* gates, bf16* OC, unsigned long long* SEL, char* shm, const int wv) {
    const int tid = opaque_tid(wv), lane = tid & 63, r32 = lane & 31, hi = lane >> 5, wid = wv;
    const int g = wid >> 1, th = wid & 1, b = bk >> 1, kvh = bk & 1, head = kvh * 4 + g;
    const long rowbase = (long)b * SEQ;
    const int tok0 = blk * 64 + th * 32, t = tok0 + r32;
    const bf16* Qw = QKVb + (rowbase + tok0) * QP + C_QA + (long)head * HS;
    bf16x8 qr[4];
#pragma unroll
    for (int d0 = 0; d0 < 4; ++d0) qr[d0] = *reinterpret_cast<const bf16x8*>(&Qw[(long)r32 * QP + d0 * 16 + hi * 8]);
    float gvv[16];
    { const float* gp = gates + (size_t)(rowbase + tok0 + 4 * hi) * 24 + head * 3; asm volatile("" : "+v"(gp));
#pragma unroll
      for (int r = 0; r < 16; ++r) gvv[r] = gp[((r & 3) + 8 * (r >> 2)) * 24]; }
    const int ntile = (4 * blk + 3 + 31) >> 5;
    const lds_cptr shm3 = (lds_cptr)shm;
    f32x16 S[8];
    { const lds_cptr kp = shm3 + L_KI + hi * 4096 + r32 * 16;
#pragma unroll
      for (int j = 0; j < 8; ++j) {
          if (j < ntile) { f32x16 a = f32x16{};
#pragma unroll
              for (int d0 = 0; d0 < 4; ++d0) a = __builtin_amdgcn_mfma_f32_32x32x16_bf16(*(const __attribute__((address_space(3))) bf16x8*)(kp + d0 * 8192 + j * 512), qr[d0], a, 0, 0, 0);
              S[j] = a; }
          else S[j] = f32x16{}; } }
    const int nlim = (t - 31) >> 4;
    const int nl0 = (tok0 - 31) >> 4;
    float m = -INFINITY;
    { int nb = 4 * hi; asm volatile("" : "+v"(nb));
#pragma unroll
      for (int j = 0; j < 8; ++j) if (j < ntile) {
          if (32 * j + 31 > nl0) {
#pragma unroll
              for (int r = 0; r < 16; ++r) { const int n = nb + 32 * j + (r & 3) + 8 * (r >> 2); if (n > nlim) S[j][r] = -INFINITY; } }
          float a = att::max3f(S[j][0], S[j][1], S[j][2]), c = att::max3f(S[j][3], S[j][4], S[j][5]);
          a = att::max3f(a, S[j][6], S[j][7]); c = att::max3f(c, S[j][8], S[j][9]); a = att::max3f(a, S[j][10], S[j][11]); c = att::max3f(c, S[j][12], S[j][13]);
          a = att::max3f(a, S[j][14], S[j][15]); m = att::max3f(m, a, c); } }
    m = fmaxf(m, swap_half(m, hi));
    if (m == -INFINITY) m = 0.f;
    float l = 0.f;
#pragma unroll
    for (int j = 0; j < 8; ++j) if (j < ntile) {
#pragma unroll
        for (int r = 0; r < 16; ++r) { S[j][r] = __builtin_amdgcn_exp2f(S[j][r] - m); l += S[j][r]; } }
    l += swap_half(l, hi);
    const float rl = l > 0.f ? 1.0f / l : 0.f;
#pragma unroll
    for (int j = 0; j < 8; ++j) if (j < ntile) S[j] = S[j] * rl;
    { float* impw = (float*)(shm + L_IMP + wid * IMP_WAVE) + r32 * IMP_ROW + hi;
      float carry = 0.f;
#pragma unroll
      for (int j = 0; j < 8; ++j) if (j < ntile)
#pragma unroll
          for (int k = 0; k < 4; ++k) {
              const float G = (S[j][4 * k] + S[j][4 * k + 1]) + (S[j][4 * k + 2] + S[j][4 * k + 3]);
              const float LP = swap_half(S[j][4 * k + 3], hi);
              impw[2 * (4 * j + k)] = G + (hi ? LP : carry);
              carry = LP; } }
    __syncthreads();
    {
      if (blk < 16) {
          if (lane < 8) SEL[(size_t)(rowbase + blk * 64 + wid * 8 + lane) * 2 + kvh] = (2ull << blk) - 1ull;
      } else {
#pragma unroll 1
      for (int i = 0; i < 8; i += 4) {
          const int cur = blk; unsigned kb[4]; bool vld[4];
#pragma unroll
          for (int u = 0; u < 4; ++u) { const int tl = wid * 8 + i + u, th2 = tl >> 5, q2 = tl & 31;
              const float* ip = (const float*)(shm + L_IMP) + q2 * IMP_ROW + lane;
              float val = (ip[(0 + th2) * (IMP_WAVE / 4)] + ip[(2 + th2) * (IMP_WAVE / 4)]) + (ip[(4 + th2) * (IMP_WAVE / 4)] + ip[(6 + th2) * (IMP_WAVE / 4)]);
              if (lane > cur) val = -1.f; else if (lane == 0 || lane == cur || lane == cur - 1) val = 1e6f;
              vld[u] = val >= 0.f; kb[u] = vld[u] ? __float_as_uint(val) : 0u; }
          unsigned T[4] = {0u, 0u, 0u, 0u};
#pragma unroll
          for (int bit = 30; bit >= TKS; --bit) {
#pragma unroll
              for (int u = 0; u < 4; ++u) { const unsigned c = T[u] | (1u << bit); T[u] = bcnt64(__ballot(kb[u] >= c)) >= 16u ? c : T[u]; } }
          bool more = false;
#pragma unroll
          for (int u = 0; u < 4; ++u) { const unsigned hi1 = T[u] + (1u << TKS);
              const unsigned n_eq = bcnt64(__ballot(kb[u] >= T[u] && kb[u] < hi1 && vld[u])), n_gt = bcnt64(__ballot(kb[u] >= hi1));
              more = more || (n_gt + n_eq != 16u); }
          if (more) {
#pragma unroll
              for (int bit = TKS - 1; bit >= 0; --bit) {
#pragma unroll
                  for (int u = 0; u < 4; ++u) { const unsigned c = T[u] | (1u << bit); T[u] = bcnt64(__ballot(kb[u] >= c)) >= 16u ? c : T[u]; } } }
#pragma unroll
          for (int u = 0; u < 4; ++u) { const int tl = wid * 8 + i + u;
              const bool gt_ = kb[u] > T[u], eq_ = (kb[u] == T[u]) && vld[u];
              const unsigned long long eqm = __ballot(eq_); const int need = 16 - (int)bcnt64(__ballot(gt_));
              const int below = (int)__builtin_amdgcn_mbcnt_hi((unsigned)(eqm >> 32), __builtin_amdgcn_mbcnt_lo((unsigned)eqm, 0u));
              const unsigned long long selmask = __ballot(gt_ || (eq_ && below < need));
              if (lane == 0) SEL[(size_t)(rowbase + blk * 64 + tl) * 2 + kvh] = selmask; } } } }
    __syncthreads();
    f32x16 o[2]; o[0] = f32x16{}; o[1] = f32x16{};
    { const lds_cptr vp0 = shm3 + L_VI + ((lane >> 4) & 1) * 32 + (lane & 3) * 8 + (4 * hi + ((lane & 15) >> 2)) * 64;
#pragma unroll
      for (int j = 0; j < 8; ++j) if (j < ntile) {
#pragma unroll
          for (int s = 0; s < 2; ++s) {
              u32x4 pw; pw[0] = att::cvtpk_s(S[j][8 * s], S[j][8 * s + 1]); pw[1] = att::cvtpk_s(S[j][8 * s + 2], S[j][8 * s + 3]); pw[2] = att::cvtpk_s(S[j][8 * s + 4], S[j][8 * s + 5]); pw[3] = att::cvtpk_s(S[j][8 * s + 6], S[j][8 * s + 7]);
#pragma unroll
              for (int d0 = 0; d0 < 2; ++d0) { const s16x4 lo = att::vtr(vp0 + d0 * 16384 + j * 2048 + s * 1024), hh = att::vtr(vp0 + d0 * 16384 + j * 2048 + s * 1024 + 512);
                  const bf16x8 vf = (bf16x8){lo[0], lo[1], lo[2], lo[3], hh[0], hh[1], hh[2], hh[3]};
                  o[d0] = __builtin_amdgcn_mfma_f32_32x32x16_bf16(__builtin_bit_cast(bf16x8, pw), vf, o[d0], 0, 0, 0); } } } }
    { bf16* stg = (bf16*)(shm + L_IMP + wid * IMP_WAVE); bf16* sq_ = stg + (4 * hi) * 64 + r32; asm volatile("" : "+v"(sq_));
#pragma unroll
      for (int r = 0; r < 16; ++r) { const int orow = (r & 3) + 8 * (r >> 2); const float gv = gvv[r];
#pragma unroll
          for (int d0 = 0; d0 < 2; ++d0) sq_[orow * 64 + d0 * 32] = f2bf(o[d0][r] * gv); }
      asm volatile("s_waitcnt lgkmcnt(0)" ::: "memory");
      bf16* Ow = OC + (rowbase + tok0) * 1024 + head * 64;
#pragma unroll
      for (int i = 0; i < 4; ++i) { const int row = i * 8 + (lane >> 3), ch = lane & 7; const u32x4 v = *(const u32x4*)(stg + row * 64 + ch * 8);
          *(u32x4*)(Ow + (long)row * 1024 + ch * 8) = v; } }
    __syncthreads();
}
}
#define LAS __attribute__((address_space(3)))
typedef unsigned v4u __attribute__((ext_vector_type(4)));
typedef float f32x4 __attribute__((ext_vector_type(4)));
constexpr int NWAVES = 8;
constexpr int RING_BYTES = 131072, LDS_BYTES = 147456;

__device__ __forceinline__ unsigned pk2(float lo, float hi) { return (unsigned)f2bf(lo) | ((unsigned)f2bf(hi) << 16); }
__device__ __forceinline__ int src_win(int np) {
    const int tile = np >> 8, w = np & 255;
    if (tile == 11) { if (w < 24) return 1280 + w; if (w < 32) return 2840 + (w - 24); return -1; }
    const int half = w >> 7, head = (w >> 5) & 3, i = w & 31;
    const int c = tile * 256 + head * 64 + half * 32 + i;
    return c < 1280 ? c : c + 24;
}
template <bool F8 = false> __device__ __forceinline__ void transpose_item(const float* W, int N, int K, const float* gain, bf16* WT, int n0, int k0, int sc4, LAS float* scr, int lane) {
    const int kr = lane >> 3, c4 = (lane & 7) * 4;
    f32x4 v[8];
#pragma unroll
    for (int i = 0; i < 8; ++i) v[i] = sc4 >= 0 ? __builtin_nontemporal_load((const f32x4*)(W + (size_t)(k0 + 8 * i + kr) * N + sc4)) : (f32x4){0.f, 0.f, 0.f, 0.f};
#pragma unroll
    for (int i = 0; i < 8; ++i) { const int kk = 8 * i + kr; const float gg = gain ? gain[k0 + kk] : 1.f;
#pragma unroll
        for (int e = 0; e < 4; ++e) scr[kk * 33 + c4 + e] = v[i][e] * gg; }
    asm volatile("s_waitcnt lgkmcnt(0)" ::: "memory");
    const int c = lane & 7;
#pragma unroll
    for (int j = 0; j < 4; ++j) { const int n = (lane >> 3) + 8 * j; const LAS float* s = scr + (8 * c) * 33 + n;
        if (F8) { int w0 = __builtin_amdgcn_cvt_pk_fp8_f32(s[0 * 33], s[1 * 33], 0, false); w0 = __builtin_amdgcn_cvt_pk_fp8_f32(s[2 * 33], s[3 * 33], w0, true);
            int w1 = __builtin_amdgcn_cvt_pk_fp8_f32(s[4 * 33], s[5 * 33], 0, false); w1 = __builtin_amdgcn_cvt_pk_fp8_f32(s[6 * 33], s[7 * 33], w1, true);
            *(unsigned long long*)((unsigned char*)WT + (size_t)(n0 + n) * K + k0 + 8 * c) = (unsigned long long)(unsigned)w0 | ((unsigned long long)(unsigned)w1 << 32); }
        else { v4u o; o.x = pk2(s[0 * 33], s[1 * 33]); o.y = pk2(s[2 * 33], s[3 * 33]); o.z = pk2(s[4 * 33], s[5 * 33]); o.w = pk2(s[6 * 33], s[7 * 33]);
            *(v4u*)(WT + (size_t)(n0 + n) * K + k0 + 8 * c) = o; } }
    asm volatile("s_waitcnt lgkmcnt(0)" ::: "memory");
}
template <int PART> __device__ __forceinline__ void ph_prep(const P& p, LAS unsigned char* lds, const int wv, const int vb, const int nvb) {
    const int tid = opaque_tid(wv), lane = tid & 63, wave = wv;
    const int gw = vb * NWAVES + wave, NGW = nvb * NWAVES;
    LAS float* scr = (LAS float*)(lds + wave * 16384);
    constexpr int I_GU = 176 * 16, I_D = 32 * 44, I_IN = 96 * 16, I_SQ = 32 * 16, I_PR = 32 * 4, I_C1 = 512, I_C2 = 16, I_PB = 128;
    constexpr int NITEMS = PART == 0 ? (I_GU + I_D + I_IN + I_C1 + I_C2 + I_PB) : (I_GU + I_D + 2 * I_SQ + I_PR);
    for (int it = gw; it < NITEMS; it += NGW) {
        int r = it;
        if (r < I_GU) {
            const int ng = r / 16, kb = r % 16, n0 = ng * 32, tile = n0 >> 8, w = n0 & 255;
            const float* W = PART ? (w < 128 ? p.in[25] : p.in[26]) : (w < 128 ? p.in[3] : p.in[4]);
            if (PART == 0) transpose_item<F8_G1>(W, DFF, D, nullptr, (bf16*)(p.ws + WS_WGU1), n0, kb * 64, tile * 128 + (w & 127) + 4 * (lane & 7), scr, lane);
            else transpose_item<F8_G5>(W, DFF, D, p.in[24], (bf16*)(p.ws + WS_WGU2), n0, kb * 64, tile * 128 + (w & 127) + 4 * (lane & 7), scr, lane);
            continue; }
        r -= I_GU;
        if (r < I_D) {
            const int ng = r / 44, kb = r % 44;
            if (PART == 0) transpose_item<F8_G2>(p.in[5], D, DFF, nullptr, (bf16*)(p.ws + WS_WD1), ng * 32, kb * 64, ng * 32 + 4 * (lane & 7), scr, lane);
            else transpose_item<F8_G6>(p.in[27], D, DFF, nullptr, (bf16*)(p.ws + WS_WD2), ng * 32, kb * 64, ng * 32 + 4 * (lane & 7), scr, lane);
            continue; }
        r -= I_D;
        if (PART == 0) {
            if (r < I_IN) { const int ng = r / 16, kb = r % 16;
                transpose_item(p.in[7], INW, D, p.in[6], (bf16*)(p.ws + WS_WIN), ng * 32, kb * 64, src_win(ng * 32 + 4 * (lane & 7)), scr, lane);
                continue; }
            r -= I_IN;
            if (r < I_C1) { const int ng = r >> 5, kb = r & 31, which = ng >> 3;
                transpose_item(which ? p.in[17] : p.in[15], 256, 2048, nullptr, (bf16*)(p.ws + WS_WC1), ng * 32, kb * 64, (ng & 7) * 32 + 4 * (lane & 7), scr, lane);
                continue; }
            r -= I_C1;
            if (r < I_C2) { const int ng = r >> 2, kb = r & 3, which = ng >> 1;
                transpose_item(which ? p.in[18] : p.in[16], 64, 256, nullptr, (bf16*)(p.ws + WS_WC2), ng * 32, kb * 64, (ng & 1) * 32 + 4 * (lane & 7), scr, lane);
                continue; }
            r -= I_C2;
            {
                const int which = r >> 6, p64 = r & 63; const float* pos = which ? p.in[14] : p.in[13]; const float* w1 = which ? p.in[17] : p.in[15];
                f32x4 acc = (f32x4){0.f, 0.f, 0.f, 0.f};
#pragma unroll 1
                for (int r0 = 0; r0 < 32; r0 += 8) { f32x4 wv_[8];
#pragma unroll
                    for (int q = 0; q < 8; ++q) wv_[q] = __builtin_nontemporal_load((const f32x4*)(w1 + (size_t)(32 * p64 + r0 + q) * 256) + lane);
#pragma unroll
                    for (int q = 0; q < 8; ++q) acc = acc + wv_[q] * pos[32 * p64 + r0 + q]; }
                *((f32x4*)(p.ws + WS_POSBP) + (size_t)(which * 64 + p64) * 64 + lane) = acc; }
        } else {
            if (r < 2 * I_SQ) { const int second = r >= I_SQ; if (second) r -= I_SQ;
                const int ng = r / 16, kb = r % 16;
                if (second && F8_G7) transpose_item<true>(p.in[29], D, D, p.in[28], (bf16*)(p.ws + WS_WGATE), ng * 32, kb * 64, ng * 32 + 4 * (lane & 7), scr, lane);
                else transpose_item(second ? p.in[29] : p.in[23], D, D, second ? p.in[28] : (const float*)(p.ws + WS_GOUT), (bf16*)(p.ws + (second ? WS_WGATE : WS_WOUT)), ng * 32, kb * 64, ng * 32 + 4 * (lane & 7), scr, lane);
                continue; }
            r -= 2 * I_SQ;
            { const int ng = r / 4, kb = r % 4;
              transpose_item(p.in[30], D, DPLE, nullptr, (bf16*)(p.ws + WS_WPROJ), ng * 32, kb * 64, ng * 32 + 4 * (lane & 7), scr, lane); }
        }
    }
    if (PART == 0) {
    for (int i = vb * 512 + tid; i < 1024; i += nvb * 512) ((float*)(p.ws + WS_GOUT))[i] = i < 512 ? p.in[21][i] : p.in[22][i - 512];
    { bf16* XN = (bf16*)(p.ws + (F8_G1 ? WS_O : WS_XN)); const float* g1 = p.in[2];
      f32x4 gg[4];
#pragma unroll
      for (int j = 0; j < 4; ++j) gg[j] = *((const f32x4*)g1 + lane + 64 * j);
      for (int m0 = gw * 8; m0 < M; m0 += NGW * 8) {
          f32x4 v[8][4];
#pragma unroll
          for (int r = 0; r < 8; ++r) { const f32x4* xr = (const f32x4*)(p.in[0] + (size_t)(m0 + r) * D) + lane;
#pragma unroll
              for (int j = 0; j < 4; ++j) v[r][j] = __builtin_nontemporal_load(xr + 64 * j); }
#pragma unroll
          for (int r = 0; r < 8; ++r) { float s = 0.f;
#pragma unroll
              for (int j = 0; j < 4; ++j) s += (v[r][j][0] * v[r][j][0] + v[r][j][1] * v[r][j][1]) + (v[r][j][2] * v[r][j][2] + v[r][j][3] * v[r][j][3]);
              s = wave_sum(s);
              const float rs = 1.0f / sqrtf(s * (1.f / D) + EPS);
              if constexpr (F8_G1) { unsigned* o4 = (unsigned*)((unsigned char*)XN + (size_t)(m0 + r) * D) + lane;
#pragma unroll
                  for (int j = 0; j < 4; ++j) { int w = __builtin_amdgcn_cvt_pk_fp8_f32(v[r][j][0] * rs * gg[j][0], v[r][j][1] * rs * gg[j][1], 0, false);
                      w = __builtin_amdgcn_cvt_pk_fp8_f32(v[r][j][2] * rs * gg[j][2], v[r][j][3] * rs * gg[j][3], w, true); o4[64 * j] = (unsigned)w; } }
              else { unsigned long long* o8 = (unsigned long long*)(XN + (size_t)(m0 + r) * D) + lane;
#pragma unroll
                  for (int j = 0; j < 4; ++j) o8[64 * j] = (unsigned long long)pk2(v[r][j][0] * rs * gg[j][0], v[r][j][1] * rs * gg[j][1]) | ((unsigned long long)pk2(v[r][j][2] * rs * gg[j][2], v[r][j][3] * rs * gg[j][3]) << 32); } }
      } }
    { float* rope = (float*)(p.ws + WS_ROPE);
      for (int t = vb * 16 + tid; tid < 16 && t < SEQ; t += nvb * 16) {
#pragma unroll
        for (int f = 0; f < 8; ++f) {
          const double ang = (double)t * p.rc[f];
          const double kq = __builtin_rint(ang * p.rc[8]);
          double r = __builtin_fma(-kq, p.rc[9], ang); r = __builtin_fma(-kq, p.rc[10], r);
          const float x = (float)r, x2 = x * x; const int q = (int)kq & 3;
          const float sn = x + x * x2 * (-1.6666667e-1f + x2 * (8.3333333e-3f + x2 * (-1.9841270e-4f + x2 * 2.7557319e-6f)));
          const float cs = 1.0f + x2 * (-0.5f + x2 * (4.1666667e-2f + x2 * (-1.3888889e-3f + x2 * (2.4801587e-5f + x2 * -2.7557319e-7f))));
          const float c = q == 0 ? cs : q == 1 ? -sn : q == 2 ? -cs : sn;
          const float s = q == 0 ? sn : q == 1 ? cs : q == 2 ? -sn : -cs;
          rope[t * 16 + f] = c; rope[t * 16 + 8 + f] = s; } } }
    }
    if (PART == 1) {
    { const f32x4* src = (const f32x4*)p.in[1]; unsigned long long* dst = (unsigned long long*)(p.ws + WS_PB);
      for (size_t i = (size_t)vb * 512 + tid; i < (size_t)M * DPLE / 4; i += (size_t)nvb * 512) { const f32x4 v = __builtin_nontemporal_load(src + i); dst[i] = (unsigned long long)pk2(v[0], v[1]) | ((unsigned long long)pk2(v[2], v[3]) << 32); } }
    }
}

#define RLX_AGENT __ATOMIC_RELAXED, __HIP_MEMORY_SCOPE_AGENT
#define XB_TMO      128
#define XB_XCNT(j)  (256  + 64 * (j))
#define XB_XSUB(j)  (1280 + 64 * (j))
#define XB_XGEN(j)  (2304 + 64 * (j))
#define XB_TOP      3328
#define XB_TOPGEN   3392
#define XCD_BAR_WORDS 3456
#define XB_SPIN_CAP (1u << 18)

__device__ __forceinline__ unsigned xb_ld(unsigned* p)              { return __hip_atomic_load(p, __ATOMIC_RELAXED, __HIP_MEMORY_SCOPE_AGENT); }
__device__ __forceinline__ unsigned xb_add(unsigned* p, unsigned v) { return __hip_atomic_fetch_add(p, v, __ATOMIC_RELAXED, __HIP_MEMORY_SCOPE_AGENT); }
__device__ __forceinline__ unsigned xb_xcc_id() { return (unsigned)__builtin_amdgcn_s_getreg((3 << 11) | 20) & 0xFu; }
#define XB_SPIN(cond, bar) do { unsigned _sp = 0; while (cond) { __builtin_amdgcn_s_sleep(1); \
    if ((++_sp & 255u) == 0u) { if (xb_ld(&(bar)[XB_TMO])) break; if (_sp > XB_SPIN_CAP) { atomicAdd(&(bar)[XB_TMO], 1u); break; } } } } while (0)

struct XcdBarrier {
    unsigned* bar; unsigned x;
    volatile LAS unsigned* st;
};

__device__ __forceinline__ XcdBarrier xcd_barrier_post(unsigned* bar, volatile LAS unsigned* st, bool leader) {
    XcdBarrier b; b.bar = bar; b.x = xb_xcc_id(); b.st = st;
    if (leader) st[2] = xb_add(&bar[XB_XCNT(b.x)], 1u);
    return b;
}
__device__ __forceinline__ void xcd_barrier_complete(unsigned* bar, unsigned x, unsigned& nloc, unsigned& nx) {
    const unsigned G = gridDim.x * gridDim.y * gridDim.z;
    unsigned sum, cnt, mine, sp = 0u;
    for (;;) {
        sum = 0u; cnt = 0u; mine = 0u;
#pragma unroll
        for (unsigned j = 0; j < 16; ++j) { const unsigned c = xb_ld(&bar[XB_XCNT(j)]); sum += c; cnt += (c > 0u) ? 1u : 0u; mine = (j == x) ? c : mine; }
        if (sum == G) break;
        __builtin_amdgcn_s_sleep(1);
        if ((++sp & 255u) == 0u) { if (xb_ld(&bar[XB_TMO])) break; if (sp > XB_SPIN_CAP) { atomicAdd(&bar[XB_TMO], 1u); break; } }
    }
    nloc = mine > 0u ? mine : 1u; nx = cnt > 0u ? cnt : 1u;
}

__device__ __forceinline__ void xcd_barrier(const XcdBarrier& b, bool leader) {
    asm volatile("s_waitcnt vmcnt(0)" ::: "memory");
    __syncthreads();
    if (leader) {
        unsigned* bar = b.bar;
        __builtin_amdgcn_s_waitcnt(0);
        unsigned nloc = b.st[0], nx = b.st[1];
        if (nloc == 0u) { xcd_barrier_complete(bar, b.x, nloc, nx); b.st[0] = nloc; b.st[1] = nx; }
        const unsigned old = xb_add(&bar[XB_XSUB(b.x)], 1u);
        const unsigned gen = old / nloc;
        if (old + 1u == (gen + 1u) * nloc) {
            __builtin_amdgcn_fence(__ATOMIC_RELEASE, "agent");
            asm volatile("s_waitcnt vmcnt(0)" ::: "memory");
            const unsigned og = xb_add(&bar[XB_TOP], 1u);
            const unsigned tg = og / nx;
            if (og + 1u == (tg + 1u) * nx) xb_add(&bar[XB_TOPGEN], 1u);
            else XB_SPIN(xb_ld(&bar[XB_TOPGEN]) == tg, bar);
            __builtin_amdgcn_fence(__ATOMIC_ACQUIRE, "agent");
            xb_add(&bar[XB_XGEN(b.x)], 1u);
            asm volatile("s_waitcnt vmcnt(0)" ::: "memory");
        } else {
            XB_SPIN(xb_ld(&bar[XB_XGEN(b.x)]) == gen, bar);
            __builtin_amdgcn_fence(__ATOMIC_ACQUIRE, "agent");
            asm volatile("s_waitcnt vmcnt(0)" ::: "memory");
        }
    }
    __syncthreads();
}
__device__ __forceinline__ void xcd_barrier_local(const XcdBarrier& b, bool leader) {
    asm volatile("s_waitcnt vmcnt(0)" ::: "memory");
    __syncthreads();
    if (leader) {
        unsigned* bar = b.bar;
        __builtin_amdgcn_s_waitcnt(0);
        unsigned nloc = b.st[0], nx = b.st[1];
        if (nloc == 0u) { xcd_barrier_complete(bar, b.x, nloc, nx); b.st[0] = nloc; b.st[1] = nx; }
        const unsigned old = xb_add(&bar[XB_XSUB(b.x)], 1u);
        const unsigned gen = old / nloc;
        if (old + 1u == (gen + 1u) * nloc) {
            __builtin_amdgcn_fence(__ATOMIC_ACQUIRE, "agent");
            xb_add(&bar[XB_XGEN(b.x)], 1u);
            asm volatile("s_waitcnt vmcnt(0)" ::: "memory");
        } else {
            XB_SPIN(xb_ld(&bar[XB_XGEN(b.x)]) == gen, bar);
            __builtin_amdgcn_fence(__ATOMIC_ACQUIRE, "agent");
            asm volatile("s_waitcnt vmcnt(0)" ::: "memory");
        }
    }
    __syncthreads();
}

template <int VAR> __device__ __forceinline__ void ph_attn(const P& p, LAS unsigned char* lds, const int wv) {
    char* shm = (char*)lds;
    const bf16* QKV = (const bf16*)(p.ws + WS_BIG);
    bf16* Ob = (bf16*)(p.ws + WS_OMIX); float* SSQO = (float*)(p.ws + WS_SSQO);
    const float* gates = (const float*)(p.ws + WS_GATES);
    const float* Cc = (const float*)(p.ws + WS_C);
    const unsigned long long* SEL = (const unsigned long long*)(p.ws + WS_SEL);
    const int G = gridDim.x, bx = blockIdx.x;
    const int vcu0 = (G == 256) ? (bx % 8) * (G / 8) + bx / 8 : bx;
    int cur_bh = -1;
    for (int i = 0;; ++i) {
        const int L = i * G + vcu0; if (L >= 1024) break;
        const int vcu = L & 255, rnd = L >> 8;
        if (VAR == 0) {
            const int bh = vcu >> 2, s = vcu & 3, qb = rnd == 0 ? s : rnd == 1 ? 7 - s : rnd == 2 ? 8 + s : 15 - s;
            if (bh != cur_bh) {
                cur_bh = bh;
                __syncthreads();
                LAS unsigned* cb = (LAS unsigned*)(lds + att::LDS_CB);
                const int k0_ = opaque_tid(wv);
                float cv_[8];
#pragma unroll
                for (int u = 0; u < 8; ++u) cv_[u] = Cc[(size_t)bh * SEQ + k0_ + 512 * u];
#pragma unroll
                for (int u = 0; u < 8; ++u) { const int k = k0_ + 512 * u; const float v = -cv_[u] * LOG2E;
                    const bf16 h1 = f2bf(v); const float r1 = v - bf2f(h1); const bf16 h2 = f2bf(r1); const float r2 = r1 - bf2f(h2); const bf16 h3 = f2bf(r2);
                    cb[2 * k] = (unsigned)h1 | ((unsigned)h2 << 16); cb[2 * k + 1] = (unsigned)h3; }
                __syncthreads();
            }
            att::attn_unit<0, 8>(bh >> 3, bh & 7, qb, QKV, Ob, gates, Cc, SEL, SSQO, shm, wv, nullptr, nullptr, false);
        } else {
            const int bk = vcu >> 4, s = vcu & 15, blk = rnd == 0 ? s : rnd == 1 ? 31 - s : rnd == 2 ? 32 + s : 63 - s;
            att::attn_unit<VAR, 8>(bk >> 1, bk & 1, blk, QKV, Ob, gates, Cc, SEL, SSQO, shm, wv, nullptr, nullptr, false);
        }
    }
}

__device__ __forceinline__ void ph_cmpsel2(const P& p, LAS unsigned char* lds, const int wv) {
    char* shm = (char*)lds;
    const int G = gridDim.x, bx = blockIdx.x;
    const int vcu0 = (G == 256) ? (bx % 8) * (G / 8) + bx / 8 : bx;
    int cur_bk = -1;
    for (int i = 0;; ++i) {
        const int L = i * G + vcu0; if (L >= 1024) break;
        const int vcu = L & 255, rnd = L >> 8, bk = vcu >> 4, s = vcu & 15, blk = rnd == 0 ? s : rnd == 1 ? 31 - s : rnd == 2 ? 32 + s : 63 - s;
        if (bk != cur_bk) { cur_bk = bk; __syncthreads(); cmpx::load_kv(bk, (const bf16*)(p.ws + WS_KCMP), (const bf16*)(p.ws + WS_VCMP), shm, opaque_tid(wv)); __syncthreads(); }
        cmpx::cmp_unit(bk, blk, (const bf16*)(p.ws + WS_BIG), (const float*)(p.ws + WS_GATES), (bf16*)(p.ws + WS_O), (unsigned long long*)(p.ws + WS_SEL), shm, wv);
    }
}

__device__ __forceinline__ void ph_attn_fs(const P& p, LAS unsigned char* lds, const int wv, const int bx) {
    char* shm = (char*)lds;
    const bf16* QKV = (const bf16*)(p.ws + WS_BIG); bf16* Ob = (bf16*)(p.ws + WS_OMIX); float* SSQO = (float*)(p.ws + WS_SSQO);
    const float* gates = (const float*)(p.ws + WS_GATES); const float* Cc = (const float*)(p.ws + WS_C); const unsigned long long* SEL = (const unsigned long long*)(p.ws + WS_SEL);
    const int vcu = (bx % 8) * 32 + bx / 8;
    const int bh = vcu >> 2, sf = vcu & 3, bk = vcu >> 4, ss = vcu & 15;
    const bf16* fK = QKV + (size_t)(bh >> 3) * SEQ * QP + C_KF + (size_t)(bh & 7) * HS; const bf16* fV = QKV + (size_t)(bh >> 3) * SEQ * QP + C_VF + (size_t)(bh & 7) * HS;
    const bf16* sK = QKV + (size_t)(bk >> 1) * SEQ * QP + C_SK + (size_t)(bk & 1) * HS; const bf16* sV = QKV + (size_t)(bk >> 1) * SEQ * QP + C_SV + (size_t)(bk & 1) * HS;
    { __syncthreads(); cmpx::load_kv(bk, (const bf16*)(p.ws + WS_KCMP), (const bf16*)(p.ws + WS_VCMP), shm, opaque_tid(wv)); __syncthreads();
#pragma unroll 1
      for (int i = 0; i < 4; ++i) { const int blk = i == 0 ? ss : i == 1 ? 31 - ss : i == 2 ? 32 + ss : 63 - ss;
          cmpx::cmp_unit(bk, blk, QKV, gates, (bf16*)(p.ws + WS_O), (unsigned long long*)(p.ws + WS_SEL), shm, wv); }
      __syncthreads(); }
    {
        LAS unsigned* cb = (LAS unsigned*)(lds + att::LDS_CB);
        const int k0_ = opaque_tid(wv);
        float cv_[8];
#pragma unroll
        for (int u = 0; u < 8; ++u) cv_[u] = Cc[(size_t)bh * SEQ + k0_ + 512 * u];
#pragma unroll
        for (int u = 0; u < 8; ++u) { const int k = k0_ + 512 * u; const float v = -cv_[u] * LOG2E;
            const bf16 h1 = f2bf(v); const float r1 = v - bf2f(h1); const bf16 h2 = f2bf(r1); const float r2 = r1 - bf2f(h2); const bf16 h3 = f2bf(r2);
            cb[2 * k] = (unsigned)h1 | ((unsigned)h2 << 16); cb[2 * k + 1] = (unsigned)h3; }
        __syncthreads();
    }
#pragma unroll 1
    for (int i = 0; i < 4; ++i) { const int qb = i == 0 ? sf : i == 1 ? 7 - sf : i == 2 ? 8 + sf : 15 - sf;
        att::attn_unit<0, 8>(bh >> 3, bh & 7, qb, QKV, Ob, gates, Cc, SEL, SSQO, shm, wv, i < 3 ? fK : sK, i < 3 ? fV : sV, i > 0); }
#pragma unroll 1
    for (int i = 0; i < 4; ++i) { const int blk = i == 0 ? ss : i == 1 ? 31 - ss : i == 2 ? 32 + ss : 63 - ss;
        att::attn_unit<1, 8>(bk >> 1, bk & 1, blk, QKV, Ob, gates, Cc, SEL, SSQO, shm, wv, i < 3 ? sK : nullptr, i < 3 ? sV : nullptr, true); }
}

__device__ __forceinline__ void ph_win_queue(const P& p, LAS unsigned char* lds, const int wv) {
    unsigned* qctr = (unsigned*)(p.ws + WS_CTL) + 8192;
    volatile LAS unsigned* qslot = (volatile LAS unsigned*)(lds + LDS_BYTES - 128);
    const bool leader = opaque_tid(wv) == 0;
    for (;;) {
        if (leader) *qslot = __hip_atomic_fetch_add(qctr, 1u, __ATOMIC_RELAXED, __HIP_MEMORY_SCOPE_AGENT);
        __syncthreads();
        const unsigned idx = *qslot;
        __syncthreads();
        if (idx >= 1024u) break;
        const int blk = 63 - (int)(idx >> 4), bk = (int)(idx & 15u);
        att::attn_unit<2, 8>(bk >> 1, bk & 1, blk, (const bf16*)(p.ws + WS_BIG), (bf16*)(p.ws + WS_OMIX), (const float*)(p.ws + WS_GATES), (const float*)(p.ws + WS_C), (const unsigned long long*)(p.ws + WS_SEL), (float*)(p.ws + WS_SSQO), (char*)lds, wv, nullptr, nullptr, false);
    }
}

enum { PH_PREP = 0, PH_G1, PH_G2, PH_G3, PH_CMPR, PH_ATTN, PH_G4, PH_G5, PH_G6, PH_G7, PH_N };

__global__ void __launch_bounds__(512, 2) k_main(P p, int ph_lo, int ph_hi) {
    extern __shared__ __attribute__((aligned(16))) unsigned char lds_raw[];
    using namespace pg8;
    cg::grid_group grid = cg::this_grid();
    const int wv = __builtin_amdgcn_readfirstlane((int)(threadIdx.x >> 6));
    LAS unsigned char* lds = (LAS unsigned char*)lds_raw;
    const int G = gridDim.x, c = blockIdx.x;
    volatile LAS unsigned* MISC = (volatile LAS unsigned*)(lds + LDS_BYTES - 64);
    const bool leader = opaque_tid(wv) == 0;
    if (leader) { MISC[0] = 0u; MISC[1] = 0u; }
    __syncthreads();
    XcdBarrier bar = xcd_barrier_post((unsigned*)(p.ws + WS_CTL) + 4096, MISC, leader);
    __syncthreads();
    const int xrank = __builtin_amdgcn_readfirstlane((int)MISC[2]), xcc = (int)bar.x;
    if (ph_lo < 0) grid.sync();
#define IN(k) (ph_lo <= (k) && (k) < ph_hi)
#define SEAM(k) do { if (IN(k) && IN((k) + 1)) xcd_barrier(bar, leader); } while (0)
#define SEAML(k) do { if (IN(k) && IN((k) + 1)) { if (xl_ok) xcd_barrier_local(bar, leader); else xcd_barrier(bar, leader); } } while (0)
#define WSP(T, off) ((T*)(p.ws + (off)))
    if (IN(PH_PREP)) { ph_prep<0>(p, lds, wv, c, G); } SEAM(PH_PREP);
    bool xl_ok = false;
    int cz = c;
    if (G == 256 && IN(PH_PREP)) { const unsigned* xc = (const unsigned*)(p.ws + WS_CTL) + 4096; bool ok = true;
#pragma unroll
        for (int j = 0; j < 8; ++j) ok = ok && (__hip_atomic_load(xc + XB_XCNT(j), __ATOMIC_RELAXED, __HIP_MEMORY_SCOPE_AGENT) == 32u);
        if (ok) { cz = xrank * 8 + xcc; xl_ok = true; } }
    if (IN(PH_G1)) { Gemm g{WSP(bf16, F8_G1 ? WS_O : WS_XN), WSP(const bf16, WS_WGU1), M, 5632, F8_G1 ? D / 2 : D}; StaticOrder S; S.init(M, 5632, G, cz); EpiSwiglu<false, F8_G2> E{WSP(bf16, WS_BIG), nullptr, nullptr};
        gemm_phase<EpiSwiglu<false, F8_G2>, StaticOrder, true, true, F8_G1>(lds, g, S, E, wv); } SEAML(PH_G1);
    if (IN(PH_G2)) { Gemm g{WSP(bf16, WS_BIG), WSP(const bf16, WS_WD1), M, D, F8_G2 ? DFF / 2 : DFF, 128, HS * 2, 0}; StaticOrder S; S.init(M, D, G, cz, 1); EpiResid<true> E{p.in[0], WSP(bf16, WS_XN), WSP(float, WS_SSQ1), 0.5f};
        gemm_phase<EpiResid<true>, StaticOrder, true, true, F8_G2>(lds, g, S, E, wv); } SEAML(PH_G2);
    if (IN(PH_G3)) { Gemm g{WSP(bf16, WS_XN), WSP(const bf16, WS_WIN), M, 3072, D}; StaticOrder S; S.init(M, 3072, G, cz);
        EpiQKV E{WSP(bf16, WS_BIG), WSP(float, WS_GATES), WSP(float, WS_LOGF), WSP(float, WS_SSQ1), WSP(const float, WS_ROPE), p.in[9], p.in[11], p.in[12], p.in[19], p.in[20], p.in[8]};
        gemm_phase<EpiQKV, StaticOrder, true, true>(lds, g, S, E, wv); } SEAM(PH_G3);
    if (IN(PH_CMPR)) { { Gemm g{WSP(bf16, WS_BIG), WSP(const bf16, WS_WC1), 4096, 512, 2048, 16 * QP * 2, QP * 2, 1}; StaticOrder S; S.init(4096, 512, G, cz);
          float* posb = WSP(float, WS_POSBS) + (size_t)c * 512;
          { if (cz < 32) { const int t_ = opaque_tid(wv);
                const float* pp = WSP(const float, WS_POSBP) + (size_t)(t_ >> 8) * 64 * 256 + (t_ & 255); float s_ = 0.f;
#pragma unroll 8
              for (int q = 0; q < 64; ++q) s_ += pp[q * 256];
              posb[t_] = s_; } __syncthreads(); }
          EpiCompress E{posb, WSP(const bf16, WS_WC2), p.in[10], WSP(bf16, WS_KCMP), WSP(bf16, WS_VCMP)};
          gemm_phase<EpiCompress, StaticOrder, false, true>(lds, g, S, E, wv); }
        ph_cumsum(p, cz, G, wv);
        if (G == 256) { if (cz >= 32 && cz < 248) ph_prep<1>(p, lds, wv, cz - 32, 216); } else ph_prep<1>(p, lds, wv, cz, G);
        __syncthreads();
        ph_win_queue(p, lds, wv); } SEAM(PH_CMPR);
    if (IN(PH_ATTN)) { if (G == 256) ph_attn_fs(p, lds, wv, cz); else { ph_cmpsel2(p, lds, wv); xcd_barrier(bar, leader); ph_attn<0>(p, lds, wv); ph_attn<1>(p, lds, wv); } } SEAML(PH_ATTN);
    if (IN(PH_G4)) { Gemm g{WSP(bf16, WS_OMIX), WSP(const bf16, WS_WOUT), M, D, D}; StaticOrder S; S.init(M, D, G, cz); EpiResidNorm<F8_G5> E{WSP(const bf16, WS_XN), WSP(bf16, WS_O), WSP(float, WS_SSQ2), WSP(const float, WS_SSQO), p.ws + WS_H2F8};
        gemm_phase<EpiResidNorm<F8_G5>, StaticOrder, true, true>(lds, g, S, E, wv); } SEAML(PH_G4);
    if (IN(PH_G5)) { Gemm g{WSP(bf16, F8_G5 ? WS_H2F8 : WS_O), WSP(const bf16, WS_WGU2), M, 5632, F8_G5 ? D / 2 : D}; StaticOrder S; S.init(M, 5632, G, cz, 1); EpiSwiglu<true, F8_G6> E{WSP(bf16, WS_BIG), WSP(float, WS_SSQ2), (LDSF*)(lds + RING_BYTES)};
        { if (opaque_tid(wv) < 8) ((LDSI*)(lds + RING_BYTES) + 1024)[opaque_tid(wv)] = -1; __syncthreads(); }
        gemm_phase<EpiSwiglu<true, F8_G6>, StaticOrder, true, true, F8_G5>(lds, g, S, E, wv); } SEAML(PH_G5);
    if (IN(PH_G6)) { Gemm g{WSP(bf16, WS_BIG), WSP(const bf16, WS_WD2), M, D, F8_G6 ? DFF / 2 : DFF, 128, HS * 2, 0}; StaticOrder S; S.init(M, D, G, cz); EpiResid<false, F8_G7> E{WSP(const bf16, WS_O), WSP(bf16, WS_XN), WSP(float, WS_SSQ3), 0.5f};
        gemm_phase<EpiResid<false, F8_G7>, StaticOrder, true, true, F8_G6>(lds, g, S, E, wv);
        { Gemm g2{WSP(const bf16, WS_PB), WSP(const bf16, WS_WPROJ), M, D, DPLE}; StaticOrder S2; S2.init(M, D, G, cz); EpiE E2{WSP(bf16, WS_E), WSP(float, WS_SSQE), p.in[31]};
          gemm_phase<EpiE, StaticOrder, true, true>(lds, g2, S2, E2, wv); } } SEAML(PH_G6);
    if (IN(PH_G7)) { Gemm g{WSP(bf16, F8_G7 ? WS_H2F8 : WS_XN), WSP(const bf16, WS_WGATE), M, D, F8_G7 ? D / 2 : D}; StaticOrder S; S.init(M, D, G, cz, 1); EpiPle E{p.out, WSP(const bf16, WS_XN), WSP(const bf16, WS_E), WSP(float, WS_SSQ3), WSP(float, WS_SSQE)};
        gemm_phase<EpiPle, StaticOrder, true, true, F8_G7>(lds, g, S, E, wv); }
#undef IN
#undef SEAML
#undef SEAM
#undef WSP
}

#ifndef ONE_LAUNCH
#define ONE_LAUNCH 1
#endif
extern "C" void kernel_launch(void* const* d_in, const int* in_sizes, int n_in, void* d_out, int out_size, void* d_ws, size_t ws_size, hipStream_t stream) {
    static int grid = 0;
    if (grid == 0) {
        if (n_in != 32 || out_size != M * D || ws_size < WS_END) { fprintf(stderr, "kernel_launch: unexpected sizes n_in %d out %d ws %zu\n", n_in, out_size, ws_size); grid = -1; return; }
        int dev = 0, cus = 0, per_cu = 0;
        (void)hipGetDevice(&dev); (void)hipDeviceGetAttribute(&cus, hipDeviceAttributeMultiprocessorCount, dev);
        if (hipFuncSetAttribute((const void*)k_main, hipFuncAttributeMaxDynamicSharedMemorySize, LDS_BYTES) != hipSuccess) { fprintf(stderr, "hipFuncSetAttribute failed\n"); grid = -1; return; }
        if (hipOccupancyMaxActiveBlocksPerMultiprocessor(&per_cu, (const void*)k_main, 512, LDS_BYTES) != hipSuccess || per_cu < 1) { fprintf(stderr, "occupancy query: %d blocks per CU\n", per_cu); }
        (void)hipGetLastError();
        grid = cus;
    }
    if (grid < 0) return;
    P p{};
    for (int i = 0; i < 32; ++i) p.in[i] = (const float*)d_in[i];
    p.out = (float*)d_out; p.ws = (unsigned char*)d_ws;
    { const double rc[12] = {1.0, 0.19392274474868576, 0.03760603093086393, 0.007292664737217109, 0.001414213562373095, 0.0002742481756762073, 5.318295896944988e-05, 1.031338537721246e-05,
                             0.6366197723675814, 1.5707963267948966, 6.123233995736766e-17, 0.0};
      for (int i = 0; i < 12; ++i) p.rc[i] = rc[i]; }
    (void)hipMemsetAsync((char*)d_ws + WS_CTL, 0, 64 * 1024, stream);
#if ONE_LAUNCH
    int lo = 0, hi = PH_N;
    void* args[] = {&p, &lo, &hi};
    hipError_t e = hipLaunchCooperativeKernel((const void*)k_main, dim3(grid), dim3(512), args, LDS_BYTES, stream);
    if (e != hipSuccess) fprintf(stderr, "cooperative launch failed: %s (grid %d)\n", hipGetErrorString(e), grid);
#else
    for (int ph = 0; ph < PH_N; ++ph) hipLaunchKernelGGL(k_main, dim3(grid), dim3(512), LDS_BYTES, stream, p, ph, ph + 1);
#endif
}
```

```cpp
#include <hip/hip_runtime.h>
#include <hip/hip_cooperative_groups.h>
#include <cstdint>
#include <cstdio>
namespace cg = cooperative_groups;

typedef unsigned short bf16;
constexpr int BATCH = 8, SEQ = 4096, M = BATCH * SEQ, D = 1024, DFF = 2816, INW = 2848, DPLE = 256;
constexpr int QP = 64;
constexpr int HS = M * 64;
constexpr float EPS = 1e-6f;
constexpr float C2 = 0.125f * 1.4426950408889634f;
constexpr float LOG2E = 1.4426950408889634f;
constexpr int C_QA = 0, C_CK = 8 * HS, C_CV = 10 * HS, C_SK = 12 * HS, C_SV = 14 * HS, C_WK = 16 * HS, C_WV = 18 * HS, C_QF = 20 * HS, C_KF = 28 * HS, C_VF = 36 * HS;

constexpr size_t MiB = 1u << 20;
constexpr size_t WS_CTL = 0;
constexpr size_t WS_WGU1 = 2 * MiB, WS_WD1 = 13 * MiB, WS_WIN = 19 * MiB, WS_WOUT = 25 * MiB, WS_WGU2 = 27 * MiB, WS_WD2 = 38 * MiB, WS_WGATE = 44 * MiB, WS_WPROJ = 46 * MiB;
constexpr size_t WS_WC1 = 47 * MiB, WS_WC2 = 49 * MiB, WS_POSBP = 49 * MiB + 512 * 1024;
constexpr size_t WS_KCMP = 50 * MiB, WS_VCMP = 51 * MiB, WS_C = 52 * MiB, WS_GATES = 53 * MiB, WS_LOGF = 56 * MiB, WS_ROPE = 57 * MiB;
constexpr size_t WS_SSQ1 = 58 * MiB, WS_SSQ2 = 60 * MiB, WS_SSQ3 = 62 * MiB, WS_SSQE = 64 * MiB, WS_SEL = 66 * MiB;
constexpr size_t WS_POSBS = 66 * MiB + 512 * 1024;
constexpr size_t WS_SSQO = 67 * MiB;
constexpr size_t WS_GOUT = 49 * MiB + 768 * 1024;
constexpr size_t WS_PB = 70 * MiB;
constexpr size_t WS_XN = 88 * MiB;
constexpr size_t WS_O = 152 * MiB;
constexpr size_t WS_BIG = 216 * MiB;
constexpr size_t WS_E = 408 * MiB;
constexpr size_t WS_OMIX = WS_E;
constexpr size_t WS_H2F8 = 472 * MiB;
constexpr size_t WS_END = 504 * MiB;
constexpr bool F8_G1 = true, F8_G2 = true, F8_G5 = true, F8_G6 = true, F8_G7 = true;

struct P {
    const float* in[32];
    float* out;
    unsigned char* ws;
    double rc[12];
};

__device__ __forceinline__ int opaque_tid(int wv) { int l; asm volatile("v_mbcnt_lo_u32_b32 %0, -1, 0\n\tv_mbcnt_hi_u32_b32 %0, -1, %0" : "=v"(l)); return (wv << 6) | l; }

__device__ __forceinline__ float bf2f(bf16 v) { return __uint_as_float((unsigned)v << 16); }
__device__ __forceinline__ bf16 f2bf(float f) { unsigned u = __float_as_uint(f); return (bf16)((u + 0x7fffu + ((u >> 16) & 1u)) >> 16); }
__device__ __forceinline__ float wave_sum(float v) {
#pragma unroll
    for (int o = 1; o < 64; o <<= 1) v += __shfl_xor(v, o);
    return v;
}
__device__ __forceinline__ float wave_max(float v) {
#pragma unroll
    for (int o = 1; o < 64; o <<= 1) v = fmaxf(v, __shfl_xor(v, o));
    return v;
}
__device__ __forceinline__ float sigmoidf_(float x) { return 1.f / (1.f + __expf(-x)); }
__device__ __forceinline__ float siluf_(float x) { return x / (1.f + __expf(-x)); }

__device__ __forceinline__ void ph_cumsum(const P& p, int bid, int nb, const int wv) {
    const float* logf_ = (const float*)(p.ws + WS_LOGF);
    float* C = (float*)(p.ws + WS_C);
    const int tid = opaque_tid(wv), lane = tid & 63, w = tid >> 6;
    for (int item = (nb - 1 - bid) * 8 + w; item < BATCH * 8; item += nb * 8) {
        const int b = item >> 3, h = item & 7;
        float carry = 0.f;
        for (int t0 = 0; t0 < SEQ; t0 += 256) {
            float v[4];
#pragma unroll
            for (int u = 0; u < 4; ++u) v[u] = logf_[(size_t)(b * SEQ + t0 + 64 * u + lane) * 8 + h];
#pragma unroll
            for (int u = 0; u < 4; ++u) {
#pragma unroll
                for (int o = 1; o < 64; o <<= 1) { const float x = __shfl_up(v[u], o); if (lane >= o) v[u] += x; }
                v[u] += carry;
                C[(size_t)item * SEQ + t0 + 64 * u + lane] = v[u];
                carry = __shfl(v[u], 63);
            }
        }
    }
}
namespace pg8 {
#define PG8_LAS __attribute__((address_space(3)))
typedef unsigned short bf16_t;
typedef short bf16x8 __attribute__((ext_vector_type(8)));
typedef float f32x4 __attribute__((ext_vector_type(4)));
typedef unsigned u32x4 __attribute__((ext_vector_type(4)));
constexpr int BM = 256, BK = 64, HALF = 128, HTB = HALF * BK * 2  , STAGE_BYTES = 8 * HTB, NXCD = 8, WGM = 8;

__host__ __device__ __forceinline__ int lds_byte(int r, int c) { const int st = (r >> 4) * 2 + (c >> 5), rr = r & 15, cc = c & 31, ob = rr * 64 + cc * 2; return st * 1024 + (ob ^ (((ob >> 9) & 1) << 5)); }
__host__ __device__ __forceinline__ void stage_rc(int b, int& R, int& C) { const int st = b / 1024, sb = b % 1024, swz = sb ^ (((sb >> 9) & 1) << 5); R = (st >> 1) * 16 + swz / 64; C = (st & 1) * 32 + (swz % 64) / 2; }
__host__ __device__ __forceinline__ int perm32(int rho) { const int n = rho >> 4, i = rho & 15; return 8 * (i >> 2) + 4 * n + (i & 3); }

struct Unit { int pm, pn; };
struct Gemm { const bf16_t* A; const bf16_t* Bt; int M, N, K; int rsA = 0, ksA = BK * 2, amode = 0; };
__device__ __forceinline__ const char* a_tile(const Gemm& g, const Unit& u) {
    if (g.amode == 0) return (const char*)g.A + (size_t)u.pm * BM * (g.rsA ? (size_t)g.rsA : (size_t)g.K * 2);
    const int b = u.pm >> 1, kvh = u.pm & 1;
    return (const char*)g.A + ((size_t)((u.pn ? 10 : 8) + kvh) * (32768 * 64) + (size_t)b * 4096 * 64) * 2;
}

struct StaticOrder {
    int nM, nN, nwg, G, c, rev;
    int q, nig, inv, fast;
    __host__ __device__ void init(int M, int N, int G_, int c_, int rev_ = 0) { nM = M / BM; nN = N / BM; nwg = nM * nN; G = G_; c = c_; rev = rev_;
        q = nwg / NXCD; nig = WGM * nN; inv = (1 << 20) / nig + 1; fast = (nwg % NXCD == 0) && (nM % WGM == 0) && NXCD == 8 && WGM == 8 && nwg <= 4096 && nig <= 256; }
    __host__ __device__ bool next(int i, Unit& u) const {
        const long L = (long)i * G + c; if (L >= nwg) return false;
        int wgid = (int)L;
        if (fast) { const int xcd = wgid & 7; int off = wgid >> 3; if (rev) off = q - 1 - off; wgid = xcd * q + off;
            const int gid = (int)(((unsigned)wgid * (unsigned)inv) >> 20), rem = wgid - gid * nig; u.pm = gid * 8 + (rem & 7); u.pn = rem >> 3; return true; }
        { const int q_ = nwg / NXCD, r = nwg % NXCD, xcd = wgid % NXCD; int off = wgid / NXCD; if (rev && r == 0) off = q_ - 1 - off; wgid = (xcd < r ? xcd * (q_ + 1) : r * (q_ + 1) + (xcd - r) * q_) + off; }
        const int nig_ = WGM * nN, gid = wgid / nig_, fm = gid * WGM, gsz = (nM - fm) < WGM ? (nM - fm) : WGM;
        u.pm = fm + ((wgid % nig_) % gsz); u.pn = (wgid % nig_) / gsz; return true;
    }
    __device__ __forceinline__ void a_ready(const Unit&) const {}
    __device__ __forceinline__ void done(const Unit&) const {}
};

__device__ __forceinline__ unsigned cvt_pk_bf16(float lo, float hi) { unsigned r; asm volatile("v_cvt_pk_bf16_f32 %0, %1, %2" : "=v"(r) : "v"(lo), "v"(hi)); return r; }
__device__ __forceinline__ float hsum4(const f32x4 a) { return (a[0] + a[1]) + (a[2] + a[3]); }
__device__ __forceinline__ float sum_rows4(float x) {
    auto a = __builtin_amdgcn_permlane16_swap(__float_as_uint(x), __float_as_uint(x), false, false); const float s = __uint_as_float(a[0]) + __uint_as_float(a[1]);
    auto b = __builtin_amdgcn_permlane32_swap(__float_as_uint(s), __float_as_uint(s), false, false); return __uint_as_float(b[0]) + __uint_as_float(b[1]); }
__device__ __forceinline__ float xor16(float x, int fq) { auto a = __builtin_amdgcn_permlane16_swap(__float_as_uint(x), __float_as_uint(x), false, false); return __uint_as_float((fq & 1) ? a[0] : a[1]); }
__device__ __forceinline__ float rstd16(const float* ssq, int row, float invn) {
    const f32x4* s = (const f32x4*)(ssq + (size_t)row * 16);
    const float t = (hsum4(s[0]) + hsum4(s[1])) + (hsum4(s[2]) + hsum4(s[3]));
    return __builtin_amdgcn_rsqf(t * invn + 1e-6f);
}
__device__ __forceinline__ f32x4 ssq_part(const float* ssq, int row, int fq) { return *((const f32x4*)(ssq + (size_t)row * 16) + fq); }
__device__ __forceinline__ float rstd_fin(const f32x4 s, float invn) { return __builtin_amdgcn_rsqf(sum_rows4(hsum4(s)) * invn + 1e-6f); }
__device__ __forceinline__ float xor32(float x, int fq) { auto a = __builtin_amdgcn_permlane32_swap(__float_as_uint(x), __float_as_uint(x), false, false); return __uint_as_float((fq & 2) ? a[0] : a[1]); }
__device__ __forceinline__ f32x4 sigmoid4(const f32x4 x) { f32x4 r;
#pragma unroll
    for (int e = 0; e < 4; ++e) r[e] = __builtin_amdgcn_rcpf(1.0f + __builtin_amdgcn_exp2f(-1.4426950408889634f * x[e]));
    return r; }
__device__ __forceinline__ u32x4 pack8(const f32x4 a, const f32x4 b) { u32x4 w; w.x = cvt_pk_bf16(a[0], a[1]); w.y = cvt_pk_bf16(a[2], a[3]); w.z = cvt_pk_bf16(b[0], b[1]); w.w = cvt_pk_bf16(b[2], b[3]); return w; }
__device__ __forceinline__ void unpack8(const u32x4 w, f32x4& a, f32x4& b) {
    a[0] = __uint_as_float(w.x << 16); a[1] = __uint_as_float(w.x & 0xffff0000u); a[2] = __uint_as_float(w.y << 16); a[3] = __uint_as_float(w.y & 0xffff0000u);
    b[0] = __uint_as_float(w.z << 16); b[1] = __uint_as_float(w.z & 0xffff0000u); b[2] = __uint_as_float(w.w << 16); b[3] = __uint_as_float(w.w & 0xffff0000u); }

typedef __attribute__((address_space(3))) float LDSF; typedef __attribute__((address_space(3))) int LDSI; typedef __attribute__((address_space(3))) f32x4 LDSV4;
template <bool HAS_SSQ, bool F8OUT = false, bool W32 = false> struct EpiSwiglu {
    static constexpr bool PERM = true, AFTER_DRAIN = false, MIDSCALE = false;
    bf16_t* H; const float* ssq; LDSF* cache;
    __device__ __forceinline__ void operator()(const f32x4 (&acc)[2][2][4][2], const Unit& u, int wr, int wc, int fr, int fq) const {
        const int row0 = u.pm * BM + wr * 64 + fr, col0 = u.pn * 128 + wc * 32 + 8 * fq;
        float rr[2][4];
        if (HAS_SSQ) {
            LDSF* cw = cache + (wr * 4 + wc) * 128 + fr * 8; LDSI* tag = (LDSI*)(cache + 1024) + (wr * 4 + wc);
            const int have = __builtin_amdgcn_readfirstlane(*tag);
            if (have == u.pm) {
                const f32x4 c0 = *(const LDSV4*)cw, c1 = *(const LDSV4*)(cw + 4);
#pragma unroll
                for (int m = 0; m < 4; ++m) { rr[0][m] = c0[m]; rr[1][m] = c1[m]; }
            } else { f32x4 sp[2][4];
#pragma unroll
                for (int ai = 0; ai < 2; ++ai)
#pragma unroll
                    for (int m = 0; m < 4; ++m) sp[ai][m] = ssq_part(ssq, row0 + ai * HALF + m * 16, fq);
#pragma unroll
                for (int ai = 0; ai < 2; ++ai)
#pragma unroll
                    for (int m = 0; m < 4; ++m) rr[ai][m] = rstd_fin(sp[ai][m], 1.f / 1024.f);
                if (fq == 0) { *(LDSV4*)cw = (f32x4){rr[0][0], rr[0][1], rr[0][2], rr[0][3]}; *(LDSV4*)(cw + 4) = (f32x4){rr[1][0], rr[1][1], rr[1][2], rr[1][3]}; }
                *tag = u.pm; } }
#pragma unroll
        for (int ai = 0; ai < 2; ++ai)
#pragma unroll
            for (int m = 0; m < 4; ++m) { const int row = row0 + ai * HALF + m * 16;
                const float r = HAS_SSQ ? rr[ai][m] : 1.f, k1 = -1.4426950408889634f * r * (W32 ? 0.03125f : 1.f), r2 = r * r * ((W32 && HAS_SSQ) ? (1.f / 1024.f) : 1.f);
                f32x4 o[2];
#pragma unroll
                for (int n = 0; n < 2; ++n) {
                    const f32x4 g4 = acc[ai][0][m][n], u4 = acc[ai][1][m][n], x4 = g4 * k1;
                    f32x4 e4;
#pragma unroll
                    for (int e2 = 0; e2 < 4; ++e2) e4[e2] = __builtin_amdgcn_exp2f(x4[e2]);
                    const f32x4 d4 = (W32 && !HAS_SSQ) ? e4 * 1024.f + 1024.f : e4 + 1.0f; f32x4 rc4;
#pragma unroll
                    for (int e2 = 0; e2 < 4; ++e2) rc4[e2] = __builtin_amdgcn_rcpf(d4[e2]);
                    f32x4 t4 = g4 * u4; if (HAS_SSQ) t4 = t4 * r2;
                    o[n] = t4 * rc4; }
                if constexpr (F8OUT) { int w0 = __builtin_amdgcn_cvt_pk_fp8_f32(o[0][0], o[0][1], 0, false); w0 = __builtin_amdgcn_cvt_pk_fp8_f32(o[0][2], o[0][3], w0, true);
                    int w1 = __builtin_amdgcn_cvt_pk_fp8_f32(o[1][0], o[1][1], 0, false); w1 = __builtin_amdgcn_cvt_pk_fp8_f32(o[1][2], o[1][3], w1, true);
                    *(unsigned long long*)((unsigned char*)H + (size_t)(col0 >> 7) * (32768 * 128) + (size_t)row * 128 + (col0 & 127)) = (unsigned long long)(unsigned)w0 | ((unsigned long long)(unsigned)w1 << 32); }
                else *(u32x4*)(H + (size_t)(col0 >> 6) * (32768 * 64) + (size_t)row * 64 + (col0 & 63)) = pack8(o[0], o[1]); }
    }
};
template <bool RES_F32, bool F8C = false> struct EpiResid {
    static constexpr bool PERM = true, AFTER_DRAIN = false, MIDSCALE = false;
    const void* res; bf16_t* xb; float* ssq; float alpha;
    __device__ __forceinline__ void operator()(const f32x4 (&acc)[2][2][4][2], const Unit& u, int wr, int wc, int fr, int fq) const {
        const int row0 = u.pm * BM + wr * 64 + fr, col0 = u.pn * BM + wc * 32 + 8 * fq;
        if constexpr (!RES_F32) {
            u32x4 rb[2][2][2];
#define PG8_BLOAD(g, buf) do { _Pragma("unroll") for (int mm = 0; mm < 2; ++mm) _Pragma("unroll") for (int bj = 0; bj < 2; ++bj) \
                rb[buf][mm][bj] = *(const u32x4*)((const bf16_t*)res + (size_t)(row0 + ((g) >> 1) * HALF + (((g) & 1) * 2 + mm) * 16) * 1024 + col0 + bj * HALF); } while (0)
            PG8_BLOAD(0, 0);
#pragma unroll
            for (int g = 0; g < 4; ++g) { const int ai = g >> 1;
                if (g + 1 < 4) PG8_BLOAD(g + 1, (g + 1) & 1);
#pragma unroll
                for (int mm = 0; mm < 2; ++mm) { const int m = (g & 1) * 2 + mm, row = row0 + ai * HALF + m * 16; float ss = 0.f;
#pragma unroll
                    for (int bj = 0; bj < 2; ++bj) { const size_t off = (size_t)row * 1024 + col0 + bj * HALF;
                        f32x4 r0, r1; unpack8(rb[g & 1][mm][bj], r0, r1);
                        const f32x4 o0 = r0 + alpha * acc[ai][bj][m][0], o1 = r1 + alpha * acc[ai][bj][m][1];
                        *(u32x4*)(xb + off) = pack8(o0, o1);
                        if constexpr (F8C) { int w0 = __builtin_amdgcn_cvt_pk_fp8_f32(o0[0], o0[1], 0, false); w0 = __builtin_amdgcn_cvt_pk_fp8_f32(o0[2], o0[3], w0, true);
                            int w1 = __builtin_amdgcn_cvt_pk_fp8_f32(o1[0], o1[1], 0, false); w1 = __builtin_amdgcn_cvt_pk_fp8_f32(o1[2], o1[3], w1, true);
                            *((unsigned long long*)((unsigned char*)xb + ((long)WS_H2F8 - (long)WS_XN) + off)) = (unsigned long long)(unsigned)w0 | ((unsigned long long)(unsigned)w1 << 32); }
                        ss += hsum4(o0 * o0) + hsum4(o1 * o1); }
                    ss = sum_rows4(ss);
                    if (fq == 0) ssq[(size_t)row * 16 + u.pn * 4 + wc] = ss; } }
#undef PG8_BLOAD
        } else {
            f32x4 rf[2][2][2][2];
#define PG8_RLOAD(g, buf) do { _Pragma("unroll") for (int mm = 0; mm < 2; ++mm) _Pragma("unroll") for (int bj = 0; bj < 2; ++bj) { \
                const float* rp_ = (const float*)res + (size_t)(row0 + ((g) >> 1) * HALF + (((g) & 1) * 2 + mm) * 16) * 1024 + col0 + bj * HALF; \
                rf[buf][mm][bj][0] = *(const f32x4*)rp_; rf[buf][mm][bj][1] = *(const f32x4*)(rp_ + 4); } } while (0)
            PG8_RLOAD(0, 0);
#pragma unroll
            for (int g = 0; g < 4; ++g) { const int ai = g >> 1;
                if (g + 1 < 4) PG8_RLOAD(g + 1, (g + 1) & 1);
#pragma unroll
                for (int mm = 0; mm < 2; ++mm) { const int m = (g & 1) * 2 + mm, row = row0 + ai * HALF + m * 16; float ss = 0.f;
#pragma unroll
                    for (int bj = 0; bj < 2; ++bj) { const size_t off = (size_t)row * 1024 + col0 + bj * HALF;
                        const f32x4 o0 = rf[g & 1][mm][bj][0] + alpha * acc[ai][bj][m][0], o1 = rf[g & 1][mm][bj][1] + alpha * acc[ai][bj][m][1];
                        *(u32x4*)(xb + off) = pack8(o0, o1);
                        ss += hsum4(o0 * o0) + hsum4(o1 * o1); }
                    ss = sum_rows4(ss);
                    if (fq == 0) ssq[(size_t)row * 16 + u.pn * 4 + wc] = ss; } }
#undef PG8_RLOAD
        }
    }
};
template <bool F8C = false> struct EpiResidNorm {
    static constexpr bool PERM = true, AFTER_DRAIN = false, MIDSCALE = true;
    const bf16_t* res; bf16_t* xb; float* ssq; const float* ssqo; unsigned char* h8;
    __device__ __forceinline__ void rarb_fin(const f32x4 s, int fq, float& ra, float& rb) const {
        const float t = hsum4(s), t2 = t + xor16(t, fq), o2 = xor32(t2, fq);
        const float sa = (fq & 2) ? o2 : t2, sb = (fq & 2) ? t2 : o2;
        ra = __builtin_amdgcn_rsqf(sa * (1.f / 512.f) + 1e-6f); rb = __builtin_amdgcn_rsqf(sb * (1.f / 512.f) + 1e-6f); }
    __device__ __forceinline__ void midscale(f32x4 (&acc)[2][2][4][2], const Unit& u, int wr, int fr, int fq) const {
        const int row0 = u.pm * BM + wr * 64 + fr;
#pragma unroll
        for (int ai = 0; ai < 2; ++ai)
#pragma unroll
          for (int mh = 0; mh < 4; mh += 2) { f32x4 sp[2];
#pragma unroll
            for (int mm = 0; mm < 2; ++mm) sp[mm] = ssq_part(ssqo, row0 + ai * HALF + (mh + mm) * 16, fq);
#pragma unroll
            for (int mm = 0; mm < 2; ++mm) { const int m = mh + mm; float ra, rb; rarb_fin(sp[mm], fq, ra, rb); const float f = ra * __builtin_amdgcn_rcpf(rb);
#pragma unroll
                for (int bj = 0; bj < 2; ++bj)
#pragma unroll
                    for (int n = 0; n < 2; ++n) acc[ai][bj][m][n] = acc[ai][bj][m][n] * f; }
            asm volatile("" ::: "memory"); }
    }
    __device__ __forceinline__ void operator()(const f32x4 (&acc)[2][2][4][2], const Unit& u, int wr, int wc, int fr, int fq) const {
        const int row0 = u.pm * BM + wr * 64 + fr, col0 = u.pn * BM + wc * 32 + 8 * fq;
        u32x4 rbv[2][2][2]; float rbs[2][4];
#define PG8_NLOAD(g, buf) do { _Pragma("unroll") for (int mm = 0; mm < 2; ++mm) _Pragma("unroll") for (int bj = 0; bj < 2; ++bj) \
            rbv[buf][mm][bj] = *(const u32x4*)(res + (size_t)(row0 + ((g) >> 1) * HALF + (((g) & 1) * 2 + mm) * 16) * 1024 + col0 + bj * HALF); } while (0)
        { f32x4 sp[2][4];
#pragma unroll
          for (int ai = 0; ai < 2; ++ai)
#pragma unroll
              for (int m = 0; m < 4; ++m) sp[ai][m] = ssq_part(ssqo, row0 + ai * HALF + m * 16, fq);
          PG8_NLOAD(0, 0);
#pragma unroll
          for (int ai = 0; ai < 2; ++ai)
#pragma unroll
              for (int m = 0; m < 4; ++m) { float ra; rarb_fin(sp[ai][m], fq, ra, rbs[ai][m]); } }
#pragma unroll
        for (int g = 0; g < 4; ++g) { const int ai = g >> 1;
            if (g + 1 < 4) PG8_NLOAD(g + 1, (g + 1) & 1);
#pragma unroll
            for (int mm = 0; mm < 2; ++mm) { const int m = (g & 1) * 2 + mm, row = row0 + ai * HALF + m * 16; float ss = 0.f;
#pragma unroll
                for (int bj = 0; bj < 2; ++bj) { const size_t off = (size_t)row * 1024 + col0 + bj * HALF;
                    f32x4 r0, r1; unpack8(rbv[g & 1][mm][bj], r0, r1);
                    const f32x4 o0 = r0 + rbs[ai][m] * acc[ai][bj][m][0], o1 = r1 + rbs[ai][m] * acc[ai][bj][m][1];
                    *(u32x4*)(xb + off) = pack8(o0, o1);
                    if constexpr (F8C) { int w0 = __builtin_amdgcn_cvt_pk_fp8_f32(o0[0], o0[1], 0, false); w0 = __builtin_amdgcn_cvt_pk_fp8_f32(o0[2], o0[3], w0, true);
                        int w1 = __builtin_amdgcn_cvt_pk_fp8_f32(o1[0], o1[1], 0, false); w1 = __builtin_amdgcn_cvt_pk_fp8_f32(o1[2], o1[3], w1, true);
                        *(unsigned long long*)(h8 + off) = (unsigned long long)(unsigned)w0 | ((unsigned long long)(unsigned)w1 << 32); }
                    ss += hsum4(o0 * o0) + hsum4(o1 * o1); }
                ss = sum_rows4(ss);
                if (fq == 0) ssq[(size_t)row * 16 + u.pn * 4 + wc] = ss; } }
#undef PG8_NLOAD
    }
};
struct EpiE {
    static constexpr bool PERM = true, AFTER_DRAIN = false, MIDSCALE = false;
    bf16_t* E; float* ssq; const float* ge;
    __device__ __forceinline__ void operator()(const f32x4 (&acc)[2][2][4][2], const Unit& u, int wr, int wc, int fr, int fq) const {
        const int row0 = u.pm * BM + wr * 64 + fr, col0 = u.pn * BM + wc * 32 + 8 * fq;
        f32x4 gv[2][2];
#pragma unroll
        for (int bj = 0; bj < 2; ++bj) { gv[bj][0] = *(const f32x4*)(ge + col0 + bj * HALF); gv[bj][1] = *(const f32x4*)(ge + col0 + bj * HALF + 4); }
#pragma unroll
        for (int ai = 0; ai < 2; ++ai)
#pragma unroll
            for (int m = 0; m < 4; ++m) { const int row = row0 + ai * HALF + m * 16; float ss = 0.f;
#pragma unroll
                for (int bj = 0; bj < 2; ++bj) { const size_t off = (size_t)row * 1024 + col0 + bj * HALF; const f32x4 o0 = acc[ai][bj][m][0], o1 = acc[ai][bj][m][1];
                    *(u32x4*)(E + off) = pack8(o0 * gv[bj][0], o1 * gv[bj][1]); ss += hsum4(o0 * o0) + hsum4(o1 * o1); }
                ss = sum_rows4(ss);
                if (fq == 0) ssq[(size_t)row * 16 + u.pn * 4 + wc] = ss; }
    }
};
struct EpiPle {
    static constexpr bool PERM = true, AFTER_DRAIN = false, MIDSCALE = false;
    float* out; const bf16_t* hb; const bf16_t* E; const float* ssq3; const float* ssqe;
    __device__ __forceinline__ void operator()(const f32x4 (&acc)[2][2][4][2], const Unit& u, int wr, int wc, int fr, int fq) const {
        const int row0 = u.pm * BM + wr * 64 + fr, col0 = u.pn * BM + wc * 32 + 8 * fq;
        float r3[2][4], re[2][4];
        { f32x4 s3[2][4], se[2][4];
#pragma unroll
          for (int ai = 0; ai < 2; ++ai)
#pragma unroll
              for (int m = 0; m < 4; ++m) { s3[ai][m] = ssq_part(ssq3, row0 + ai * HALF + m * 16, fq); se[ai][m] = ssq_part(ssqe, row0 + ai * HALF + m * 16, fq); }
#pragma unroll
          for (int ai = 0; ai < 2; ++ai)
#pragma unroll
              for (int m = 0; m < 4; ++m) { r3[ai][m] = rstd_fin(s3[ai][m], 1.f / 1024.f) * (F8_G7 ? 0.03125f : 1.f); re[ai][m] = rstd_fin(se[ai][m], 1.f / 1024.f); } }
        u32x4 eb[2][2][2], hh[2][2][2];
#define PG8_PLOAD(g, buf) do { _Pragma("unroll") for (int mm = 0; mm < 2; ++mm) _Pragma("unroll") for (int bj = 0; bj < 2; ++bj) { \
            const size_t off_ = (size_t)(row0 + ((g) >> 1) * HALF + (((g) & 1) * 2 + mm) * 16) * 1024 + col0 + bj * HALF; \
            eb[buf][mm][bj] = *(const u32x4*)(E + off_); hh[buf][mm][bj] = *(const u32x4*)(hb + off_); } } while (0)
        PG8_PLOAD(0, 0);
#pragma unroll
        for (int g = 0; g < 4; ++g) { const int ai = g >> 1;
            if (g + 1 < 4) PG8_PLOAD(g + 1, (g + 1) & 1);
#pragma unroll
            for (int mm = 0; mm < 2; ++mm) { const int m = (g & 1) * 2 + mm, row = row0 + ai * HALF + m * 16;
#pragma unroll
                for (int bj = 0; bj < 2; ++bj) { const size_t off = (size_t)row * 1024 + col0 + bj * HALF;
                    f32x4 e0, e1, h0, h1; unpack8(eb[g & 1][mm][bj], e0, e1); unpack8(hh[g & 1][mm][bj], h0, h1);
                    const f32x4 o0 = h0 + sigmoid4(acc[ai][bj][m][0] * r3[ai][m]) * (e0 * re[ai][m]);
                    const f32x4 o1 = h1 + sigmoid4(acc[ai][bj][m][1] * r3[ai][m]) * (e1 * re[ai][m]);
                    __builtin_nontemporal_store(o0, (f32x4*)(out + off)); __builtin_nontemporal_store(o1, (f32x4*)(out + off + 4)); } } }
#undef PG8_PLOAD
    }
};
struct EpiQKV {
    static constexpr bool PERM = true, AFTER_DRAIN = false, MIDSCALE = false;
    bf16_t* QKV; float* gates; float* logf; const float* ssq1; const float* rope; const float* gq_nsa; const float* gk_slc; const float* gk_win; const float* gq_fox; const float* gk_fox; const float* bforget;
    __device__ __forceinline__ void operator()(const f32x4 (&acc)[2][2][4][2], const Unit& u, int wr, int wc, int fr, int fq) const {
        const int row0 = u.pm * BM + wr * 64 + fr;
        if (u.pn == 11) {
            if (wc != 0) return;
            f32x4 bf0 = *(const f32x4*)(bforget), bf1 = *(const f32x4*)(bforget + 4);
            float rq[2][4];
            { f32x4 sp[2][4];
#pragma unroll
              for (int ai = 0; ai < 2; ++ai)
#pragma unroll
                  for (int m = 0; m < 4; ++m) sp[ai][m] = ssq_part(ssq1, row0 + ai * HALF + m * 16, fq);
#pragma unroll
              for (int ai = 0; ai < 2; ++ai)
#pragma unroll
                  for (int m = 0; m < 4; ++m) rq[ai][m] = rstd_fin(sp[ai][m], 1.f / 1024.f); }
#pragma unroll
            for (int ai = 0; ai < 2; ++ai)
#pragma unroll
                for (int m = 0; m < 4; ++m) { const int row = row0 + ai * HALF + m * 16; const float r1 = rq[ai][m];
                    const f32x4 v0 = acc[ai][0][m][0] * r1, v1 = acc[ai][0][m][1] * r1;
                    if (fq < 3) { *(f32x4*)(gates + (size_t)row * 24 + 8 * fq) = sigmoid4(v0); *(f32x4*)(gates + (size_t)row * 24 + 8 * fq + 4) = sigmoid4(v1); }
                    else { f32x4 x0 = v0 + bf0, x1 = v1 + bf1, l0, l1;
#pragma unroll
                        for (int e = 0; e < 4; ++e) { l0[e] = fminf(x0[e], 0.f) - __logf(1.0f + __expf(-fabsf(x0[e]))); l1[e] = fminf(x1[e], 0.f) - __logf(1.0f + __expf(-fabsf(x1[e]))); }
                        *(f32x4*)(logf + (size_t)row * 8) = l0; *(f32x4*)(logf + (size_t)row * 8 + 4) = l1; } }
            return;
        }
        const int c0 = u.pn * 256 + wc * 64;
        const float* gain = nullptr; bool dorope = false; float scale = 1.f;
        if (c0 < 512) { gain = gq_nsa; dorope = true; scale = 0.125f * 1.4426950408889634f; }
        else if (c0 < 640) { dorope = true; }
        else if (c0 < 768) {}
        else if (c0 < 896) { gain = gk_slc; dorope = true; }
        else if (c0 < 1024) {}
        else if (c0 < 1152) { gain = gk_win; dorope = true; }
        else if (c0 < 1280) {}
        else if (c0 < 1792) { gain = gq_fox; scale = 0.125f * 1.4426950408889634f; }
        else if (c0 < 2304) { gain = gk_fox; }
        f32x4 gv[2][2];
#pragma unroll
        for (int bj = 0; bj < 2; ++bj)
#pragma unroll
            for (int n = 0; n < 2; ++n) gv[bj][n] = (gain ? *(const f32x4*)(gain + 32 * bj + 8 * fq + 4 * n) : (f32x4){1.f, 1.f, 1.f, 1.f}) * scale;
        float rq[2][4];
        { f32x4 sp[2][4];
#pragma unroll
          for (int ai = 0; ai < 2; ++ai)
#pragma unroll
              for (int m = 0; m < 4; ++m) sp[ai][m] = ssq_part(ssq1, row0 + ai * HALF + m * 16, fq);
#pragma unroll
          for (int ai = 0; ai < 2; ++ai)
#pragma unroll
              for (int m = 0; m < 4; ++m) rq[ai][m] = rstd_fin(sp[ai][m], 1.f / 1024.f); }
#pragma unroll
        for (int ai = 0; ai < 2; ++ai) {
#pragma unroll
            for (int m = 0; m < 4; ++m) { const int row = row0 + ai * HALF + m * 16, t = row & 4095; const float r1 = rq[ai][m];
                float rs = r1;
                if (gain) { float ss = (hsum4(acc[ai][0][m][0] * acc[ai][0][m][0]) + hsum4(acc[ai][0][m][1] * acc[ai][0][m][1])) + (hsum4(acc[ai][1][m][0] * acc[ai][1][m][0]) + hsum4(acc[ai][1][m][1] * acc[ai][1][m][1]));
                    ss = sum_rows4(ss);
                    rs = r1 * __builtin_amdgcn_rsqf(ss * (r1 * r1) * (1.f / 64.f) + 1e-6f); }
                f32x4 v[2][2];
#pragma unroll
                for (int bj = 0; bj < 2; ++bj)
#pragma unroll
                    for (int n = 0; n < 2; ++n) v[bj][n] = acc[ai][bj][m][n] * (gv[bj][n] * rs);
                if (dorope) { f32x4 p0, p1;
#pragma unroll
                    for (int e = 0; e < 4; ++e) { p0[e] = xor16(v[0][0][e], fq); p1[e] = xor16(v[0][1][e], fq); }
                    if (fq < 2) { const f32x4 cs0 = *(const f32x4*)(rope + t * 16), cs1 = *(const f32x4*)(rope + t * 16 + 4), sn0 = *(const f32x4*)(rope + t * 16 + 8), sn1 = *(const f32x4*)(rope + t * 16 + 12);
                        if (fq == 0) { v[0][0] = v[0][0] * cs0 - p0 * sn0; v[0][1] = v[0][1] * cs1 - p1 * sn1; }
                        else { v[0][0] = v[0][0] * cs0 + p0 * sn0; v[0][1] = v[0][1] * cs1 + p1 * sn1; } } }
#pragma unroll
                for (int bj = 0; bj < 2; ++bj) *(u32x4*)(QKV + (size_t)(c0 >> 6) * (32768 * 64) + (size_t)row * 64 + 32 * bj + 8 * fq) = pack8(v[bj][0], v[bj][1]);
            }
        }
    }
};

struct EpiCompress {
    static constexpr bool PERM = true, AFTER_DRAIN = true, MIDSCALE = false;
    const float* posb; const bf16_t* w2t; const float* gk; bf16_t* KC; bf16_t* VC;
    __device__ __forceinline__ void fused(f32x4 (&acc)[2][2][4][2], const Unit& u, int wr, int wc, int fr, int fq, PG8_LAS unsigned char* lds, int wid, int lane) const {
        typedef float f32x16 __attribute__((ext_vector_type(16))); typedef unsigned u32x2v __attribute__((ext_vector_type(2)));
        const int which = u.pn, bk = u.pm;
        {
            const int col0 = wc * 32 + 8 * fq;
#pragma unroll
            for (int bj = 0; bj < 2; ++bj) { const f32x4 b0 = *(const f32x4*)(posb + which * 256 + col0 + bj * HALF), b1 = *(const f32x4*)(posb + which * 256 + col0 + bj * HALF + 4);
#pragma unroll
                for (int ai = 0; ai < 2; ++ai)
#pragma unroll
                    for (int m = 0; m < 4; ++m) { const int row = ai * HALF + wr * 64 + m * 16 + fr; const f32x4 g0 = acc[ai][bj][m][0] + b0, g1 = acc[ai][bj][m][1] + b1;
                        *(PG8_LAS u32x4*)(lds + row * 528 + (col0 + bj * HALF) * 2) = pack8(g0 * sigmoid4(g0), g1 * sigmoid4(g1)); } }
        }
        asm volatile("s_waitcnt lgkmcnt(0)" ::: "memory"); __builtin_amdgcn_s_barrier(); asm volatile("" ::: "memory");
        const int r32 = lane & 31, hi = lane >> 5, n = wid * 32 + r32;
        f32x16 o[2]; o[0] = f32x16{}; o[1] = f32x16{};
        { const PG8_LAS unsigned char* hp = lds + n * 528 + hi * 16; const bf16_t* wp = w2t + (size_t)(which * 64 + r32) * 256 + hi * 8;
#pragma unroll 4
          for (int ks = 0; ks < 16; ++ks) { const bf16x8 bfr = *(const PG8_LAS bf16x8*)(hp + ks * 32);
              const bf16x8 a0 = *(const bf16x8*)(wp + ks * 16), a1 = *(const bf16x8*)(wp + 32 * 256 + ks * 16);
              o[0] = __builtin_amdgcn_mfma_f32_32x32x16_bf16(a0, bfr, o[0], 0, 0, 0); o[1] = __builtin_amdgcn_mfma_f32_32x32x16_bf16(a1, bfr, o[1], 0, 0, 0); } }
        if (which == 0) {
            float ss = 0.f;
#pragma unroll
            for (int dt = 0; dt < 2; ++dt)
#pragma unroll
                for (int r = 0; r < 16; ++r) ss += o[dt][r] * o[dt][r];
            { auto rr = __builtin_amdgcn_permlane32_swap(__float_as_uint(ss), __float_as_uint(ss), false, false); ss = __uint_as_float(rr[0]) + __uint_as_float(rr[1]); }
            const float rn = __builtin_amdgcn_rsqf(ss * (1.f / 64.f) + 1e-6f);
#pragma unroll
            for (int dt = 0; dt < 2; ++dt)
#pragma unroll
                for (int k = 0; k < 4; ++k) { const f32x4 gv = *(const f32x4*)(gk + 32 * dt + 8 * k + 4 * hi);
#pragma unroll
                    for (int e2 = 0; e2 < 4; ++e2) o[dt][4 * k + e2] = o[dt][4 * k + e2] * rn * gv[e2]; }
        }
        bf16_t* outp = (which ? VC : KC) + ((size_t)bk * 256 + n) * 64 + 4 * hi;
        const bool live = n < 255;
#pragma unroll
        for (int dt = 0; dt < 2; ++dt)
#pragma unroll
            for (int k = 0; k < 4; ++k) { u32x2v w; w.x = cvt_pk_bf16(o[dt][4 * k], o[dt][4 * k + 1]); w.y = cvt_pk_bf16(o[dt][4 * k + 2], o[dt][4 * k + 3]);
                if (!live) { w.x = 0u; w.y = 0u; }
                *(u32x2v*)(outp + 32 * dt + 8 * k) = w; }
    }
};
typedef int v4i_t __attribute__((ext_vector_type(4))); typedef int v8i_t __attribute__((ext_vector_type(8)));
template <class Epi, class Sched, bool ALIGN_EPI = false, bool SP2 = false, bool MX8 = false>
__device__ __forceinline__ void gemm_phase(PG8_LAS unsigned char* lds, const Gemm g, const Sched& S, const Epi& E, const int wv) {
    const int tid = opaque_tid(wv), wid = wv, lane = tid & 63, wr = wid >> 2, wc = wid & 3, fr = lane & 15, fq = lane >> 4;
    const int K = g.K, nt = K / BK;
    unsigned voffA[2], voffB[2];
#pragma unroll
    for (int i = 0; i < 2; ++i) { int R, C; stage_rc(tid * 16 + i * 8192, R, C); const int Rb = Epi::PERM ? ((R & ~31) + perm32(R & 31)) : R;
        voffA[i] = (unsigned)(R * (g.rsA ? g.rsA : K * 2) + C * 2); voffB[i] = (unsigned)(Rb * K + C) * 2u; }
    const size_t kstep = (size_t)(BK * 2);
    const size_t hstep = (size_t)HALF * K * 2;
    const size_t tstep = 2 * hstep;
    const size_t rsA = g.rsA ? (size_t)g.rsA : (size_t)K * 2, kstepA = (size_t)g.ksA, hstepA = (size_t)HALF * rsA;
    const unsigned ldsw = (unsigned)wid * 1024u;
    const int aoff = lds_byte(wr * 64 + fr, fq * 8), boff = lds_byte(wc * 32 + fr, fq * 8);
#define PG8_SA(b, h) (((b) * 2 + (h)) * HTB)
#define PG8_SB(b, h) ((4 + (b) * 2 + (h)) * HTB)
#define PG8_STAGE(bufoff, gbase, voff) do { _Pragma("unroll") for (int _i = 0; _i < 2; ++_i) { unsigned vo_ = (voff)[_i]; if constexpr (MX8) asm volatile("" : "+v"(vo_));     \
        __builtin_amdgcn_global_load_lds((const unsigned*)((const char*)(gbase) + vo_), (PG8_LAS unsigned*)(lds + (bufoff) + ldsw + _i * 8192), 16, 0, 0); } } while (0)
#define PG8_LDA(dst, b, h) do { _Pragma("unroll") for (int m = 0; m < 4; ++m) { if constexpr (MX8) { const v4i_t lo_ = *(const PG8_LAS v4i_t*)(lds + PG8_SA(b, h) + aoff + m * 2048), hi_ = *(const PG8_LAS v4i_t*)(lds + PG8_SA(b, h) + aoff + m * 2048 + 1024); dst##8[m] = __builtin_shufflevector(lo_, hi_, 0, 1, 2, 3, 4, 5, 6, 7); } \
        else { _Pragma("unroll") for (int k = 0; k < 2; ++k) dst[m][k] = *(const PG8_LAS bf16x8*)(lds + PG8_SA(b, h) + aoff + m * 2048 + k * 1024); } } } while (0)
#define PG8_LDB(dst, b, h) do { _Pragma("unroll") for (int n = 0; n < 2; ++n) { if constexpr (MX8) { const v4i_t lo_ = *(const PG8_LAS v4i_t*)(lds + PG8_SB(b, h) + boff + n * 2048), hi_ = *(const PG8_LAS v4i_t*)(lds + PG8_SB(b, h) + boff + n * 2048 + 1024); dst##8[n] = __builtin_shufflevector(lo_, hi_, 0, 1, 2, 3, 4, 5, 6, 7); } \
        else { _Pragma("unroll") for (int k = 0; k < 2; ++k) dst[n][k] = *(const PG8_LAS bf16x8*)(lds + PG8_SB(b, h) + boff + n * 2048 + k * 1024); } } } while (0)
#define PG8_MMA(ai, bj, At, Bt) do { __builtin_amdgcn_s_setprio(1); _Pragma("unroll") for (int m = 0; m < 4; ++m) _Pragma("unroll") for (int n = 0; n < 2; ++n) { \
        if constexpr (MX8) acc[ai][bj][m][n] = __builtin_amdgcn_mfma_scale_f32_16x16x128_f8f6f4(Bt##8[n], At##8[m], acc[ai][bj][m][n], 0, 0, 0, 0x7F7F7F7F, 0, 0x7F7F7F7F); \
        else { _Pragma("unroll") for (int k = 0; k < 2; ++k) acc[ai][bj][m][n] = __builtin_amdgcn_mfma_f32_16x16x32_bf16(Bt[n][k], At[m][k], acc[ai][bj][m][n], 0, 0, 0); } } \
        __builtin_amdgcn_s_setprio(0); } while (0)
#define PG8_WAIT_V(n) asm volatile("s_waitcnt vmcnt(" #n ")" ::: "memory")
#define PG8_WAIT_L(n) asm volatile("s_waitcnt lgkmcnt(" #n ")" ::: "memory")
#define PG8_BAR __builtin_amdgcn_s_barrier()
#define PG8_SCHED __builtin_amdgcn_sched_barrier(0)
    Unit cur, nxt; int ui = 0;
    if (!S.next(0, cur)) return;
    f32x4 acc[2][2][4][2];
#pragma unroll
    for (int a = 0; a < 2; ++a)
#pragma unroll
        for (int b = 0; b < 2; ++b)
#pragma unroll
            for (int m = 0; m < 4; ++m)
#pragma unroll
                for (int n = 0; n < 2; ++n) acc[a][b][m][n] = (f32x4){0.f, 0.f, 0.f, 0.f};
    bf16x8 At[4][2], B0[2][2], B1[2][2]; v8i_t At8[4], B08[2], B18[2];
    const char* cA = a_tile(g, cur); const char* cB = (const char*)g.Bt + (size_t)cur.pn * tstep;
    S.a_ready(cur);
    if constexpr (SP2) {
        PG8_STAGE(PG8_SB(0, 0), cB, voffB); PG8_STAGE(PG8_SB(0, 1), cB + hstep, voffB); PG8_STAGE(PG8_SA(0, 0), cA, voffA); PG8_STAGE(PG8_SA(0, 1), cA + hstepA, voffA);
        if (wr == 1) PG8_BAR;
        PG8_WAIT_V(2); PG8_BAR;
        PG8_STAGE(PG8_SB(1, 0), cB + kstep, voffB); PG8_STAGE(PG8_SA(1, 0), cA + kstepA, voffA); PG8_STAGE(PG8_SB(1, 1), cB + hstep + kstep, voffB);
        PG8_WAIT_V(6); PG8_BAR;
    } else {
        PG8_STAGE(PG8_SB(0, 0), cB, voffB); PG8_STAGE(PG8_SA(0, 0), cA, voffA); PG8_STAGE(PG8_SB(0, 1), cB + hstep, voffB); PG8_STAGE(PG8_SA(0, 1), cA + hstepA, voffA);
        if (wr == 1) PG8_BAR;
        PG8_WAIT_V(4); PG8_BAR;
        PG8_STAGE(PG8_SB(1, 0), cB + kstep, voffB); PG8_STAGE(PG8_SA(1, 0), cA + kstepA, voffA); PG8_STAGE(PG8_SB(1, 1), cB + hstep + kstep, voffB);
        PG8_WAIT_V(6); PG8_BAR;
    }
    for (;;) {
        const bool has_next = S.next(ui + 1, nxt);
        const char* nA = has_next ? a_tile(g, nxt) : cA; const char* nB = has_next ? (const char*)g.Bt + (size_t)nxt.pn * tstep : cB;
#pragma unroll 1
        for (int t = 0; t < nt; t += 2) {
            if constexpr (Epi::MIDSCALE) { if (t == 8) { const int l4_ = opaque_tid(wv) & 63; E.midscale(acc, cur, wr, l4_ & 15, l4_ >> 4); } }
            const bool last = (t == nt - 2);
            const char* a1 = cA + (size_t)(t + 1) * kstepA;
            const char* a2 = last ? nA : cA + (size_t)(t + 2) * kstepA; const char* b2 = last ? nB : cB + (size_t)(t + 2) * kstep;
            const char* a3 = a2 + kstepA; const char* b3 = b2 + kstep;
            if (last && has_next) S.a_ready(nxt);
            if constexpr (SP2) {
            PG8_LDB(B0, 0, 0); PG8_LDB(B1, 0, 1); PG8_SCHED; PG8_LDA(At, 0, 0); PG8_STAGE(PG8_SA(1, 1), a1 + hstepA, voffA);
            PG8_WAIT_V(8); PG8_WAIT_L(0); PG8_BAR; PG8_MMA(0, 0, At, B0); PG8_MMA(0, 1, At, B1); PG8_BAR; PG8_SCHED;
            PG8_LDA(At, 0, 1); PG8_STAGE(PG8_SB(0, 0), b2, voffB); PG8_STAGE(PG8_SB(0, 1), b2 + hstep, voffB); PG8_STAGE(PG8_SA(0, 0), a2, voffA);
            PG8_WAIT_V(8); PG8_WAIT_L(0); PG8_BAR; PG8_MMA(1, 0, At, B0); PG8_MMA(1, 1, At, B1); PG8_BAR; PG8_SCHED;
            PG8_LDB(B0, 1, 0); PG8_LDB(B1, 1, 1); PG8_SCHED; PG8_LDA(At, 1, 0); PG8_STAGE(PG8_SA(0, 1), a2 + hstepA, voffA);
            PG8_WAIT_V(8); PG8_WAIT_L(0); PG8_BAR; PG8_MMA(0, 0, At, B0); PG8_MMA(0, 1, At, B1); PG8_BAR; PG8_SCHED;
            PG8_LDA(At, 1, 1); PG8_STAGE(PG8_SB(1, 0), b3, voffB); PG8_STAGE(PG8_SB(1, 1), b3 + hstep, voffB); PG8_STAGE(PG8_SA(1, 0), a3, voffA);
            PG8_WAIT_V(8); PG8_WAIT_L(0); PG8_BAR; PG8_MMA(1, 0, At, B0); PG8_MMA(1, 1, At, B1); PG8_BAR; PG8_SCHED;
            } else {
            PG8_LDB(B0, 0, 0); PG8_SCHED; PG8_LDA(At, 0, 0); PG8_STAGE(PG8_SA(1, 1), a1 + hstepA, voffA);
            PG8_WAIT_L(8); PG8_BAR; PG8_WAIT_L(0); PG8_MMA(0, 0, At, B0); PG8_BAR; PG8_SCHED;
            PG8_LDB(B1, 0, 1); PG8_STAGE(PG8_SB(0, 0), b2, voffB);
            PG8_BAR; PG8_WAIT_L(0); PG8_MMA(0, 1, At, B1); PG8_BAR;
            PG8_LDA(At, 0, 1); PG8_STAGE(PG8_SA(0, 0), a2, voffA);
            PG8_BAR; PG8_WAIT_L(0); PG8_MMA(1, 0, At, B0); PG8_BAR; PG8_SCHED;
            PG8_STAGE(PG8_SB(0, 1), b2 + hstep, voffB);
            PG8_WAIT_V(6); PG8_BAR; PG8_MMA(1, 1, At, B1); PG8_BAR;
            PG8_LDB(B0, 1, 0); PG8_SCHED; PG8_LDA(At, 1, 0); PG8_STAGE(PG8_SA(0, 1), a2 + hstepA, voffA);
            PG8_WAIT_L(8); PG8_BAR; PG8_WAIT_L(0); PG8_MMA(0, 0, At, B0); PG8_BAR; PG8_SCHED;
            PG8_LDB(B1, 1, 1); PG8_STAGE(PG8_SB(1, 0), b3, voffB);
            PG8_BAR; PG8_WAIT_L(0); PG8_MMA(0, 1, At, B1); PG8_BAR;
            PG8_LDA(At, 1, 1); PG8_STAGE(PG8_SA(1, 0), a3, voffA);
            PG8_BAR; PG8_WAIT_L(0); PG8_MMA(1, 0, At, B0); PG8_BAR; PG8_SCHED;
            PG8_STAGE(PG8_SB(1, 1), b3 + hstep, voffB);
            PG8_WAIT_V(6); PG8_BAR; PG8_MMA(1, 1, At, B1); PG8_BAR;
            }
        }
        if constexpr (ALIGN_EPI) { if (wr == 0) PG8_BAR; }
        if constexpr (!Epi::AFTER_DRAIN) { const int l2_ = opaque_tid(wv) & 63; E(acc, cur, wr, wc, l2_ & 15, l2_ >> 4); S.done(cur); }
        if (!has_next) break;
#pragma unroll
        for (int a = 0; a < 2; ++a)
#pragma unroll
            for (int b = 0; b < 2; ++b)
#pragma unroll
                for (int m = 0; m < 4; ++m)
#pragma unroll
                    for (int n = 0; n < 2; ++n) acc[a][b][m][n] = (f32x4){0.f, 0.f, 0.f, 0.f};
        cur = nxt; cA = nA; cB = nB; ++ui;
        if constexpr (ALIGN_EPI) { if (wr == 1) PG8_BAR; }
    }
    PG8_WAIT_V(0);
    if constexpr (!ALIGN_EPI) { if (wr == 0) PG8_BAR; }
    PG8_BAR;
    if constexpr (Epi::AFTER_DRAIN) { const int l3_ = opaque_tid(wv) & 63; E.fused(acc, cur, wr, wc, l3_ & 15, l3_ >> 4, lds, wid, l3_); S.done(cur); }
#undef PG8_SA
#undef PG8_SB
#undef PG8_STAGE
#undef PG8_LDA
#undef PG8_LDB
#undef PG8_MMA
#undef PG8_WAIT_V
#undef PG8_WAIT_L
#undef PG8_BAR
#undef PG8_SCHED
}
}

#include <hip/hip_bf16.h>
namespace att {
using bf16x8=__attribute__((ext_vector_type(8)))short;
using s16x4=__attribute__((ext_vector_type(4)))short;
using f32x16=__attribute__((ext_vector_type(16)))float;
using u32x4=__attribute__((ext_vector_type(4)))unsigned;
using u32x2=__attribute__((ext_vector_type(2)))unsigned;
using f32x4_t=__attribute__((ext_vector_type(4)))float;
using bf16x4=__attribute__((ext_vector_type(4)))short;
constexpr int NW=8,QBLK=32,KVBLK=64;
__device__ __forceinline__ int crow(int r,int hi){return (r&3)+8*(r>>2)+4*hi;}
#define SBAR() __builtin_amdgcn_sched_barrier(0)
template<int VAR> __device__ __forceinline__ void amask(f32x16&p0,f32x16&p1,int keybase,int qpos,int lower,int hi){
  const float NEG=-INFINITY; int kb=keybase+4*hi; asm volatile("":"+v"(kb)); asm volatile("":"+v"(qpos)); if(VAR==2) asm volatile("":"+v"(lower));
  #pragma unroll
  for(int r=0;r<16;++r){const int kv=kb+(r&3)+8*(r>>2); bool m0=kv>qpos,m1=kv+32>qpos; if(VAR==2){m0=m0||(kv<lower);m1=m1||(kv+32<lower);} if(m0)p0[r]=NEG; if(m1)p1[r]=NEG;}
}
constexpr int NSLOT=4, SLOTB=8192;
constexpr int LDS_K=0, LDS_V=NSLOT*SLOTB, LDS_WS=2*NSLOT*SLOTB, LDS_OST=LDS_WS+NW*64*4, LDS_CB=LDS_OST+NW*4096, LDS_BYTES_ATT=LDS_CB+16384;
__device__ __forceinline__ void glds16(const void*gsrc,unsigned lds_dst){unsigned keep;
  asm volatile("s_mov_b32 %0, m0\n\ts_mov_b32 m0, %2\n\ts_nop 0\n\tglobal_load_lds_dwordx4 %1, off\n\ts_mov_b32 m0, %0":"=&s"(keep):"v"(gsrc),"s"(lds_dst):"memory");}
__device__ __forceinline__ float max3f(float a,float b,float c){float r;asm("v_max3_f32 %0, %1, %2, %3":"=v"(r):"v"(a),"v"(b),"v"(c));return r;}
__device__ __forceinline__ float max2f(float a,float b){float r;asm("v_max_f32_e32 %0, %1, %2":"=v"(r):"v"(a),"v"(b));return r;}
__device__ __forceinline__ float fadd_s(float a,float b){float r;asm("v_add_f32_e32 %0, %1, %2":"=v"(r):"v"(a),"v"(b));return r;}
__device__ __forceinline__ float fsub_s(float a,float b){float r;asm("v_sub_f32_e32 %0, %1, %2":"=v"(r):"v"(a),"v"(b));return r;}
typedef float f32x2_t __attribute__((ext_vector_type(2))); typedef __bf16 bf16x2_t __attribute__((ext_vector_type(2)));
__device__ __forceinline__ unsigned cvtpk_s(float lo,float hi){f32x2_t v={lo,hi};bf16x2_t b=__builtin_convertvector(v,bf16x2_t);return __builtin_bit_cast(unsigned,b);}
#define WAIT_BAR(N) asm volatile("s_waitcnt vmcnt(" #N ") lgkmcnt(0)\n\ts_barrier":::"memory")
typedef __attribute__((address_space(3))) const char* lds_cptr;
typedef short v4i16_t __attribute__((ext_vector_type(4)));
template<int VAR> __device__ __forceinline__ void qkt(f32x16&p0,f32x16&p1,const char*Kslot,const bf16x8*qr,int r32,int hi){
  const char*kb=Kslot+hi*1024+r32*16;
  #pragma unroll
  for(int d0=0;d0<4;++d0){
    const bf16x8 b0=*reinterpret_cast<const bf16x8*>(kb+d0*2048);
    const bf16x8 b1=*reinterpret_cast<const bf16x8*>(kb+d0*2048+512);
    p0=__builtin_amdgcn_mfma_f32_32x32x16_bf16(b0,qr[d0],p0,0,0,0);p1=__builtin_amdgcn_mfma_f32_32x32x16_bf16(b1,qr[d0],p1,0,0,0);}
}
__device__ __forceinline__ void kload8(bf16x8*kf,lds_cptr kp){
  kf[0]=*(const __attribute__((address_space(3))) bf16x8*)(kp);      kf[1]=*(const __attribute__((address_space(3))) bf16x8*)(kp+512);
  kf[2]=*(const __attribute__((address_space(3))) bf16x8*)(kp+2048); kf[3]=*(const __attribute__((address_space(3))) bf16x8*)(kp+2560);
  kf[4]=*(const __attribute__((address_space(3))) bf16x8*)(kp+4096); kf[5]=*(const __attribute__((address_space(3))) bf16x8*)(kp+4608);
  kf[6]=*(const __attribute__((address_space(3))) bf16x8*)(kp+6144); kf[7]=*(const __attribute__((address_space(3))) bf16x8*)(kp+6656);
}
__device__ __forceinline__ void kload2(bf16x8*kf,lds_cptr kp,int j){ kf[2*j]=*(const __attribute__((address_space(3))) bf16x8*)(kp+j*2048); kf[2*j+1]=*(const __attribute__((address_space(3))) bf16x8*)(kp+j*2048+512); }
__device__ __forceinline__ s16x4 vtr(lds_cptr p){ return __builtin_bit_cast(s16x4,__builtin_amdgcn_ds_read_tr16_b64_v4i16((__attribute__((address_space(3))) v4i16_t*)p)); }
__device__ __forceinline__ float rowmax(const f32x16&p0,const f32x16&p1){
  float a=max3f(p0[0],p0[1],p1[0]),b=max3f(p0[2],p0[3],p1[1]);a=max3f(a,p1[2],p1[3]);
  #pragma unroll
  for(int r=4;r<16;r+=4){a=max3f(a,p0[r],p0[r+1]);b=max3f(b,p0[r+2],p0[r+3]);a=max3f(a,p1[r],p1[r+1]);b=max3f(b,p1[r+2],p1[r+3]);}
  const float m=max2f(a,b);
  auto rr=__builtin_amdgcn_permlane32_swap(__float_as_uint(m),__float_as_uint(m),false,false);
  return max2f(__uint_as_float(rr[0]),__uint_as_float(rr[1]));
}
__device__ __forceinline__ void pv(f32x16*o,int vb,bf16x8 pa0,bf16x8 pa1,bf16x8 pa2,bf16x8 pa3){
  #pragma unroll
  for(int d0=0;d0<2;++d0){s16x4 lo[4],hi[4];
    #pragma unroll
    for(int ks=0;ks<4;++ks){
      asm volatile("ds_read_b64_tr_b16 %0,%1 offset:%c2":"=&v"(lo[ks]):"v"(vb),"i"(d0*4096+ks*1024):"memory");
      asm volatile("ds_read_b64_tr_b16 %0,%1 offset:%c2":"=&v"(hi[ks]):"v"(vb),"i"(d0*4096+ks*1024+512):"memory");}
    asm volatile("s_waitcnt lgkmcnt(0)":::"memory");SBAR();
    #define PK(k) (bf16x8){lo[k][0],lo[k][1],lo[k][2],lo[k][3],hi[k][0],hi[k][1],hi[k][2],hi[k][3]}
    o[d0]=__builtin_amdgcn_mfma_f32_32x32x16_bf16(pa0,PK(0),o[d0],0,0,0);
    o[d0]=__builtin_amdgcn_mfma_f32_32x32x16_bf16(pa1,PK(1),o[d0],0,0,0);
    o[d0]=__builtin_amdgcn_mfma_f32_32x32x16_bf16(pa2,PK(2),o[d0],0,0,0);
    o[d0]=__builtin_amdgcn_mfma_f32_32x32x16_bf16(pa3,PK(3),o[d0],0,0,0);
    #undef PK
  }
}
template<int VAR,int THRL> __device__ __forceinline__ void attn_unit(int b,int hx,int ux,const bf16*QKVb,bf16*Ob,const float*gates,const float*Cc,const unsigned long long*SEL,float*SSQO,char*shm,const int wv,const bf16*nxK_,const bf16*nxV_,const bool pf,unsigned*qctr=nullptr,volatile __attribute__((address_space(3))) unsigned*qslot=nullptr){
  const bf16*nxK=nxK_,*nxV=nxV_; int nx_ux=0;
  int tid_=opaque_tid(wv);
  const int tid=tid_,lane=tid&63,r32=lane&31,hi=lane>>5; const int wid=wv;
  const long rowbase=(long)b*SEQ;
  const int head=(VAR==0)?hx:(hx*4+(wid>>1));
  const int row0=(VAR==0)?(ux*256+wid*32):(ux*64+(wid&1)*32);
  const int qcol=(VAR==0)?(C_QF+hx*HS):(C_QA+head*HS);
  const int kcol=(VAR==0)?(C_KF+hx*HS):(VAR==1)?(C_SK+hx*HS):(C_WK+hx*HS);
  const int vcol=(VAR==0)?(C_VF+hx*HS):(VAR==1)?(C_SV+hx*HS):(C_WV+hx*HS);
  const int NTreal=(VAR==0)?(4*ux+4):(VAR==1)?(ux+1):((ux<8?ux:8)+1);
  const int NT=NTreal<4?4:NTreal;
  const int tdiag=ux;
  #define TNOM(t) ((VAR==2)?(tdiag-(t)):(t))
  #define TACT(t) ((VAR==2)?((tdiag-(t))<0?0:(tdiag-(t))):(t))
  const bf16*Qw=QKVb+(rowbase+row0)*QP+qcol;
  const bf16*Kh=QKVb+rowbase*QP+kcol,*Vh=QKVb+rowbase*QP+vcol;
  const unsigned lds0=(unsigned)(uintptr_t)shm;
  float*wsf=(float*)(shm+LDS_WS)+wid*64;
  const bf16*ksrc=Kh+(long)lane*QP+wid*8;
  const bf16*vsrc=Vh+(long)(16*(wid&3)+(lane>>2))*QP+(wid>>2)*32+(lane&3)*8;
  const unsigned kdst=lds0+LDS_K+wid*1024, vdst=lds0+LDS_V+wid*1024;
  #define DMA_K(t,slot) glds16(ksrc+(long)TACT(t)*KVBLK*QP,(unsigned)__builtin_amdgcn_readfirstlane(kdst+(slot)))
  #define DMA_V(t,slot) glds16(vsrc+(long)TACT(t)*KVBLK*QP,(unsigned)__builtin_amdgcn_readfirstlane(vdst+(slot)))
  const int vb0=(int)(lds0+LDS_V)+((lane>>4)&1)*32+(lane&3)*8+(4*hi+((lane&15)>>2))*64;
  const char*Kbase=shm+LDS_K; bf16x8 kf[8];
  const lds_cptr shm3=(lds_cptr)shm; const lds_cptr kp0=shm3+LDS_K+hi*1024+r32*16; const lds_cptr vp0=shm3+LDS_V+((lane>>4)&1)*32+(lane&3)*8+(4*hi+((lane&15)>>2))*64;
  if(!pf){DMA_K(0,0);DMA_V(0,0);DMA_K(1,SLOTB);}
  bf16x8 qr[4];
  #pragma unroll
  for(int d0=0;d0<4;++d0)qr[d0]=*reinterpret_cast<const bf16x8*>(&Qw[(long)r32*QP+d0*16+hi*8]);
  const int qpos=row0+r32; const int lower=(VAR==2)?((qpos-511)<0?0:(qpos-511)):0;
  unsigned long long sel=~0ull; if(VAR==1)sel=SEL[(size_t)(rowbase+qpos)*2+hx];
  const __attribute__((address_space(3))) float* cbf=(const __attribute__((address_space(3))) float*)(shm3+LDS_CB)+4*hi;
  #define BLD(P0,P1,t,g) do{ if(VAR==0){ const f32x4_t q0_=*(const __attribute__((address_space(3))) f32x4_t*)(cbf+64*(t)+8*(g)), q1_=*(const __attribute__((address_space(3))) f32x4_t*)(cbf+64*(t)+32+8*(g)); \
      P0[4*(g)]=q0_[0];P0[4*(g)+1]=q0_[1];P0[4*(g)+2]=q0_[2];P0[4*(g)+3]=q0_[3]; P1[4*(g)]=q1_[0];P1[4*(g)+1]=q1_[1];P1[4*(g)+2]=q1_[2];P1[4*(g)+3]=q1_[3]; } }while(0)
  #define BIASLD(P0,P1,t) do{ BLD(P0,P1,t,0);BLD(P0,P1,t,1);BLD(P0,P1,t,2);BLD(P0,P1,t,3); }while(0)
  float mhat=0.f,l_reg=0.f;f32x16 o[2];o[0]=f32x16{};o[1]=f32x16{};const f32x16 zero16=f32x16{};
  #define NEEDM(t) ((TNOM(t)<0)||(64*TNOM(t)+63>row0)||((VAR==2)&&(64*TNOM(t)<row0-480)))
  #define CMASK(P0,P1,t) do{ if(NEEDM(t)){ amask<VAR>(P0,P1,64*TNOM(t),qpos,lower,hi); } }while(0)
  bool resc=false;
  #define START(P0,P1) do{ const float rm=rowmax(P0,P1); resc=false; mhat=rm; \
      _Pragma("unroll") for(int r=0;r<16;++r){P0[r]=fsub_s(P0[r],rm);P1[r]=fsub_s(P1[r],rm);} \
    _Pragma("unroll") for(int r=0;r<16;++r)P0[r]=__builtin_amdgcn_exp2f(P0[r]); }while(0)
  #define RESC() do{ if(resc){ asm volatile("s_waitcnt lgkmcnt(0)":::"memory"); const float*wq_=wsf+4*hi; asm volatile("":"+v"(wq_)); \
      _Pragma("unroll") for(int d_=0;d_<2;++d_) _Pragma("unroll") for(int r=0;r<16;++r)o[d_][r]*=wq_[(r&3)+8*(r>>2)]; } }while(0)
  f32x16 pA0,pA1;
  int sl_prev=0,sl_cur=0,sl_next=SLOTB,sl_nn=2*SLOTB;
  #define ROT() do{sl_prev=sl_cur;sl_cur=sl_next;sl_next=sl_nn;sl_nn=(sl_nn==(NSLOT-1)*SLOTB)?0:sl_nn+SLOTB;}while(0)
  if(!pf){DMA_K(2,2*SLOTB);}
  DMA_K(3,3*SLOTB);DMA_V(1,SLOTB);
  WAIT_BAR(5);
  if(VAR==0){ BIASLD(pA0,pA1,0); } else { pA0=f32x16{}; pA1=f32x16{}; }
  qkt<VAR>(pA0,pA1,Kbase,qr,r32,hi);asm volatile("s_nop 15\n\ts_nop 7":"+v"(pA0),"+v"(pA1));CMASK(pA0,pA1,0);
  START(pA0,pA1);
  f32x16 pB0,pB1; BIASLD(pB0,pB1,1);
  _Pragma("unroll") for(int r=0;r<16;++r)pA1[r]=__builtin_amdgcn_exp2f(pA1[r]);
  WAIT_BAR(2);
  if(4<NT){DMA_K(4,0);} DMA_V(2,2*SLOTB);
  ROT();
  kload8(kf,kp0+sl_cur);
  WAIT_BAR(4);
  s16x4 vlo[8],vhi[8]; u32x4 pw0,pw1,pw2,pw3;
  #define PKW(P,B) cvtpk_s(P[B],P[B+1])
  #define PAF(k) __builtin_bit_cast(bf16x8,pw##k)
  #define VFR(i) (bf16x8){vlo[i][0],vlo[i][1],vlo[i][2],vlo[i][3],vhi[i][0],vhi[i][1],vhi[i][2],vhi[i][3]}
  #define PIN(x) asm volatile("":"+v"(x))
  #define MX3(a,b,c) __builtin_fmaxf(__builtin_fmaxf((a),(b)),(c))
  #define GAPA(MF,A0,A1,A2,A3,W0,W1,PW) do{ MF; sacc+=A0; sacc+=A1; sacc+=A2; sacc+=A3; PIN(sacc); W0; W1; PIN(PW); SBAR(); }while(0)
  #define EX(v) __builtin_amdgcn_exp2f(v)
  #define GAPB(MF,X,B) do{ MF; X[B]=EX(X[B]-mhe); X[B+1]=EX(X[B+1]-mhe); X[B+2]=EX(X[B+2]-mhe); X[B+3]=EX(X[B+3]-mhe); PIN(X); SBAR(); }while(0)
  #define VRD(i) do{ vlo[i]=vtr(vp_+(((i)>>2)*4096+((i)&3)*1024)); vhi[i]=vtr(vp_+(((i)>>2)*4096+((i)&3)*1024+512)); }while(0)
  #define KRD(G,j) do{ if(G){ kload2(kf,kp0+sl_next,j); SBAR(); } }while(0)
  #define STEP(C0,C1,P0,P1,t,GK,GV,GL) do{ SBAR(); \
    const lds_cptr vp_=vp0+sl_prev; \
    VRD(0); SBAR(); float sacc=(P0[0]+P0[1]); \
    GAPA(C0=__builtin_amdgcn_mfma_f32_32x32x16_bf16(kf[0],qr[0],(VAR==0)?C0:zero16,0,0,0), P0[2],P0[3],P0[4],P0[5],     pw0[0]=PKW(P0,0), pw0[1]=PKW(P0,2), pw0); \
    VRD(4); SBAR(); GAPA(C1=__builtin_amdgcn_mfma_f32_32x32x16_bf16(kf[1],qr[0],(VAR==0)?C1:zero16,0,0,0), P0[6],P0[7],P0[8],P0[9],     pw0[2]=PKW(P0,4), pw0[3]=PKW(P0,6), pw0); \
    VRD(1); SBAR(); GAPA(C0=__builtin_amdgcn_mfma_f32_32x32x16_bf16(kf[2],qr[1],C0,0,0,0),   P0[10],P0[11],P0[12],P0[13], pw1[0]=PKW(P0,8), pw1[1]=PKW(P0,10), pw1); \
    VRD(5); SBAR(); GAPA(C1=__builtin_amdgcn_mfma_f32_32x32x16_bf16(kf[3],qr[1],C1,0,0,0),   P0[14],P0[15],P1[0],P1[1],   pw1[2]=PKW(P0,12),pw1[3]=PKW(P0,14), pw1); \
    VRD(2); SBAR(); GAPA(C0=__builtin_amdgcn_mfma_f32_32x32x16_bf16(kf[4],qr[2],C0,0,0,0),   P1[2],P1[3],P1[4],P1[5],     pw2[0]=PKW(P1,0), pw2[1]=PKW(P1,2), pw2); \
    VRD(6); SBAR(); GAPA(C1=__builtin_amdgcn_mfma_f32_32x32x16_bf16(kf[5],qr[2],C1,0,0,0),   P1[6],P1[7],P1[8],P1[9],     pw2[2]=PKW(P1,4), pw2[3]=PKW(P1,6), pw2); \
    VRD(3); SBAR(); GAPA(C0=__builtin_amdgcn_mfma_f32_32x32x16_bf16(kf[6],qr[3],C0,0,0,0),   P1[10],P1[11],P1[12],P1[13], pw3[0]=PKW(P1,8), pw3[1]=PKW(P1,10), pw3); \
    VRD(7); SBAR(); GAPA(C1=__builtin_amdgcn_mfma_f32_32x32x16_bf16(kf[7],qr[3],C1,0,0,0),   P1[14],P1[15],0.f,0.f,       pw3[2]=PKW(P1,12),pw3[3]=PKW(P1,14), pw3); \
    l_reg+=sacc; \
    if(GK){DMA_K((t)+4,sl_cur);} if(GV){DMA_V((t)+2,sl_nn);} \
    CMASK(C0,C1,t); \
    float mhe; \
    { float a=MX3(C0[0],C0[1],C1[0]),b=MX3(C0[2],C0[3],C1[1]); a=MX3(a,C1[2],C1[3]); \
      _Pragma("unroll") for(int r=4;r<16;r+=4){a=MX3(a,C0[r],C0[r+1]);b=MX3(b,C0[r+2],C0[r+3]);a=MX3(a,C1[r],C1[r+1]);b=MX3(b,C1[r+2],C1[r+3]);} \
      float rm=__builtin_fmaxf(a,b); { auto rr=__builtin_amdgcn_permlane32_swap(__float_as_uint(rm),__float_as_uint(rm),false,false); rm=__builtin_fmaxf(__uint_as_float(rr[0]),__uint_as_float(rr[1])); } \
      bool on_=true; if(VAR==1) on_=((sel>>(t))&1ull)!=0ull; \
      rm=on_?(rm-mhat):-INFINITY; \
      resc=false; \
      if(__builtin_expect(__any(rm>(float)THRL),0)){ const float dl=__builtin_fmaxf(rm,0.f); mhat+=dl; \
        const float f=__builtin_amdgcn_exp2f(-dl); l_reg*=f; if(hi==0)wsf[r32]=f; resc=true; } \
      mhe=on_?mhat:INFINITY; } \
    SBAR(); \
    if(GL){BLD(P0,P1,(t)+1,0);SBAR();} GAPB(o[0]=__builtin_amdgcn_mfma_f32_32x32x16_bf16(PAF(0),VFR(0),o[0],0,0,0), C0,0); \
    if(GL){BLD(P0,P1,(t)+1,1);SBAR();} GAPB(o[1]=__builtin_amdgcn_mfma_f32_32x32x16_bf16(PAF(0),VFR(4),o[1],0,0,0), C0,4); \
    KRD(GL,0); GAPB(o[0]=__builtin_amdgcn_mfma_f32_32x32x16_bf16(PAF(1),VFR(1),o[0],0,0,0), C0,8); \
    KRD(GL,1); GAPB(o[1]=__builtin_amdgcn_mfma_f32_32x32x16_bf16(PAF(1),VFR(5),o[1],0,0,0), C0,12); \
    KRD(GL,2); GAPB(o[0]=__builtin_amdgcn_mfma_f32_32x32x16_bf16(PAF(2),VFR(2),o[0],0,0,0), C1,0); \
    KRD(GL,3); GAPB(o[1]=__builtin_amdgcn_mfma_f32_32x32x16_bf16(PAF(2),VFR(6),o[1],0,0,0), C1,4); \
    if(GL){BLD(P0,P1,(t)+1,2);SBAR();} GAPB(o[0]=__builtin_amdgcn_mfma_f32_32x32x16_bf16(PAF(3),VFR(3),o[0],0,0,0), C1,8); \
    if(GL){BLD(P0,P1,(t)+1,3);SBAR();} GAPB(o[1]=__builtin_amdgcn_mfma_f32_32x32x16_bf16(PAF(3),VFR(7),o[1],0,0,0), C1,12); \
    }while(0)
  int t=1;
  #undef CMASK
  #define CMASK(P0,P1,t) do{}while(0)
  for(;t+5<NT;t+=2){
    STEP(pB0,pB1,pA0,pA1,t,true,true,true);     WAIT_BAR(4); RESC(); ROT();
    STEP(pA0,pA1,pB0,pB1,t+1,true,true,true);   WAIT_BAR(4); RESC(); ROT();
  }
  #undef CMASK
  #define CMASK(P0,P1,t) do{ if(NEEDM(t)){ amask<VAR>(P0,P1,64*TNOM(t),qpos,lower,hi); } }while(0)
  #define CNT_(s_) (((s_)<=0)?((4<NT?1:0)+1):((((s_)+4<NT)?1:0)+(((s_)+2<NT)?1:0)))
  #define ENDW(tt) do{ const int a_=((tt)==NT-2)?0:(CNT_(tt)+CNT_((tt)-1)); if(a_>=4){WAIT_BAR(4);} else if(a_==3){WAIT_BAR(3);} else if(a_==2){WAIT_BAR(2);} else if(a_==1){WAIT_BAR(1);} else {WAIT_BAR(0);} }while(0)
  float gv_=1.f; if(VAR!=0) gv_=gates[(size_t)(rowbase+qpos)*24+head*3+VAR];
  unsigned nq_=0u; if(VAR==2&&qctr){ if(tid==0) nq_=__hip_atomic_fetch_add(qctr,1u,__ATOMIC_RELAXED,__HIP_MEMORY_SCOPE_AGENT); }
  for(;t+1<NT;t+=2){
    STEP(pB0,pB1,pA0,pA1,t,(t+4<NT),(t+2<NT),(t+1<NT));       ENDW(t);   RESC(); ROT();
    STEP(pA0,pA1,pB0,pB1,t+1,(t+5<NT),(t+3<NT),(t+2<NT));     ENDW(t+1); RESC(); ROT();
  }
  #define DRAIN(X0,X1,slot) do{ float sacc=X0[0]+X0[1]; _Pragma("unroll") for(int r=2;r<16;++r)sacc+=X0[r]; _Pragma("unroll") for(int r=0;r<16;++r)sacc+=X1[r]; l_reg+=sacc; \
    pw0=(u32x4){PKW(X0,0),PKW(X0,2),PKW(X0,4),PKW(X0,6)};pw1=(u32x4){PKW(X0,8),PKW(X0,10),PKW(X0,12),PKW(X0,14)};pw2=(u32x4){PKW(X1,0),PKW(X1,2),PKW(X1,4),PKW(X1,6)};pw3=(u32x4){PKW(X1,8),PKW(X1,10),PKW(X1,12),PKW(X1,14)}; \
    SBAR(); pv(o,vb0+(slot),PAF(0),PAF(1),PAF(2),PAF(3)); }while(0)
  if(t<NT){
    STEP(pB0,pB1,pA0,pA1,NT-1,false,false,false); RESC();
    DRAIN(pB0,pB1,sl_cur);
  } else {
    DRAIN(pA0,pA1,sl_prev);
  }
  #undef DRAIN
  if(VAR==2&&qctr){ if(tid==0)*qslot=nq_; asm volatile("s_waitcnt lgkmcnt(0)\n\ts_barrier":::"memory"); const unsigned ni_=*qslot;
    if(ni_<1024u){ const int nbk_=(int)(ni_&15u); nx_ux=63-(int)(ni_>>4); nxK=QKVb+(size_t)(nbk_>>1)*SEQ*QP+C_WK+(size_t)(nbk_&1)*HS; nxV=QKVb+(size_t)(nbk_>>1)*SEQ*QP+C_WV+(size_t)(nbk_&1)*HS; } }
  float rg_=1.f; if(VAR!=0){ rg_=__builtin_amdgcn_rcpf(gv_); asm volatile("":"+v"(rg_)); }
  if(nxK){ const bf16*kn_=nxK+(long)lane*QP+wid*8; const int t0_=(VAR==2)?nx_ux:0, t1_=(VAR==2)?(nx_ux-1<0?0:nx_ux-1):1, t2_=(VAR==2)?(nx_ux-2<0?0:nx_ux-2):2;
    glds16(kn_+(long)t0_*KVBLK*QP,(unsigned)__builtin_amdgcn_readfirstlane(kdst)); glds16(kn_+(long)t1_*KVBLK*QP,(unsigned)__builtin_amdgcn_readfirstlane(kdst+SLOTB)); glds16(kn_+(long)t2_*KVBLK*QP,(unsigned)__builtin_amdgcn_readfirstlane(kdst+2*SLOTB)); }
  #undef PKW
  #undef PAF
  #undef VFR
  #undef PIN
  #undef MX3
  #undef GAPA
  #undef GAPB
  #undef EX
  #undef VRD
  #undef KRD
  #undef STEP
  #undef ENDW
  #undef CNT_
  {auto rr=__builtin_amdgcn_permlane32_swap(__float_as_uint(l_reg),__float_as_uint(l_reg),false,false);l_reg=__uint_as_float(rr[0])+__uint_as_float(rr[1]);}
  if(VAR!=0){ l_reg=l_reg*rg_; }
  if(hi==0)wsf[32+r32]=l_reg;asm volatile("s_waitcnt lgkmcnt(0)":::"memory");
  float rli[16];
  { const float*wq_=wsf+32+4*hi; asm volatile("":"+v"(wq_));
  #pragma unroll
  for(int r=0;r<16;++r)rli[r]=__builtin_amdgcn_rcpf(wq_[(r&3)+8*(r>>2)]); }
  bf16*Ow=Ob+(rowbase+row0)*1024+((VAR==0)?(512+hx*64):head*64);
  const bf16*Oc=(const bf16*)((const char*)Ob-(WS_OMIX-WS_O))+(rowbase+row0)*1024+head*64;
  { bf16*stg=(bf16*)(shm+LDS_OST)+wid*2048; bf16*sq_=stg+(4*hi)*64+r32; asm volatile("":"+v"(sq_));
    #pragma unroll
    for(int r=0;r<16;++r){const int orow=(r&3)+8*(r>>2);
      #pragma unroll
      for(int d0=0;d0<2;++d0)sq_[orow*64+d0*32]=f2bf(o[d0][r]*rli[r]);}
    asm volatile("s_waitcnt lgkmcnt(0)":::"memory");
    float*sqp=SSQO+(size_t)(rowbase+row0)*16+((VAR==0)?(8+hx):head);
    u32x4 pvv[4],pcv[4];
    if(VAR==1){
      #pragma unroll
      for(int i=0;i<4;++i){const int row=i*8+(lane>>3),ch=lane&7; pvv[i]=*(const u32x4*)(Ow+(long)row*1024+ch*8); pcv[i]=*(const u32x4*)(Oc+(long)row*1024+ch*8);} }
    #pragma unroll
    for(int i=0;i<4;++i){const int row=i*8+(lane>>3),ch=lane&7; u32x4 v=*(const u32x4*)(stg+row*64+ch*8);
      if(VAR==1){ const u32x4 pv_=pvv[i]; const u32x4 pc_=pcv[i];
        #pragma unroll
        for(int q=0;q<4;++q){ const float lo_=__uint_as_float(v[q]<<16)+(__uint_as_float(pv_[q]<<16)+__uint_as_float(pc_[q]<<16)), hi_=__uint_as_float(v[q]&0xffff0000u)+(__uint_as_float(pv_[q]&0xffff0000u)+__uint_as_float(pc_[q]&0xffff0000u)); v[q]=cvtpk_s(lo_,hi_); } }
      *(u32x4*)(Ow+(long)row*1024+ch*8)=v;
      if(VAR!=2){ float ss=0.f;
        #pragma unroll
        for(int q=0;q<4;++q){ const float lo_=__uint_as_float(v[q]<<16), hi_=__uint_as_float(v[q]&0xffff0000u); ss+=lo_*lo_+hi_*hi_; }
        ss+=__shfl_xor(ss,1); ss+=__shfl_xor(ss,2); ss+=__shfl_xor(ss,4);
        if(ch==0)sqp[(size_t)row*16]=ss; } } }
  asm volatile("s_waitcnt lgkmcnt(0)\n\ts_barrier":::"memory");
  if(nxV){ const bf16*vn_=nxV+(long)(16*(wid&3)+(lane>>2))*QP+(wid>>2)*32+(lane&3)*8+(long)((VAR==2)?nx_ux:0)*KVBLK*QP; glds16(vn_,(unsigned)__builtin_amdgcn_readfirstlane(vdst)); }
  #undef DMA_K
  #undef DMA_V
  #undef CMASK
  #undef NEEDM
  #undef SELMASK
  #undef START
  #undef RESC
  #undef ROT
  #undef BIASLD
  #undef BLD
  #undef TNOM
  #undef TACT
}
#undef SBAR
#undef WAIT_BAR
}
namespace cmpx {
using att::bf16x8; using att::s16x4; using att::f32x16; using att::u32x4; using att::lds_cptr;
constexpr int TKS = 9;
constexpr int L_KI = 0, L_VI = 32768, L_IMP = 65536, IMP_ROW = 65, IMP_WAVE = 32 * IMP_ROW * 4, LDS_BYTES_CMP = L_IMP + 8 * IMP_WAVE;
__device__ __forceinline__ float swap_half(float x, int hi) {
    auto rr = __builtin_amdgcn_permlane32_swap(__float_as_uint(x), __float_as_uint(x), false, false);
    return __uint_as_float(hi ? rr[0] : rr[1]);
}
__device__ __forceinline__ unsigned bcnt64(unsigned long long m) { unsigned n; asm("s_bcnt1_i32_b64 %0, %1" : "=s"(n) : "s"(m) : "scc"); return n; }
__device__ __forceinline__ void load_kv(int bk, const bf16* KC, const bf16* VC, char* shm, int tid) {
    const bf16* kc = KC + (size_t)bk * 256 * 64; const bf16* vc = VC + (size_t)bk * 256 * 64;
#pragma unroll
    for (int u = 0; u < 4; ++u) { const int i = tid + 512 * u, r = i >> 3, c = i & 7;
        const u32x4 kv = *(const u32x4*)(kc + r * 64 + c * 8), vv = *(const u32x4*)(vc + r * 64 + c * 8);
        *(u32x4*)(shm + L_KI + c * 4096 + r * 16) = kv;
        *(u32x4*)(shm + L_VI + (c >> 2) * 16384 + r * 64 + (c & 3) * 16) = vv; }
}
__device__ __forceinline__ void cmp_unit(int bk, int blk, const bf16* QKVb, const float* gates, bf16* OC, unsigned long long* SEL, char* shm, const int wv) {
    const int tid = opaque_tid(wv), lane = tid & 63, r32 = lane & 31, hi = lane >> 5, wid = wv;
    const int g = wid >> 1, th = wid & 1, b = bk >> 1, kvh = bk & 1, head = kvh * 4 + g;
    const long rowbase = (long)b * SEQ;
    const int tok0 = blk * 64 + th * 32, t = tok0 + r32;
    const bf16* Qw = QKVb + (rowbase + tok0) * QP + C_QA + (long)head * HS;
    bf16x8 qr[4];
#pragma unroll
    for (int d0 = 0; d0 < 4; ++d0) qr[d0] = *reinterpret_cast<const bf16x8*>(&Qw[(long)r32 * QP + d0 * 16 + hi * 8]);
    float gvv[16];
    { const float* gp = gates + (size_t)(rowbase + tok0 + 4 * hi) * 24 + head * 3; asm volatile("" : "+v"(gp));
#pragma unroll
      for (int r = 0; r < 16; ++r) gvv[r] = gp[((r & 3) + 8 * (r >> 2)) * 24]; }
    const int ntile = (4 * blk + 3 + 31) >> 5;
    const lds_cptr shm3 = (lds_cptr)shm;
    f32x16 S[8];
    { const lds_cptr kp = shm3 + L_KI + hi * 4096 + r32 * 16;
#pragma unroll
      for (int j = 0; j < 8; ++j) {
          if (j < ntile) { f32x16 a = f32x16{};
#pragma unroll
              for (int d0 = 0; d0 < 4; ++d0) a = __builtin_amdgcn_mfma_f32_32x32x16_bf16(*(const __attribute__((address_space(3))) bf16x8*)(kp + d0 * 8192 + j * 512), qr[d0], a, 0, 0, 0);
              S[j] = a; }
          else S[j] = f32x16{}; } }
    const int nlim = (t - 31) >> 4;
    const int nl0 = (tok0 - 31) >> 4;
    float m = -INFINITY;
    { int nb = 4 * hi; asm volatile("" : "+v"(nb));
#pragma unroll
      for (int j = 0; j < 8; ++j) if (j < ntile) {
          if (32 * j + 31 > nl0) {
#pragma unroll
              for (int r = 0; r < 16; ++r) { const int n = nb + 32 * j + (r & 3) + 8 * (r >> 2); if (n > nlim) S[j][r] = -INFINITY; } }
          float a = att::max3f(S[j][0], S[j][1], S[j][2]), c = att::max3f(S[j][3], S[j][4], S[j][5]);
          a = att::max3f(a, S[j][6], S[j][7]); c = att::max3f(c, S[j][8], S[j][9]); a = att::max3f(a, S[j][10], S[j][11]); c = att::max3f(c, S[j][12], S[j][13]);
          a = att::max3f(a, S[j][14], S[j][15]); m = att::max3f(m, a, c); } }
    m = fmaxf(m, swap_half(m, hi));
    if (m == -INFINITY) m = 0.f;
    float l = 0.f;
#pragma unroll
    for (int j = 0; j < 8; ++j) if (j < ntile) {
#pragma unroll
        for (int r = 0; r < 16; ++r) { S[j][r] = __builtin_amdgcn_exp2f(S[j][r] - m); l += S[j][r]; } }
    l += swap_half(l, hi);
    const float rl = l > 0.f ? 1.0f / l : 0.f;
#pragma unroll
    for (int j = 0; j < 8; ++j) if (j < ntile) S[j] = S[j] * rl;
    { float* impw = (float*)(shm + L_IMP + wid * IMP_WAVE) + r32 * IMP_ROW + hi;
      float carry = 0.f;
#pragma unroll
      for (int j = 0; j < 8; ++j) if (j < ntile)
#pragma unroll
          for (int k = 0; k < 4; ++k) {
              const float G = (S[j][4 * k] + S[j][4 * k + 1]) + (S[j][4 * k + 2] + S[j][4 * k + 3]);
              const float LP = swap_half(S[j][4 * k + 3], hi);
              impw[2 * (4 * j + k)] = G + (hi ? LP : carry);
              carry = LP; } }
    __syncthreads();
    {
      if (blk < 16) {
          if (lane < 8) SEL[(size_t)(rowbase + blk * 64 + wid * 8 + lane) * 2 + kvh] = (2ull << blk) - 1ull;
      } else {
#pragma unroll 1
      for (int i = 0; i < 8; i += 4) {
          const int cur = blk; unsigned kb[4]; bool vld[4];
#pragma unroll
          for (int u = 0; u < 4; ++u) { const int tl = wid * 8 + i + u, th2 = tl >> 5, q2 = tl & 31;
              const float* ip = (const float*)(shm + L_IMP) + q2 * IMP_ROW + lane;
              float val = (ip[(0 + th2) * (IMP_WAVE / 4)] + ip[(2 + th2) * (IMP_WAVE / 4)]) + (ip[(4 + th2) * (IMP_WAVE / 4)] + ip[(6 + th2) * (IMP_WAVE / 4)]);
              if (lane > cur) val = -1.f; else if (lane == 0 || lane == cur || lane == cur - 1) val = 1e6f;
              vld[u] = val >= 0.f; kb[u] = vld[u] ? __float_as_uint(val) : 0u; }
          unsigned T[4] = {0u, 0u, 0u, 0u};
#pragma unroll
          for (int bit = 30; bit >= TKS; --bit) {
#pragma unroll
              for (int u = 0; u < 4; ++u) { const unsigned c = T[u] | (1u << bit); T[u] = bcnt64(__ballot(kb[u] >= c)) >= 16u ? c : T[u]; } }
          bool more = false;
#pragma unroll
          for (int u = 0; u < 4; ++u) { const unsigned hi1 = T[u] + (1u << TKS);
              const unsigned n_eq = bcnt64(__ballot(kb[u] >= T[u] && kb[u] < hi1 && vld[u])), n_gt = bcnt64(__ballot(kb[u] >= hi1));
              more = more || (n_gt + n_eq != 16u); }
          if (more) {
#pragma unroll
              for (int bit = TKS - 1; bit >= 0; --bit) {
#pragma unroll
                  for (int u = 0; u < 4; ++u) { const unsigned c = T[u] | (1u << bit); T[u] = bcnt64(__ballot(kb[u] >= c)) >= 16u ? c : T[u]; } } }
#pragma unroll
          for (int u = 0; u < 4; ++u) { const int tl = wid * 8 + i + u;
              const bool gt_ = kb[u] > T[u], eq_ = (kb[u] == T[u]) && vld[u];
              const unsigned long long eqm = __ballot(eq_); const int need = 16 - (int)bcnt64(__ballot(gt_));
              const int below = (int)__builtin_amdgcn_mbcnt_hi((unsigned)(eqm >> 32), __builtin_amdgcn_mbcnt_lo((unsigned)eqm, 0u));
              const unsigned long long selmask = __ballot(gt_ || (eq_ && below < need));
              if (lane == 0) SEL[(size_t)(rowbase + blk * 64 + tl) * 2 + kvh] = selmask; } } } }
    __syncthreads();
    f32x16 o[2]; o[0] = f32x16{}; o[1] = f32x16{};
    { const lds_cptr vp0 = shm3 + L_VI + ((lane >> 4) & 1) * 32 + (lane & 3) * 8 + (4 * hi + ((lane & 15) >> 2)) * 64;
#pragma unroll
      for (int j = 0; j < 8; ++j) if (j < ntile) {
#pragma unroll
          for (int s = 0; s < 2; ++s) {
              u32x4 pw; pw[0] = att::cvtpk_s(S[j][8 * s], S[j][8 * s + 1]); pw[1] = att::cvtpk_s(S[j][8 * s + 2], S[j][8 * s + 3]); pw[2] = att::cvtpk_s(S[j][8 * s + 4], S[j][8 * s + 5]); pw[3] = att::cvtpk_s(S[j][8 * s + 6], S[j][8 * s + 7]);
#pragma unroll
              for (int d0 = 0; d0 < 2; ++d0) { const s16x4 lo = att::vtr(vp0 + d0 * 16384 + j * 2048 + s * 1024), hh = att::vtr(vp0 + d0 * 16384 + j * 2048 + s * 1024 + 512);
                  const bf16x8 vf = (bf16x8){lo[0], lo[1], lo[2], lo[3], hh[0], hh[1], hh[2], hh[3]};
                  o[d0] = __builtin_amdgcn_mfma_f32_32x32x16_bf16(__builtin_bit_cast(bf16x8, pw), vf, o[d0], 0, 0, 0); } } } }
    { bf16* stg = (bf16*)(shm + L_IMP + wid * IMP_WAVE); bf16* sq_ = stg + (4 * hi) * 64 + r32; asm volatile("" : "+v"(sq_));
#pragma unroll
      for (int r = 0; r < 16; ++r) { const int orow = (r & 3) + 8 * (r >> 2); const float gv = gvv[r];
#pragma unroll
          for (int d0 = 0; d0 < 2; ++d0) sq_[orow * 64 + d0 * 32] = f2bf(o[d0][r] * gv); }
      asm volatile("s_waitcnt lgkmcnt(0)" ::: "memory");
      bf16* Ow = OC + (rowbase + tok0) * 1024 + head * 64;
#pragma unroll
      for (int i = 0; i < 4; ++i) { const int row = i * 8 + (lane >> 3), ch = lane & 7; const u32x4 v = *(const u32x4*)(stg + row * 64 + ch * 8);
          *(u32x4*)(Ow + (long)row * 1024 + ch * 8) = v; } }
    __syncthreads();
}
}
#define LAS __attribute__((address_space(3)))
typedef unsigned v4u __attribute__((ext_vector_type(4)));
typedef float f32x4 __attribute__((ext_vector_type(4)));
constexpr int NWAVES = 8;
constexpr int RING_BYTES = 131072, LDS_BYTES = 147456;

__device__ __forceinline__ unsigned pk2(float lo, float hi) { return (unsigned)f2bf(lo) | ((unsigned)f2bf(hi) << 16); }
__device__ __forceinline__ int src_win(int np) {
    const int tile = np >> 8, w = np & 255;
    if (tile == 11) { if (w < 24) return 1280 + w; if (w < 32) return 2840 + (w - 24); return -1; }
    const int half = w >> 7, head = (w >> 5) & 3, i = w & 31;
    const int c = tile * 256 + head * 64 + half * 32 + i;
    return c < 1280 ? c : c + 24;
}
template <bool F8 = false> __device__ __forceinline__ void transpose_item(const float* W, int N, int K, const float* gain, bf16* WT, int n0, int k0, int sc4, LAS float* scr, int lane, const float wscale = 1.f) {
    const int kr = lane >> 3, c4 = (lane & 7) * 4;
    f32x4 v[8];
#pragma unroll
    for (int i = 0; i < 8; ++i) v[i] = sc4 >= 0 ? __builtin_nontemporal_load((const f32x4*)(W + (size_t)(k0 + 8 * i + kr) * N + sc4)) : (f32x4){0.f, 0.f, 0.f, 0.f};
#pragma unroll
    for (int i = 0; i < 8; ++i) { const int kk = 8 * i + kr; const float gg = (gain ? gain[k0 + kk] : 1.f) * wscale;
#pragma unroll
        for (int e = 0; e < 4; ++e) scr[kk * 33 + c4 + e] = v[i][e] * gg; }
    asm volatile("s_waitcnt lgkmcnt(0)" ::: "memory");
    const int c = lane & 7;
#pragma unroll
    for (int j = 0; j < 4; ++j) { const int n = (lane >> 3) + 8 * j; const LAS float* s = scr + (8 * c) * 33 + n;
        if (F8) { int w0 = __builtin_amdgcn_cvt_pk_fp8_f32(s[0 * 33], s[1 * 33], 0, false); w0 = __builtin_amdgcn_cvt_pk_fp8_f32(s[2 * 33], s[3 * 33], w0, true);
            int w1 = __builtin_amdgcn_cvt_pk_fp8_f32(s[4 * 33], s[5 * 33], 0, false); w1 = __builtin_amdgcn_cvt_pk_fp8_f32(s[6 * 33], s[7 * 33], w1, true);
            *(unsigned long long*)((unsigned char*)WT + (size_t)(n0 + n) * K + k0 + 8 * c) = (unsigned long long)(unsigned)w0 | ((unsigned long long)(unsigned)w1 << 32); }
        else { v4u o; o.x = pk2(s[0 * 33], s[1 * 33]); o.y = pk2(s[2 * 33], s[3 * 33]); o.z = pk2(s[4 * 33], s[5 * 33]); o.w = pk2(s[6 * 33], s[7 * 33]);
            *(v4u*)(WT + (size_t)(n0 + n) * K + k0 + 8 * c) = o; } }
    asm volatile("s_waitcnt lgkmcnt(0)" ::: "memory");
}
template <int PART> __device__ __forceinline__ void ph_prep(const P& p, LAS unsigned char* lds, const int wv, const int vb, const int nvb) {
    const int tid = opaque_tid(wv), lane = tid & 63, wave = wv;
    const int gw = vb * NWAVES + wave, NGW = nvb * NWAVES;
    LAS float* scr = (LAS float*)(lds + wave * 16384);
    constexpr int I_GU = 176 * 16, I_D = 32 * 44, I_IN = 96 * 16, I_SQ = 32 * 16, I_PR = 32 * 4, I_C1 = 512, I_C2 = 16, I_PB = 128;
    constexpr int NITEMS = PART == 0 ? (I_GU + I_D + I_IN + I_C1 + I_C2 + I_PB) : (I_GU + I_D + 2 * I_SQ + I_PR);
    for (int it = gw; it < NITEMS; it += NGW) {
        int r = it;
        if (r < I_GU) {
            const int ng = r / 16, kb = r % 16, n0 = ng * 32, tile = n0 >> 8, w = n0 & 255;
            const float* W = PART ? (w < 128 ? p.in[25] : p.in[26]) : (w < 128 ? p.in[3] : p.in[4]);
            if (PART == 0) transpose_item<F8_G1>(W, DFF, D, nullptr, (bf16*)(p.ws + WS_WGU1), n0, kb * 64, tile * 128 + (w & 127) + 4 * (lane & 7), scr, lane, F8_G1 ? 32.f : 1.f);
            else transpose_item<F8_G5>(W, DFF, D, p.in[24], (bf16*)(p.ws + WS_WGU2), n0, kb * 64, tile * 128 + (w & 127) + 4 * (lane & 7), scr, lane, F8_G5 ? 32.f : 1.f);
            continue; }
        r -= I_GU;
        if (r < I_D) {
            const int ng = r / 44, kb = r % 44;
            if (PART == 0) transpose_item<F8_G2>(p.in[5], D, DFF, nullptr, (bf16*)(p.ws + WS_WD1), ng * 32, kb * 64, ng * 32 + 4 * (lane & 7), scr, lane, F8_G2 ? 64.f : 1.f);
            else transpose_item<F8_G6>(p.in[27], D, DFF, nullptr, (bf16*)(p.ws + WS_WD2), ng * 32, kb * 64, ng * 32 + 4 * (lane & 7), scr, lane, F8_G6 ? 64.f : 1.f);
            continue; }
        r -= I_D;
        if (PART == 0) {
            if (r < I_IN) { const int ng = r / 16, kb = r % 16;
                transpose_item(p.in[7], INW, D, p.in[6], (bf16*)(p.ws + WS_WIN), ng * 32, kb * 64, src_win(ng * 32 + 4 * (lane & 7)), scr, lane);
                continue; }
            r -= I_IN;
            if (r < I_C1) { const int ng = r >> 5, kb = r & 31, which = ng >> 3;
                transpose_item(which ? p.in[17] : p.in[15], 256, 2048, nullptr, (bf16*)(p.ws + WS_WC1), ng * 32, kb * 64, (ng & 7) * 32 + 4 * (lane & 7), scr, lane);
                continue; }
            r -= I_C1;
            if (r < I_C2) { const int ng = r >> 2, kb = r & 3, which = ng >> 1;
                transpose_item(which ? p.in[18] : p.in[16], 64, 256, nullptr, (bf16*)(p.ws + WS_WC2), ng * 32, kb * 64, (ng & 1) * 32 + 4 * (lane & 7), scr, lane);
                continue; }
            r -= I_C2;
            {
                const int which = r >> 6, p64 = r & 63; const float* pos = which ? p.in[14] : p.in[13]; const float* w1 = which ? p.in[17] : p.in[15];
                f32x4 acc = (f32x4){0.f, 0.f, 0.f, 0.f};
#pragma unroll 1
                for (int r0 = 0; r0 < 32; r0 += 8) { f32x4 wv_[8];
#pragma unroll
                    for (int q = 0; q < 8; ++q) wv_[q] = __builtin_nontemporal_load((const f32x4*)(w1 + (size_t)(32 * p64 + r0 + q) * 256) + lane);
#pragma unroll
                    for (int q = 0; q < 8; ++q) acc = acc + wv_[q] * pos[32 * p64 + r0 + q]; }
                *((f32x4*)(p.ws + WS_POSBP) + (size_t)(which * 64 + p64) * 64 + lane) = acc; }
        } else {
            if (r < 2 * I_SQ) { const int second = r >= I_SQ; if (second) r -= I_SQ;
                const int ng = r / 16, kb = r % 16;
                if (second && F8_G7) transpose_item<true>(p.in[29], D, D, p.in[28], (bf16*)(p.ws + WS_WGATE), ng * 32, kb * 64, ng * 32 + 4 * (lane & 7), scr, lane, 32.f);
                else transpose_item(second ? p.in[29] : p.in[23], D, D, second ? p.in[28] : (const float*)(p.ws + WS_GOUT), (bf16*)(p.ws + (second ? WS_WGATE : WS_WOUT)), ng * 32, kb * 64, ng * 32 + 4 * (lane & 7), scr, lane);
                continue; }
            r -= 2 * I_SQ;
            { const int ng = r / 4, kb = r % 4;
              transpose_item(p.in[30], D, DPLE, nullptr, (bf16*)(p.ws + WS_WPROJ), ng * 32, kb * 64, ng * 32 + 4 * (lane & 7), scr, lane); }
        }
    }
    if (PART == 0) {
    for (int i = vb * 512 + tid; i < 1024; i += nvb * 512) ((float*)(p.ws + WS_GOUT))[i] = i < 512 ? p.in[21][i] : p.in[22][i - 512];
    { bf16* XN = (bf16*)(p.ws + (F8_G1 ? WS_O : WS_XN)); const float* g1 = p.in[2];
      f32x4 gg[4];
#pragma unroll
      for (int j = 0; j < 4; ++j) gg[j] = *((const f32x4*)g1 + lane + 64 * j);
      for (int m0 = gw * 8; m0 < M; m0 += NGW * 8) {
          f32x4 v[8][4];
#pragma unroll
          for (int r = 0; r < 8; ++r) { const f32x4* xr = (const f32x4*)(p.in[0] + (size_t)(m0 + r) * D) + lane;
#pragma unroll
              for (int j = 0; j < 4; ++j) v[r][j] = __builtin_nontemporal_load(xr + 64 * j); }
#pragma unroll
          for (int r = 0; r < 8; ++r) { float s = 0.f;
#pragma unroll
              for (int j = 0; j < 4; ++j) s += (v[r][j][0] * v[r][j][0] + v[r][j][1] * v[r][j][1]) + (v[r][j][2] * v[r][j][2] + v[r][j][3] * v[r][j][3]);
              s = wave_sum(s);
              const float rs = 1.0f / sqrtf(s * (1.f / D) + EPS);
              if constexpr (F8_G1) { unsigned* o4 = (unsigned*)((unsigned char*)XN + (size_t)(m0 + r) * D) + lane;
#pragma unroll
                  for (int j = 0; j < 4; ++j) { int w = __builtin_amdgcn_cvt_pk_fp8_f32(v[r][j][0] * rs * gg[j][0], v[r][j][1] * rs * gg[j][1], 0, false);
                      w = __builtin_amdgcn_cvt_pk_fp8_f32(v[r][j][2] * rs * gg[j][2], v[r][j][3] * rs * gg[j][3], w, true); o4[64 * j] = (unsigned)w; } }
              else { unsigned long long* o8 = (unsigned long long*)(XN + (size_t)(m0 + r) * D) + lane;
#pragma unroll
                  for (int j = 0; j < 4; ++j) o8[64 * j] = (unsigned long long)pk2(v[r][j][0] * rs * gg[j][0], v[r][j][1] * rs * gg[j][1]) | ((unsigned long long)pk2(v[r][j][2] * rs * gg[j][2], v[r][j][3] * rs * gg[j][3]) << 32); } }
      } }
    { float* rope = (float*)(p.ws + WS_ROPE);
      for (int t0 = vb * 16; t0 < SEQ; t0 += nvb * 16) if (lane < 16) {
          const int t = t0 + wave * 2 + (lane >> 3), f = lane & 7;
          const double rcf = f == 0 ? p.rc[0] : f == 1 ? p.rc[1] : f == 2 ? p.rc[2] : f == 3 ? p.rc[3] : f == 4 ? p.rc[4] : f == 5 ? p.rc[5] : f == 6 ? p.rc[6] : p.rc[7];
          const double ang = (double)t * rcf;
          const double kq = __builtin_rint(ang * p.rc[8]);
          double r = __builtin_fma(-kq, p.rc[9], ang); r = __builtin_fma(-kq, p.rc[10], r);
          const float x = (float)r, x2 = x * x; const int q = (int)kq & 3;
          const float sn = x + x * x2 * (-1.6666667e-1f + x2 * (8.3333333e-3f + x2 * (-1.9841270e-4f + x2 * 2.7557319e-6f)));
          const float cs = 1.0f + x2 * (-0.5f + x2 * (4.1666667e-2f + x2 * (-1.3888889e-3f + x2 * (2.4801587e-5f + x2 * -2.7557319e-7f))));
          const float c = q == 0 ? cs : q == 1 ? -sn : q == 2 ? -cs : sn;
          const float s = q == 0 ? sn : q == 1 ? cs : q == 2 ? -sn : -cs;
          rope[t * 16 + f] = c; rope[t * 16 + 8 + f] = s; } }
    }
    if (PART == 1) {
    { const f32x4* src = (const f32x4*)p.in[1]; unsigned long long* dst = (unsigned long long*)(p.ws + WS_PB);
      for (size_t i = (size_t)vb * 512 + tid; i < (size_t)M * DPLE / 4; i += (size_t)nvb * 512) { const f32x4 v = __builtin_nontemporal_load(src + i); dst[i] = (unsigned long long)pk2(v[0], v[1]) | ((unsigned long long)pk2(v[2], v[3]) << 32); } }
    }
}

#define RLX_AGENT __ATOMIC_RELAXED, __HIP_MEMORY_SCOPE_AGENT
#define XB_TMO      128
#define XB_XCNT(j)  (256  + 64 * (j))
#define XB_XSUB(j)  (1280 + 64 * (j))
#define XB_XGEN(j)  (2304 + 64 * (j))
#define XB_TOP      3328
#define XB_TOPGEN   3392
#define XCD_BAR_WORDS 3456
#define XB_SPIN_CAP (1u << 18)

__device__ __forceinline__ unsigned xb_ld(unsigned* p)              { return __hip_atomic_load(p, __ATOMIC_RELAXED, __HIP_MEMORY_SCOPE_AGENT); }
__device__ __forceinline__ unsigned xb_add(unsigned* p, unsigned v) { return __hip_atomic_fetch_add(p, v, __ATOMIC_RELAXED, __HIP_MEMORY_SCOPE_AGENT); }
__device__ __forceinline__ unsigned xb_xcc_id() { return (unsigned)__builtin_amdgcn_s_getreg((3 << 11) | 20) & 0xFu; }
#define XB_SPIN(cond, bar) do { unsigned _sp = 0; while (cond) { __builtin_amdgcn_s_sleep(1); \
    if ((++_sp & 255u) == 0u) { if (xb_ld(&(bar)[XB_TMO])) break; if (_sp > XB_SPIN_CAP) { atomicAdd(&(bar)[XB_TMO], 1u); break; } } } } while (0)

struct XcdBarrier {
    unsigned* bar; unsigned x;
    volatile LAS unsigned* st;
};

__device__ __forceinline__ XcdBarrier xcd_barrier_post(unsigned* bar, volatile LAS unsigned* st, bool leader) {
    XcdBarrier b; b.bar = bar; b.x = xb_xcc_id(); b.st = st;
    if (leader) st[2] = xb_add(&bar[XB_XCNT(b.x)], 1u);
    return b;
}
__device__ __forceinline__ void xcd_barrier_complete(unsigned* bar, unsigned x, unsigned& nloc, unsigned& nx) {
    const unsigned G = gridDim.x * gridDim.y * gridDim.z;
    unsigned sum, cnt, mine, sp = 0u;
    for (;;) {
        sum = 0u; cnt = 0u; mine = 0u;
#pragma unroll
        for (unsigned j = 0; j < 16; ++j) { const unsigned c = xb_ld(&bar[XB_XCNT(j)]); sum += c; cnt += (c > 0u) ? 1u : 0u; mine = (j == x) ? c : mine; }
        if (sum == G) break;
        __builtin_amdgcn_s_sleep(1);
        if ((++sp & 255u) == 0u) { if (xb_ld(&bar[XB_TMO])) break; if (sp > XB_SPIN_CAP) { atomicAdd(&bar[XB_TMO], 1u); break; } }
    }
    nloc = mine > 0u ? mine : 1u; nx = cnt > 0u ? cnt : 1u;
}

__device__ __forceinline__ void xcd_barrier(const XcdBarrier& b, bool leader) {
    asm volatile("s_waitcnt vmcnt(0)" ::: "memory");
    __syncthreads();
    if (leader) {
        unsigned* bar = b.bar;
        __builtin_amdgcn_s_waitcnt(0);
        unsigned nloc = b.st[0], nx = b.st[1];
        if (nloc == 0u) { xcd_barrier_complete(bar, b.x, nloc, nx); b.st[0] = nloc; b.st[1] = nx; }
        const unsigned old = xb_add(&bar[XB_XSUB(b.x)], 1u);
        const unsigned gen = old / nloc;
        if (old + 1u == (gen + 1u) * nloc) {
            __builtin_amdgcn_fence(__ATOMIC_RELEASE, "agent");
            asm volatile("s_waitcnt vmcnt(0)" ::: "memory");
            const unsigned og = xb_add(&bar[XB_TOP], 1u);
            const unsigned tg = og / nx;
            if (og + 1u == (tg + 1u) * nx) xb_add(&bar[XB_TOPGEN], 1u);
            else XB_SPIN(xb_ld(&bar[XB_TOPGEN]) == tg, bar);
            __builtin_amdgcn_fence(__ATOMIC_ACQUIRE, "agent");
            xb_add(&bar[XB_XGEN(b.x)], 1u);
            asm volatile("s_waitcnt vmcnt(0)" ::: "memory");
        } else {
            XB_SPIN(xb_ld(&bar[XB_XGEN(b.x)]) == gen, bar);
            __builtin_amdgcn_fence(__ATOMIC_ACQUIRE, "agent");
            asm volatile("s_waitcnt vmcnt(0)" ::: "memory");
        }
    }
    __syncthreads();
}
__device__ __forceinline__ void xcd_barrier_local(const XcdBarrier& b, bool leader) {
    asm volatile("s_waitcnt vmcnt(0)" ::: "memory");
    __syncthreads();
    if (leader) {
        unsigned* bar = b.bar;
        __builtin_amdgcn_s_waitcnt(0);
        unsigned nloc = b.st[0], nx = b.st[1];
        if (nloc == 0u) { xcd_barrier_complete(bar, b.x, nloc, nx); b.st[0] = nloc; b.st[1] = nx; }
        const unsigned old = xb_add(&bar[XB_XSUB(b.x)], 1u);
        const unsigned gen = old / nloc;
        if (old + 1u == (gen + 1u) * nloc) {
            __builtin_amdgcn_fence(__ATOMIC_ACQUIRE, "agent");
            xb_add(&bar[XB_XGEN(b.x)], 1u);
            asm volatile("s_waitcnt vmcnt(0)" ::: "memory");
        } else {
            XB_SPIN(xb_ld(&bar[XB_XGEN(b.x)]) == gen, bar);
            __builtin_amdgcn_fence(__ATOMIC_ACQUIRE, "agent");
            asm volatile("s_waitcnt vmcnt(0)" ::: "memory");
        }
    }
    __syncthreads();
}

template <int VAR> __device__ __forceinline__ void ph_attn(const P& p, LAS unsigned char* lds, const int wv) {
    char* shm = (char*)lds;
    const bf16* QKV = (const bf16*)(p.ws + WS_BIG);
    bf16* Ob = (bf16*)(p.ws + WS_OMIX); float* SSQO = (float*)(p.ws + WS_SSQO);
    const float* gates = (const float*)(p.ws + WS_GATES);
    const float* Cc = (const float*)(p.ws + WS_C);
    const unsigned long long* SEL = (const unsigned long long*)(p.ws + WS_SEL);
    const int G = gridDim.x, bx = blockIdx.x;
    const int vcu0 = (G == 256) ? (bx % 8) * (G / 8) + bx / 8 : bx;
    int cur_bh = -1;
    for (int i = 0;; ++i) {
        const int L = i * G + vcu0; if (L >= 1024) break;
        const int vcu = L & 255, rnd = L >> 8;
        if (VAR == 0) {
            const int bh = vcu >> 2, s = vcu & 3, qb = rnd == 0 ? s : rnd == 1 ? 7 - s : rnd == 2 ? 8 + s : 15 - s;
            if (bh != cur_bh) {
                cur_bh = bh;
                __syncthreads();
                LAS unsigned* cb = (LAS unsigned*)(lds + att::LDS_CB);
                const int k0_ = opaque_tid(wv);
                float cv_[8];
#pragma unroll
                for (int u = 0; u < 8; ++u) cv_[u] = Cc[(size_t)bh * SEQ + k0_ + 512 * u];
#pragma unroll
                for (int u = 0; u < 8; ++u) { const int k = k0_ + 512 * u; const float v = -cv_[u] * LOG2E;
                    ((LAS float*)cb)[k] = v; }
                __syncthreads();
            }
            att::attn_unit<0, 8>(bh >> 3, bh & 7, qb, QKV, Ob, gates, Cc, SEL, SSQO, shm, wv, nullptr, nullptr, false);
        } else {
            const int bk = vcu >> 4, s = vcu & 15, blk = rnd == 0 ? s : rnd == 1 ? 31 - s : rnd == 2 ? 32 + s : 63 - s;
            att::attn_unit<VAR, 8>(bk >> 1, bk & 1, blk, QKV, Ob, gates, Cc, SEL, SSQO, shm, wv, nullptr, nullptr, false);
        }
    }
}

__device__ __forceinline__ void ph_cmpsel2(const P& p, LAS unsigned char* lds, const int wv) {
    char* shm = (char*)lds;
    const int G = gridDim.x, bx = blockIdx.x;
    const int vcu0 = (G == 256) ? (bx % 8) * (G / 8) + bx / 8 : bx;
    int cur_bk = -1;
    for (int i = 0;; ++i) {
        const int L = i * G + vcu0; if (L >= 1024) break;
        const int vcu = L & 255, rnd = L >> 8, bk = vcu >> 4, s = vcu & 15, blk = rnd == 0 ? s : rnd == 1 ? 31 - s : rnd == 2 ? 32 + s : 63 - s;
        if (bk != cur_bk) { cur_bk = bk; __syncthreads(); cmpx::load_kv(bk, (const bf16*)(p.ws + WS_KCMP), (const bf16*)(p.ws + WS_VCMP), shm, opaque_tid(wv)); __syncthreads(); }
        cmpx::cmp_unit(bk, blk, (const bf16*)(p.ws + WS_BIG), (const float*)(p.ws + WS_GATES), (bf16*)(p.ws + WS_O), (unsigned long long*)(p.ws + WS_SEL), shm, wv);
    }
}

__device__ __forceinline__ void ph_attn_fs(const P& p, LAS unsigned char* lds, const int wv, const int bx) {
    char* shm = (char*)lds;
    const bf16* QKV = (const bf16*)(p.ws + WS_BIG); bf16* Ob = (bf16*)(p.ws + WS_OMIX); float* SSQO = (float*)(p.ws + WS_SSQO);
    const float* gates = (const float*)(p.ws + WS_GATES); const float* Cc = (const float*)(p.ws + WS_C); const unsigned long long* SEL = (const unsigned long long*)(p.ws + WS_SEL);
    const int vcu = (bx % 8) * 32 + bx / 8;
    const int bh = vcu >> 2, sf = vcu & 3, bk = vcu >> 4, ss = vcu & 15;
    const bf16* fK = QKV + (size_t)(bh >> 3) * SEQ * QP + C_KF + (size_t)(bh & 7) * HS; const bf16* fV = QKV + (size_t)(bh >> 3) * SEQ * QP + C_VF + (size_t)(bh & 7) * HS;
    const bf16* sK = QKV + (size_t)(bk >> 1) * SEQ * QP + C_SK + (size_t)(bk & 1) * HS; const bf16* sV = QKV + (size_t)(bk >> 1) * SEQ * QP + C_SV + (size_t)(bk & 1) * HS;
    { __syncthreads(); cmpx::load_kv(bk, (const bf16*)(p.ws + WS_KCMP), (const bf16*)(p.ws + WS_VCMP), shm, opaque_tid(wv)); __syncthreads();
#pragma unroll 1
      for (int i = 0; i < 4; ++i) { const int blk = i == 0 ? ss : i == 1 ? 31 - ss : i == 2 ? 32 + ss : 63 - ss;
          cmpx::cmp_unit(bk, blk, QKV, gates, (bf16*)(p.ws + WS_O), (unsigned long long*)(p.ws + WS_SEL), shm, wv); }
      __syncthreads(); }
    {
        LAS unsigned* cb = (LAS unsigned*)(lds + att::LDS_CB);
        const int k0_ = opaque_tid(wv);
        float cv_[8];
#pragma unroll
        for (int u = 0; u < 8; ++u) cv_[u] = Cc[(size_t)bh * SEQ + k0_ + 512 * u];
#pragma unroll
        for (int u = 0; u < 8; ++u) { const int k = k0_ + 512 * u; const float v = -cv_[u] * LOG2E;
            ((LAS float*)cb)[k] = v; }
        __syncthreads();
    }
#pragma unroll 1
    for (int i = 0; i < 4; ++i) { const int qb = i == 0 ? sf : i == 1 ? 7 - sf : i == 2 ? 8 + sf : 15 - sf;
        att::attn_unit<0, 8>(bh >> 3, bh & 7, qb, QKV, Ob, gates, Cc, SEL, SSQO, shm, wv, i < 3 ? fK : sK, i < 3 ? fV : sV, i > 0); }
#pragma unroll 1
    for (int i = 0; i < 4; ++i) { const int blk = i == 0 ? ss : i == 1 ? 31 - ss : i == 2 ? 32 + ss : 63 - ss;
        att::attn_unit<1, 8>(bk >> 1, bk & 1, blk, QKV, Ob, gates, Cc, SEL, SSQO, shm, wv, i < 3 ? sK : nullptr, i < 3 ? sV : nullptr, true); }
}

struct PermOrder : pg8::StaticOrder { unsigned long long tab;
    __device__ __forceinline__ bool next(int i, pg8::Unit& u) const { if (!pg8::StaticOrder::next(i, u)) return false; u.pn = (int)((tab >> (4 * u.pn)) & 15ull); return true; } };
__device__ __forceinline__ void ph_win_queue(const P& p, LAS unsigned char* lds, const int wv) {
    unsigned* qctr = (unsigned*)(p.ws + WS_CTL) + 8192;
    volatile LAS unsigned* qslot = (volatile LAS unsigned*)(lds + LDS_BYTES - 128);
    const bool leader = opaque_tid(wv) == 0;
    if (leader) *qslot = __hip_atomic_fetch_add(qctr, 1u, __ATOMIC_RELAXED, __HIP_MEMORY_SCOPE_AGENT);
    __syncthreads();
    unsigned idx = *qslot; bool pf = false;
    __syncthreads();
#pragma unroll 1
    for (;;) {
        if (idx >= 1024u) break;
        const int blk = 63 - (int)(idx >> 4), bk = (int)(idx & 15u);
        att::attn_unit<2, 8>(bk >> 1, bk & 1, blk, (const bf16*)(p.ws + WS_BIG), (bf16*)(p.ws + WS_OMIX), (const float*)(p.ws + WS_GATES), (const float*)(p.ws + WS_C), (const unsigned long long*)(p.ws + WS_SEL), (float*)(p.ws + WS_SSQO), (char*)lds, wv, nullptr, nullptr, pf, qctr, qslot);
        idx = *qslot; pf = idx < 1024u;
        __syncthreads();
    }
}

enum { PH_PREP = 0, PH_G1, PH_G2, PH_G3, PH_CMPR, PH_ATTN, PH_G4, PH_G5, PH_G6, PH_G7, PH_N };

__global__ void __launch_bounds__(512, 2) k_main(P p, int ph_lo, int ph_hi) {
    extern __shared__ __attribute__((aligned(16))) unsigned char lds_raw[];
    using namespace pg8;
    cg::grid_group grid = cg::this_grid();
    const int wv = __builtin_amdgcn_readfirstlane((int)(threadIdx.x >> 6));
    LAS unsigned char* lds = (LAS unsigned char*)lds_raw;
    const int G = gridDim.x, c = blockIdx.x;
    volatile LAS unsigned* MISC = (volatile LAS unsigned*)(lds + LDS_BYTES - 64);
    const bool leader = opaque_tid(wv) == 0;
    if (leader) { MISC[0] = 0u; MISC[1] = 0u; }
    __syncthreads();
    XcdBarrier bar = xcd_barrier_post((unsigned*)(p.ws + WS_CTL) + 4096, MISC, leader);
    __syncthreads();
    const int xrank = __builtin_amdgcn_readfirstlane((int)MISC[2]), xcc = (int)bar.x;
    if (ph_lo < 0) grid.sync();
#define IN(k) (ph_lo <= (k) && (k) < ph_hi)
#define SEAM(k) do { if (IN(k) && IN((k) + 1)) xcd_barrier(bar, leader); } while (0)
#define SEAML(k) do { if (IN(k) && IN((k) + 1)) { if (xl_ok) xcd_barrier_local(bar, leader); else xcd_barrier(bar, leader); } } while (0)
#define WSP(T, off) ((T*)(p.ws + (off)))
    if (IN(PH_PREP)) { ph_prep<0>(p, lds, wv, c, G); } SEAM(PH_PREP);
    bool xl_ok = false;
    int cz = c;
    if (G == 256 && IN(PH_PREP)) { const unsigned* xc = (const unsigned*)(p.ws + WS_CTL) + 4096; bool ok = true;
#pragma unroll
        for (int j = 0; j < 8; ++j) ok = ok && (__hip_atomic_load(xc + XB_XCNT(j), __ATOMIC_RELAXED, __HIP_MEMORY_SCOPE_AGENT) == 32u);
        if (ok) { cz = xrank * 8 + xcc; xl_ok = true; } }
    if (IN(PH_G1)) { Gemm g{WSP(bf16, F8_G1 ? WS_O : WS_XN), WSP(const bf16, WS_WGU1), M, 5632, F8_G1 ? D / 2 : D}; StaticOrder S; S.init(M, 5632, G, cz); EpiSwiglu<false, F8_G2, F8_G1> E{WSP(bf16, WS_BIG), nullptr, nullptr};
        gemm_phase<EpiSwiglu<false, F8_G2, F8_G1>, StaticOrder, true, true, F8_G1>(lds, g, S, E, wv); } SEAML(PH_G1);
    if (IN(PH_G2)) { Gemm g{WSP(bf16, WS_BIG), WSP(const bf16, WS_WD1), M, D, F8_G2 ? DFF / 2 : DFF, 128, HS * 2, 0}; StaticOrder S; S.init(M, D, G, cz, 1); EpiResid<true> E{p.in[0], WSP(bf16, WS_XN), WSP(float, WS_SSQ1), F8_G2 ? 0.5f / 64.f : 0.5f};
        gemm_phase<EpiResid<true>, StaticOrder, true, true, F8_G2>(lds, g, S, E, wv); } SEAML(PH_G2);
    if (IN(PH_G3)) { Gemm g{WSP(bf16, WS_XN), WSP(const bf16, WS_WIN), M, 3072, D}; PermOrder S; S.init(M, 3072, G, cz); S.tab = 0x6b7853a94210ull;
        EpiQKV E{WSP(bf16, WS_BIG), WSP(float, WS_GATES), WSP(float, WS_LOGF), WSP(float, WS_SSQ1), WSP(const float, WS_ROPE), p.in[9], p.in[11], p.in[12], p.in[19], p.in[20], p.in[8]};
        gemm_phase<EpiQKV, PermOrder, true, true>(lds, g, S, E, wv); } SEAM(PH_G3);
    if (IN(PH_CMPR)) { { Gemm g{WSP(bf16, WS_BIG), WSP(const bf16, WS_WC1), 4096, 512, 2048, 16 * QP * 2, QP * 2, 1}; StaticOrder S; S.init(4096, 512, G, cz);
          float* posb = WSP(float, WS_POSBS) + (size_t)c * 512;
          { if (cz < 32) { const int t_ = opaque_tid(wv);
                const float* pp = WSP(const float, WS_POSBP) + (size_t)(t_ >> 8) * 64 * 256 + (t_ & 255); float s_ = 0.f;
#pragma unroll 8
              for (int q = 0; q < 64; ++q) s_ += pp[q * 256];
              posb[t_] = s_; } __syncthreads(); }
          EpiCompress E{posb, WSP(const bf16, WS_WC2), p.in[10], WSP(bf16, WS_KCMP), WSP(bf16, WS_VCMP)};
          gemm_phase<EpiCompress, StaticOrder, false, true>(lds, g, S, E, wv); }
        ph_cumsum(p, cz, G, wv);
        if (G == 256) { if (cz >= 32 && cz < 248) ph_prep<1>(p, lds, wv, cz - 32, 216); } else ph_prep<1>(p, lds, wv, cz, G);
        __syncthreads();
        ph_win_queue(p, lds, wv); } SEAM(PH_CMPR);
    if (IN(PH_ATTN)) { if (G == 256) ph_attn_fs(p, lds, wv, cz); else { ph_cmpsel2(p, lds, wv); xcd_barrier(bar, leader); ph_attn<0>(p, lds, wv); ph_attn<1>(p, lds, wv); } } SEAML(PH_ATTN);
    if (IN(PH_G4)) { Gemm g{WSP(bf16, WS_OMIX), WSP(const bf16, WS_WOUT), M, D, D}; StaticOrder S; S.init(M, D, G, cz); EpiResidNorm<F8_G5> E{WSP(const bf16, WS_XN), WSP(bf16, WS_O), WSP(float, WS_SSQ2), WSP(const float, WS_SSQO), p.ws + WS_H2F8};
        gemm_phase<EpiResidNorm<F8_G5>, StaticOrder, true, true>(lds, g, S, E, wv); } SEAML(PH_G4);
    if (IN(PH_G5)) { Gemm g{WSP(bf16, F8_G5 ? WS_H2F8 : WS_O), WSP(const bf16, WS_WGU2), M, 5632, F8_G5 ? D / 2 : D}; StaticOrder S; S.init(M, 5632, G, cz, 1); EpiSwiglu<true, F8_G6, F8_G5> E{WSP(bf16, WS_BIG), WSP(float, WS_SSQ2), (LDSF*)(lds + RING_BYTES)};
        { if (opaque_tid(wv) < 8) ((LDSI*)(lds + RING_BYTES) + 1024)[opaque_tid(wv)] = -1; __syncthreads(); }
        gemm_phase<EpiSwiglu<true, F8_G6, F8_G5>, StaticOrder, true, true, F8_G5>(lds, g, S, E, wv); } SEAML(PH_G5);
    if (IN(PH_G6)) { Gemm g{WSP(bf16, WS_BIG), WSP(const bf16, WS_WD2), M, D, F8_G6 ? DFF / 2 : DFF, 128, HS * 2, 0}; StaticOrder S; S.init(M, D, G, cz); EpiResid<false, F8_G7> E{WSP(const bf16, WS_O), WSP(bf16, WS_XN), WSP(float, WS_SSQ3), F8_G6 ? 0.5f / 64.f : 0.5f};
        gemm_phase<EpiResid<false, F8_G7>, StaticOrder, true, true, F8_G6>(lds, g, S, E, wv);
        { Gemm g2{WSP(const bf16, WS_PB), WSP(const bf16, WS_WPROJ), M, D, DPLE}; StaticOrder S2; S2.init(M, D, G, cz); EpiE E2{WSP(bf16, WS_E), WSP(float, WS_SSQE), p.in[31]};
          gemm_phase<EpiE, StaticOrder, true, true>(lds, g2, S2, E2, wv); } } SEAML(PH_G6);
    if (IN(PH_G7)) { Gemm g{WSP(bf16, F8_G7 ? WS_H2F8 : WS_XN), WSP(const bf16, WS_WGATE), M, D, F8_G7 ? D / 2 : D}; StaticOrder S; S.init(M, D, G, cz, 1); EpiPle E{p.out, WSP(const bf16, WS_XN), WSP(const bf16, WS_E), WSP(float, WS_SSQ3), WSP(float, WS_SSQE)};
        gemm_phase<EpiPle, StaticOrder, true, true, F8_G7>(lds, g, S, E, wv); }
#undef IN
#undef SEAML
#undef SEAM
#undef WSP
}

#ifndef ONE_LAUNCH
#define ONE_LAUNCH 1
#endif
extern "C" void kernel_launch(void* const* d_in, const int* in_sizes, int n_in, void* d_out, int out_size, void* d_ws, size_t ws_size, hipStream_t stream) {
    static int grid = 0;
    if (grid == 0) {
        if (n_in != 32 || out_size != M * D || ws_size < WS_END) { fprintf(stderr, "kernel_launch: unexpected sizes n_in %d out %d ws %zu\n", n_in, out_size, ws_size); grid = -1; return; }
        int dev = 0, cus = 0, per_cu = 0;
        (void)hipGetDevice(&dev); (void)hipDeviceGetAttribute(&cus, hipDeviceAttributeMultiprocessorCount, dev);
        if (hipFuncSetAttribute((const void*)k_main, hipFuncAttributeMaxDynamicSharedMemorySize, LDS_BYTES) != hipSuccess) { fprintf(stderr, "hipFuncSetAttribute failed\n"); grid = -1; return; }
        if (hipOccupancyMaxActiveBlocksPerMultiprocessor(&per_cu, (const void*)k_main, 512, LDS_BYTES) != hipSuccess || per_cu < 1) { fprintf(stderr, "occupancy query: %d blocks per CU\n", per_cu); }
        (void)hipGetLastError();
        grid = cus;
    }
    if (grid < 0) return;
    P p{};
    for (int i = 0; i < 32; ++i) p.in[i] = (const float*)d_in[i];
    p.out = (float*)d_out; p.ws = (unsigned char*)d_ws;
    { const double rc[12] = {1.0, 0.19392274474868576, 0.03760603093086393, 0.007292664737217109, 0.001414213562373095, 0.0002742481756762073, 5.318295896944988e-05, 1.031338537721246e-05,
                             0.6366197723675814, 1.5707963267948966, 6.123233995736766e-17, 0.0};
      for (int i = 0; i < 12; ++i) p.rc[i] = rc[i]; }
    (void)hipMemsetAsync((char*)d_ws + WS_CTL, 0, 64 * 1024, stream);
#if ONE_LAUNCH
    int lo = 0, hi = PH_N;
    void* args[] = {&p, &lo, &hi};
    hipError_t e = hipLaunchCooperativeKernel((const void*)k_main, dim3(grid), dim3(512), args, LDS_BYTES, stream);
    if (e != hipSuccess) fprintf(stderr, "cooperative launch failed: %s (grid %d)\n", hipGetErrorString(e), grid);
#else
    for (int ph = 0; ph < PH_N; ++ph) hipLaunchKernelGGL(k_main, dim3(grid), dim3(512), LDS_BYTES, stream, p, ph, ph + 1);
#endif
}
```
